# Optimizing an MI355X kernel written in HIP

```python
import numpy as np
import jax
import jax.numpy as jnp
from jax import lax

D_MODEL = 1024
BATCH = 8
SEQ = 4096
DEPTH = 1

PLE_DIM = 256
N_HEADS = 8
N_KV = 2
HPG = N_HEADS // N_KV
HEAD_DIM = 64
CMP_BLOCK = 32
CMP_STRIDE = 16
CMP_HIDDEN = 128
SEL_BLOCK = 64
N_SEL = 8
WINDOW = 512
Q_BLOCK = 128
SEL_Q_BLOCK = 32
CONV_CH = 512
CONV_WIDTH = 31
N_GROUPS = 4
EXP_PER_GROUP = 8
N_EXPERTS = N_GROUPS * EXP_PER_GROUP
EXPERT_FF = 512
TOP_K = 2
MOE_BLOCK = 128
EPS = 1e-6
NEG = -1e30
BIG = 1e4
Q_COLS = N_HEADS * HEAD_DIM
KV_COLS = N_KV * HEAD_DIM
OFF_KV = Q_COLS
OFF_GATE = OFF_KV + 6 * KV_COLS
OFF_CONV = OFF_GATE + 3 * N_HEADS
OFF_MERGE = OFF_CONV + 2 * CONV_CH
N_IN = OFF_MERGE + 2 * D_MODEL

kernel_name = "hybrid_nsa_conformer_hmoe_block"


def rmsnorm(x, g):
    xf = x.astype(jnp.float32)
    y = xf * lax.rsqrt(jnp.mean(xf * xf, axis=-1, keepdims=True) + EPS)
    return (y * g.astype(jnp.float32)).astype(x.dtype)


def masked_softmax(s, mask):
    p = jax.nn.softmax(jnp.where(mask, s, NEG), axis=-1)
    return jnp.where(mask, p, 0.0)


def alibi_slopes():
    m = 2.0 ** (-8.0 * np.arange(1, N_HEADS + 1) / N_HEADS)
    return jnp.asarray(m.reshape(N_KV, HPG), jnp.float32)


def compress(kv_raw, pe, w1, w2):
    b, s, g, dh = kv_raw.shape
    nc = (s - CMP_BLOCK) // CMP_STRIDE + 1
    idx = np.arange(nc)[:, None] * CMP_STRIDE + np.arange(CMP_BLOCK)[None, :]
    blk = kv_raw[:, idx] + pe[None, None, :, None, :]
    blk = blk.transpose(0, 1, 3, 2, 4).reshape(b, nc, g, CMP_BLOCK * dh)
    return jax.nn.gelu(blk @ w1) @ w2


def nsa(q, kc, vc, ks, vs, kw, vw, gates, slopes):
    b, s = q.shape[0], q.shape[1]
    scale = HEAD_DIM ** -0.5
    nc = kc.shape[1]
    nsb = s // SEL_BLOCK
    n_sel = min(N_SEL, nsb)
    c_end = jnp.arange(nc, dtype=jnp.int32) * CMP_STRIDE + CMP_BLOCK - 1
    c_start_np = np.arange(nc) * CMP_STRIDE
    s_start_np = np.arange(nsb) * SEL_BLOCK
    overlap = jnp.asarray((c_start_np[:, None] < s_start_np[None, :] + SEL_BLOCK)
                          & (c_start_np[:, None] + CMP_BLOCK > s_start_np[None, :]), jnp.float32)
    blk_ids = jnp.arange(nsb, dtype=jnp.int32)

    def cmp_block(j):
        q0 = j * Q_BLOCK
        t = q0 + jnp.arange(Q_BLOCK, dtype=jnp.int32)
        qb = lax.dynamic_slice_in_dim(q, q0, Q_BLOCK, axis=1)
        sc = jnp.einsum('bqgrd,bngd->bgrqn', qb, kc).astype(jnp.float32) * scale
        dist = (t[:, None] - c_end[None, :]).astype(jnp.float32)
        sc = sc - slopes[None, :, :, None, None] * dist
        pc = masked_softmax(sc, (c_end[None, :] <= t[:, None]))
        oc = jnp.einsum('bgrqn,bngd->bqgrd', pc.astype(vc.dtype), vc)
        imp = jnp.einsum('bgrqn,nj->bgqj', pc, overlap)
        valid = (blk_ids[None, :] * SEL_BLOCK) <= t[:, None]
        cur = t[:, None] // SEL_BLOCK
        forced = (blk_ids[None, :] == 0) | (blk_ids[None, :] == cur) | (blk_ids[None, :] == cur - 1)
        score = jnp.where(valid, imp + jnp.where(forced, BIG, 0.0), -BIG)
        top, idx = lax.top_k(score, n_sel)
        ok = top > -0.5 * BIG
        return oc, idx.transpose(0, 2, 1, 3), ok.transpose(0, 2, 1, 3)

    o_c, sel_idx, sel_ok = lax.map(cmp_block, jnp.arange(s // Q_BLOCK, dtype=jnp.int32))
    o_c = jnp.moveaxis(o_c, 0, 1).reshape(b, s, N_KV, HPG, HEAD_DIM)
    sel_idx = jnp.moveaxis(sel_idx, 0, 1).reshape(b, s, N_KV, n_sel)
    sel_ok = jnp.moveaxis(sel_ok, 0, 1).reshape(b, s, N_KV, n_sel)

    ksb = ks.reshape(b, nsb, SEL_BLOCK, N_KV, HEAD_DIM).transpose(0, 3, 1, 2, 4)
    vsb = vs.reshape(b, nsb, SEL_BLOCK, N_KV, HEAD_DIM).transpose(0, 3, 1, 2, 4)
    b_ix = jnp.arange(b)[:, None, None, None]
    g_ix = jnp.arange(N_KV)[None, None, :, None]

    def sel_block(j):
        q0 = j * SEL_Q_BLOCK
        t = q0 + jnp.arange(SEL_Q_BLOCK, dtype=jnp.int32)
        qb = lax.dynamic_slice_in_dim(q, q0, SEL_Q_BLOCK, axis=1)
        idx = lax.dynamic_slice_in_dim(sel_idx, q0, SEL_Q_BLOCK, axis=1)
        ok = lax.dynamic_slice_in_dim(sel_ok, q0, SEL_Q_BLOCK, axis=1)
        kg = ksb[b_ix, g_ix, idx]
        vg = vsb[b_ix, g_ix, idx]
        kpos = idx[..., None] * SEL_BLOCK + jnp.arange(SEL_BLOCK, dtype=jnp.int32)
        tt = t[None, :, None, None, None]
        mask = ((kpos <= tt) & ok[..., None])[:, :, :, None]
        dist = (tt - kpos).astype(jnp.float32)[:, :, :, None]
        ss = jnp.einsum('bqgrd,bqgnkd->bqgrnk', qb, kg).astype(jnp.float32) * scale
        ss = ss - slopes[None, None, :, :, None, None] * dist
        m = n_sel * SEL_BLOCK
        ps = masked_softmax(ss.reshape(b, SEL_Q_BLOCK, N_KV, HPG, m), mask.reshape(b, SEL_Q_BLOCK, N_KV, 1, m))
        return jnp.einsum('bqgrm,bqgmd->bqgrd', ps.astype(vg.dtype), vg.reshape(b, SEL_Q_BLOCK, N_KV, m, HEAD_DIM))

    o_s = lax.map(sel_block, jnp.arange(s // SEL_Q_BLOCK, dtype=jnp.int32))
    o_s = jnp.moveaxis(o_s, 0, 1).reshape(b, s, N_KV, HPG, HEAD_DIM)

    kwp = jnp.pad(kw, ((0, 0), (WINDOW, 0), (0, 0), (0, 0)))
    vwp = jnp.pad(vw, ((0, 0), (WINDOW, 0), (0, 0), (0, 0)))

    def win_block(j):
        q0 = j * Q_BLOCK
        t = q0 + jnp.arange(Q_BLOCK, dtype=jnp.int32)
        qb = lax.dynamic_slice_in_dim(q, q0, Q_BLOCK, axis=1)
        kb = lax.dynamic_slice_in_dim(kwp, q0, WINDOW + Q_BLOCK, axis=1)
        vb = lax.dynamic_slice_in_dim(vwp, q0, WINDOW + Q_BLOCK, axis=1)
        kpos = q0 - WINDOW + jnp.arange(WINDOW + Q_BLOCK, dtype=jnp.int32)
        d = t[:, None] - kpos[None, :]
        mask = (d >= 0) & (d < WINDOW) & (kpos[None, :] >= 0)
        sw = jnp.einsum('bqgrd,bkgd->bgrqk', qb, kb).astype(jnp.float32) * scale
        sw = sw - slopes[None, :, :, None, None] * d.astype(jnp.float32)
        pw = masked_softmax(sw, mask)
        return jnp.einsum('bgrqk,bkgd->bqgrd', pw.astype(vb.dtype), vb)

    o_w = lax.map(win_block, jnp.arange(s // Q_BLOCK, dtype=jnp.int32))
    o_w = jnp.moveaxis(o_w, 0, 1).reshape(b, s, N_KV, HPG, HEAD_DIM)

    o = gates[..., 0:1] * o_c + gates[..., 1:2] * o_s + gates[..., 2:3] * o_w
    return o.reshape(b, s, N_HEADS * HEAD_DIM)


def conformer_conv(u, conv_w, conv_b, ln_g, ln_b, w_out):
    a, g = jnp.split(u, 2, axis=-1)
    z = a * jax.nn.sigmoid(g)
    zp = jnp.pad(z, ((0, 0), (CONV_WIDTH - 1, 0), (0, 0)))
    z = lax.conv_general_dilated(zp, conv_w[:, None, :].astype(zp.dtype), (1,), 'VALID',
                                 dimension_numbers=('NWC', 'WIO', 'NWC'),
                                 feature_group_count=CONV_CH) + conv_b
    zf = z.astype(jnp.float32)
    mu = jnp.mean(zf, axis=-1, keepdims=True)
    var = jnp.mean(jnp.square(zf - mu), axis=-1, keepdims=True)
    z = ((zf - mu) * lax.rsqrt(var + EPS) * ln_g.astype(jnp.float32) + ln_b.astype(jnp.float32)).astype(u.dtype)
    return jax.nn.silu(z) @ w_out


def hier_moe(h, w_rg, b_rg, w_re, b_re, w_g, w_u, w_d):
    b, s, d = h.shape
    t_n = b * s
    hf = h.reshape(t_n, d)
    lg = (hf @ w_rg).astype(jnp.float32) + b_rg.astype(jnp.float32)
    pg = jax.nn.softmax(lg, axis=-1)
    gsel = jnp.argmax(lg, axis=-1).astype(jnp.int32)
    pg_sel = jnp.take_along_axis(pg, gsel[:, None], axis=1)
    le = ((hf @ w_re).astype(jnp.float32) + b_re.astype(jnp.float32)).reshape(t_n, N_GROUPS, EXP_PER_GROUP)
    le_g = jnp.take_along_axis(le, gsel[:, None, None], axis=1)[:, 0]
    top, loc = lax.top_k(jax.nn.softmax(le_g, axis=-1), TOP_K)
    wts = pg_sel * top / jnp.sum(top, axis=-1, keepdims=True)
    eid = gsel[:, None] * EXP_PER_GROUP + loc.astype(jnp.int32)
    tk = t_n * TOP_K
    flat_e = eid.reshape(tk)
    flat_tok = jnp.repeat(jnp.arange(t_n, dtype=jnp.int32), TOP_K)
    flat_w = wts.reshape(tk)
    order = jnp.argsort(flat_e)
    se, stok, sw = flat_e[order], flat_tok[order], flat_w[order]
    counts = jnp.bincount(flat_e, length=N_EXPERTS).astype(jnp.int32)
    starts = jnp.cumsum(counts) - counts
    padded = (counts + MOE_BLOCK - 1) // MOE_BLOCK * MOE_BLOCK
    pends = jnp.cumsum(padded)
    pstarts = pends - padded
    dest = pstarts[se] + jnp.arange(tk, dtype=jnp.int32) - starts[se]
    n_blk = -(-(tk + N_EXPERTS * (MOE_BLOCK - 1)) // MOE_BLOCK)
    p_rows = n_blk * MOE_BLOCK
    buf_tok = jnp.full((p_rows,), t_n, jnp.int32).at[dest].set(stok)
    buf_w = jnp.zeros((p_rows,), jnp.float32).at[dest].set(sw)
    blk_e = jnp.minimum(jnp.searchsorted(pends, jnp.arange(n_blk, dtype=jnp.int32) * MOE_BLOCK, side='right'),
                        N_EXPERTS - 1).astype(jnp.int32)
    hp = jnp.concatenate([hf, jnp.zeros((1, d), hf.dtype)], axis=0)

    def expert_block(args):
        tok, w, e = args
        xb = hp[tok]
        y = (jax.nn.silu(xb @ w_g[e]) * (xb @ w_u[e])) @ w_d[e]
        return y * w[:, None].astype(y.dtype)

    yb = lax.map(expert_block, (buf_tok.reshape(n_blk, MOE_BLOCK), buf_w.reshape(n_blk, MOE_BLOCK), blk_e))
    y = jnp.zeros((t_n + 1, d), yb.dtype).at[buf_tok].add(yb.reshape(p_rows, d))[:t_n]
    return y.reshape(b, s, d).astype(h.dtype)


def setup_inputs(seed: int = 0) -> dict:
    key = jax.random.key(seed)
    ks = jax.random.split(key, 32)
    f32 = jnp.float32

    def nrm(k, shape, scale):
        return jax.random.normal(k, shape, f32) * scale

    def gain(k, shape):
        return 1.0 + 0.02 * jax.random.normal(k, shape, f32)

    L = DEPTH
    return {
        "x": nrm(ks[0], (BATCH, SEQ, D_MODEL), 1.0),
        "p": nrm(ks[1], (DEPTH, BATCH, SEQ, PLE_DIM), 1.0),
        "attn_norm_g": gain(ks[2], (L, D_MODEL)),
        "w_in": nrm(ks[3], (L, D_MODEL, N_IN), D_MODEL ** -0.5),
        "q_norm_g": gain(ks[4], (L, HEAD_DIM)),
        "k_norm_g": gain(ks[5], (L, 3, HEAD_DIM)),
        "cmp_pos": nrm(ks[6], (L, 2, CMP_BLOCK, HEAD_DIM), 0.1),
        "cmp_w1": nrm(ks[7], (L, 2, CMP_BLOCK * HEAD_DIM, CMP_HIDDEN), (CMP_BLOCK * HEAD_DIM) ** -0.5),
        "cmp_w2": nrm(ks[8], (L, 2, CMP_HIDDEN, HEAD_DIM), CMP_HIDDEN ** -0.5),
        "w_attn_out": nrm(ks[9], (L, N_HEADS * HEAD_DIM, D_MODEL), (N_HEADS * HEAD_DIM) ** -0.5),
        "conv_w": nrm(ks[10], (L, CONV_WIDTH, CONV_CH), CONV_WIDTH ** -0.5),
        "conv_b": nrm(ks[11], (L, CONV_CH), 0.02),
        "conv_norm_g": gain(ks[12], (L, CONV_CH)),
        "conv_norm_b": nrm(ks[13], (L, CONV_CH), 0.02),
        "w_conv_out": nrm(ks[14], (L, CONV_CH, D_MODEL), CONV_CH ** -0.5),
        "merge_b": nrm(ks[15], (L, 2 * D_MODEL), 0.02),
        "w_out": nrm(ks[16], (L, D_MODEL, D_MODEL), D_MODEL ** -0.5),
        "ffn_norm_g": gain(ks[17], (L, D_MODEL)),
        "w_router_group": nrm(ks[18], (L, D_MODEL, N_GROUPS), D_MODEL ** -0.5),
        "b_router_group": nrm(ks[19], (L, N_GROUPS), 0.01),
        "w_router_expert": nrm(ks[20], (L, D_MODEL, N_EXPERTS), D_MODEL ** -0.5),
        "b_router_expert": nrm(ks[21], (L, N_EXPERTS), 0.01),
        "w_exp_gate": nrm(ks[22], (L, N_EXPERTS, D_MODEL, EXPERT_FF), D_MODEL ** -0.5),
        "w_exp_up": nrm(ks[23], (L, N_EXPERTS, D_MODEL, EXPERT_FF), D_MODEL ** -0.5),
        "w_exp_down": nrm(ks[24], (L, N_EXPERTS, EXPERT_FF, D_MODEL), EXPERT_FF ** -0.5),
        "ple_norm_g": gain(ks[25], (L, D_MODEL)),
        "w_ple_gate": nrm(ks[26], (L, D_MODEL, D_MODEL), D_MODEL ** -0.5),
        "b_ple_gate": nrm(ks[27], (L, D_MODEL), 0.02),
        "w_ple_proj": nrm(ks[28], (L, PLE_DIM, D_MODEL), PLE_DIM ** -0.5),
    }


def reference(x, p, attn_norm_g, w_in, q_norm_g, k_norm_g, cmp_pos, cmp_w1, cmp_w2, w_attn_out,
              conv_w, conv_b, conv_norm_g, conv_norm_b, w_conv_out, merge_b, w_out,
              ffn_norm_g, w_router_group, b_router_group, w_router_expert, b_router_expert,
              w_exp_gate, w_exp_up, w_exp_down, ple_norm_g, w_ple_gate, b_ple_gate, w_ple_proj):
    b, s, _ = x.shape
    slopes = alibi_slopes()
    for i in range(DEPTH):
        h = rmsnorm(x, attn_norm_g[i])
        z = h @ w_in[i]
        q = rmsnorm(z[..., :Q_COLS].reshape(b, s, N_KV, HPG, HEAD_DIM), q_norm_g[i])
        kv = z[..., OFF_KV:OFF_GATE].reshape(b, s, 6, N_KV, HEAD_DIM)
        kc = rmsnorm(compress(kv[:, :, 0], cmp_pos[i, 0], cmp_w1[i, 0], cmp_w2[i, 0]), k_norm_g[i, 0])
        vc = compress(kv[:, :, 1], cmp_pos[i, 1], cmp_w1[i, 1], cmp_w2[i, 1])
        k_sel = rmsnorm(kv[:, :, 2], k_norm_g[i, 1])
        k_win = rmsnorm(kv[:, :, 4], k_norm_g[i, 2])
        nsa_gates = jax.nn.sigmoid(z[..., OFF_GATE:OFF_CONV].reshape(b, s, N_KV, HPG, 3))
        attn = nsa(q, kc, vc, k_sel, kv[:, :, 3], k_win, kv[:, :, 5], nsa_gates, slopes)
        y_a = attn @ w_attn_out[i]
        y_c = conformer_conv(z[..., OFF_CONV:OFF_MERGE], conv_w[i], conv_b[i], conv_norm_g[i],
                             conv_norm_b[i], w_conv_out[i])
        mg = jax.nn.sigmoid(z[..., OFF_MERGE:] + merge_b[i])
        x = x + (mg[..., :D_MODEL] * y_a + mg[..., D_MODEL:] * y_c) @ w_out[i]
        x = x + hier_moe(rmsnorm(x, ffn_norm_g[i]), w_router_group[i], b_router_group[i],
                         w_router_expert[i], b_router_expert[i], w_exp_gate[i], w_exp_up[i], w_exp_down[i])
        gate = jax.nn.sigmoid(rmsnorm(x, ple_norm_g[i]) @ w_ple_gate[i] + b_ple_gate[i])
        x = x + gate * (p[i] @ w_ple_proj[i])
    return x
```

```cpp
#include <hip/hip_runtime.h>
#include <cstdio>
#include <cstdint>

#define LAS __attribute__((address_space(3)))
#define GAS __attribute__((address_space(1)))
typedef unsigned short bf16;
typedef short bf16x8 __attribute__((ext_vector_type(8)));
typedef short s16x4 __attribute__((ext_vector_type(4)));
typedef float f32x2 __attribute__((ext_vector_type(2)));
typedef float f32x4 __attribute__((ext_vector_type(4)));
typedef float f32x16 __attribute__((ext_vector_type(16)));
typedef unsigned u32x2 __attribute__((ext_vector_type(2)));
typedef unsigned u32x4 __attribute__((ext_vector_type(4)));
typedef GAS unsigned gu32;

constexpr int BATCH = 8, SEQ = 4096, T = BATCH * SEQ, DM = 1024, NIN = 4376;
constexpr int OFF_KV = 512, OFF_GATE = 1280, OFF_CONV = 1304, OFF_MERGE = 2328;
constexpr int NT_IN = 18;
constexpr int NEXP = 32, EFF = 512, LISTCAP = 32768;
constexpr float EPS = 1e-6f;
constexpr float LOG2E = 1.4426950408889634f;
constexpr float QC2 = 0.125f * 1.4426950408889634f;

typedef __bf16 bf16x2_t __attribute__((ext_vector_type(2)));
__device__ __forceinline__ unsigned cvt_pk_bf16(float lo, float hi) { const f32x2 v = {lo, hi}; const bf16x2_t b = __builtin_convertvector(v, bf16x2_t); return __builtin_bit_cast(unsigned, b); }
__device__ __forceinline__ float bf_lo(unsigned w) { return __uint_as_float(w << 16); }
__device__ __forceinline__ float bf_hi(unsigned w) { return __uint_as_float(w & 0xffff0000u); }
__device__ __forceinline__ float fsigmoid(float v) { return __builtin_amdgcn_rcpf(1.0f + __builtin_amdgcn_exp2f(-v * LOG2E)); }
__device__ __forceinline__ float wave_sum(float v) {
#pragma unroll
    for (int o = 1; o < 64; o <<= 1) v += __shfl_xor(v, o);
    return v;
}

namespace pg8 {
constexpr int BM = 256, BK = 64, HALF = 128, HTB = HALF * BK * 2, STAGE_BYTES = 8 * HTB, NXCD = 8, WGM = 8;
__host__ __device__ __forceinline__ int lds_byte(int r, int c) { const int st = (r >> 4) * 2 + (c >> 5), rr = r & 15, cc = c & 31, ob = rr * 64 + cc * 2; return st * 1024 + (ob ^ (((ob >> 9) & 1) << 5)); }
__host__ __device__ __forceinline__ void stage_rc(int b, int& R, int& C) { const int st = b / 1024, sb = b % 1024, swz = sb ^ (((sb >> 9) & 1) << 5); R = (st >> 1) * 16 + swz / 64; C = (st & 1) * 32 + (swz % 64) / 2; }
__host__ __device__ __forceinline__ int perm32(int rho) { const int n = rho >> 4, i = rho & 15; return 8 * (i >> 2) + 4 * n + (i & 3); }

struct Unit { int pm, pn, b0, e, lp, nrow; };
struct Gemm { const bf16* A; const bf16* Bt; int K; };

struct StaticOrder {
    int nM, nN, nwg, G, c;
    __device__ void init(int M, int N, int G_, int c_) { nM = M / BM; nN = N / BM; nwg = nM * nN; G = G_; c = c_; }
    __device__ bool next(int i, Unit& u) const {
        const long L = (long)i * G + c; if (L >= nwg) return false;
        int wgid = (int)L; { const int q = nwg / NXCD, r = nwg % NXCD, xcd = wgid % NXCD, off = wgid / NXCD; wgid = (xcd < r ? xcd * (q + 1) : r * (q + 1) + (xcd - r) * q) + off; }
        const int nig = WGM * nN, gid = wgid / nig, fm = gid * WGM, gsz = (nM - fm) < WGM ? (nM - fm) : WGM;
        u.pm = fm + ((wgid % nig) % gsz); u.pn = (wgid % nig) / gsz; u.b0 = u.pn * BM; u.e = 0; u.lp = 0; u.nrow = BM; return true;
    }
    static constexpr bool GATHER = false;
    __device__ __forceinline__ int arow0(const Unit& u) const { return u.pm * BM; }
    __device__ __forceinline__ int arow(const Unit& u, int r) const { return u.pm * BM + r; }
};

template <class Epi, class Sched, bool ALIGN_EPI>
__device__ __forceinline__ void gemm_phase(LAS unsigned char* lds, const Gemm g, const Sched& S, const Epi& E) {
    int tid_ = threadIdx.x; asm volatile("" : "+v"(tid_));
    const int tid = tid_, wid = __builtin_amdgcn_readfirstlane(tid >> 6), lane = tid & 63, wr = wid >> 2, wc = wid & 3, fr = lane & 15, fq = lane >> 4;
    const int K = g.K, nt = K / BK;
    int RA[2], CA[2]; unsigned voffB[2];
#pragma unroll
    for (int i = 0; i < 2; ++i) { int R, C; stage_rc(tid * 16 + i * 8192, R, C); const int Rb = (R & ~31) + perm32(R & 31);
        RA[i] = R; CA[i] = C; voffB[i] = (unsigned)(Rb * K + C) * 2u; }
    const size_t kstep = (size_t)(BK * 2);
    const size_t hstep = (size_t)HALF * K * 2;
    const unsigned ldsw = (unsigned)wid * 1024u;
    const int aoff = lds_byte(wr * 64 + fr, fq * 8), boff = lds_byte(wc * 32 + fr, fq * 8);
#define PG8_SA(b, h) (((b) * 2 + (h)) * HTB)
#define PG8_SB(b, h) ((4 + (b) * 2 + (h)) * HTB)
#define PG8_STAGE(bufoff, gbase, v0, v1) do { \
        __builtin_amdgcn_global_load_lds((const unsigned*)((const char*)(gbase) + (v0)), (LAS unsigned*)(lds + (bufoff) + ldsw), 16, 0, 0); \
        __builtin_amdgcn_global_load_lds((const unsigned*)((const char*)(gbase) + (v1)), (LAS unsigned*)(lds + (bufoff) + ldsw + 8192), 16, 0, 0); } while (0)
#define PG8_LDA(dst, b, h) do { _Pragma("unroll") for (int m = 0; m < 4; ++m) _Pragma("unroll") for (int k = 0; k < 2; ++k) dst[m][k] = *(const LAS bf16x8*)(lds + PG8_SA(b, h) + aoff + m * 2048 + k * 1024); } while (0)
#define PG8_LDB(dst, b, h) do { _Pragma("unroll") for (int n = 0; n < 2; ++n) _Pragma("unroll") for (int k = 0; k < 2; ++k) dst[n][k] = *(const LAS bf16x8*)(lds + PG8_SB(b, h) + boff + n * 2048 + k * 1024); } while (0)
#define PG8_MMA(ai, bj, At, Bt) do { __builtin_amdgcn_s_setprio(1); _Pragma("unroll") for (int m = 0; m < 4; ++m) _Pragma("unroll") for (int n = 0; n < 2; ++n) _Pragma("unroll") for (int k = 0; k < 2; ++k) \
        acc[ai][bj][m][n] = __builtin_amdgcn_mfma_f32_16x16x32_bf16(Bt[n][k], At[m][k], acc[ai][bj][m][n], 0, 0, 0); __builtin_amdgcn_s_setprio(0); } while (0)
#define PG8_WAIT_V(n) asm volatile("s_waitcnt vmcnt(" #n ")" ::: "memory")
#define PG8_WAIT_L(n) asm volatile("s_waitcnt lgkmcnt(" #n ")" ::: "memory")
#define PG8_BAR __builtin_amdgcn_s_barrier()
#define PG8_SCHED __builtin_amdgcn_sched_barrier(0)
    Unit cur, nxt; int ui = 0;
    if (!S.next(0, cur)) return;
    f32x4 acc[2][2][4][2];
#pragma unroll
    for (int a = 0; a < 2; ++a)
#pragma unroll
        for (int b = 0; b < 2; ++b)
#pragma unroll
            for (int m = 0; m < 4; ++m)
#pragma unroll
                for (int n = 0; n < 2; ++n) acc[a][b][m][n] = (f32x4){0.f, 0.f, 0.f, 0.f};
    bf16x8 At[4][2], B0[2][2], B1[2][2];
    constexpr bool GA = Sched::GATHER;
    const size_t hs = GA ? (size_t)0 : hstep;
    unsigned ac00, ac01, ac10, ac11, an00, an01, an10, an11;
#define PG8_AOFF(u, h, i) ((unsigned)(S.arow(u, (h) * HALF + RA[i]) * K + CA[i]) * 2u)
    const char* A0 = (const char*)g.A;
    const char* cAu = A0; const char* nAu = A0;
    if constexpr (GA) { ac00 = PG8_AOFF(cur, 0, 0); ac01 = PG8_AOFF(cur, 0, 1); ac10 = PG8_AOFF(cur, 1, 0); ac11 = PG8_AOFF(cur, 1, 1); }
    else { ac00 = ac10 = (unsigned)(RA[0] * K + CA[0]) * 2u; ac01 = ac11 = (unsigned)(RA[1] * K + CA[1]) * 2u; cAu = A0 + (size_t)S.arow0(cur) * K * 2; }
    an00 = ac00; an01 = ac01; an10 = ac10; an11 = ac11;
    const char* cB = (const char*)g.Bt + (size_t)cur.b0 * K * 2;
    PG8_STAGE(PG8_SB(0, 0), cB, voffB[0], voffB[1]); PG8_STAGE(PG8_SB(0, 1), cB + hstep, voffB[0], voffB[1]); PG8_STAGE(PG8_SA(0, 0), cAu, ac00, ac01); PG8_STAGE(PG8_SA(0, 1), cAu + hs, ac10, ac11);
    if (wr == 1) PG8_BAR;
    PG8_WAIT_V(2); PG8_BAR;
    PG8_STAGE(PG8_SB(1, 0), cB + kstep, voffB[0], voffB[1]); PG8_STAGE(PG8_SA(1, 0), cAu + kstep, ac00, ac01); PG8_STAGE(PG8_SB(1, 1), cB + hstep + kstep, voffB[0], voffB[1]);
    PG8_WAIT_V(6); PG8_BAR;
    for (;;) {
        const bool has_next = S.next(ui + 1, nxt);
        const char* nB = has_next ? (const char*)g.Bt + (size_t)nxt.b0 * K * 2 : cB;
        if constexpr (GA) {
            if (has_next) { an00 = PG8_AOFF(nxt, 0, 0); an01 = PG8_AOFF(nxt, 0, 1); an10 = PG8_AOFF(nxt, 1, 0); an11 = PG8_AOFF(nxt, 1, 1); }
            else { an00 = ac00; an01 = ac01; an10 = ac10; an11 = ac11; }
        } else { nAu = has_next ? A0 + (size_t)S.arow0(nxt) * K * 2 : cAu; }
#pragma unroll 1
        for (int t = 0; t < nt; t += 2) {
            const bool last = (t == nt - 2);
            if constexpr (Epi::MID) { if (t == Epi::MID_T) E.mid(acc, cur, wr, wc, fr, fq); }
            const char* a1 = cAu + (size_t)(t + 1) * kstep;
            const char* a2 = last ? nAu : cAu + (size_t)(t + 2) * kstep; const char* b2 = last ? nB : cB + (size_t)(t + 2) * kstep;
            const char* a3 = a2 + kstep; const char* b3 = b2 + kstep;
            unsigned o00 = ac00, o01 = ac01, o10 = ac10, o11 = ac11;
            if constexpr (GA) { o00 = last ? an00 : ac00; o01 = last ? an01 : ac01; o10 = last ? an10 : ac10; o11 = last ? an11 : ac11; }
            PG8_LDB(B0, 0, 0); PG8_LDB(B1, 0, 1); PG8_SCHED; PG8_LDA(At, 0, 0); PG8_STAGE(PG8_SA(1, 1), a1 + hs, ac10, ac11);
            PG8_WAIT_V(8); PG8_WAIT_L(0); PG8_BAR; PG8_MMA(0, 0, At, B0); PG8_MMA(0, 1, At, B1); PG8_BAR; PG8_SCHED;
            PG8_LDA(At, 0, 1); PG8_STAGE(PG8_SB(0, 0), b2, voffB[0], voffB[1]); PG8_STAGE(PG8_SB(0, 1), b2 + hstep, voffB[0], voffB[1]); PG8_STAGE(PG8_SA(0, 0), a2, o00, o01);
            PG8_WAIT_V(8); PG8_WAIT_L(0); PG8_BAR; PG8_MMA(1, 0, At, B0); PG8_MMA(1, 1, At, B1); PG8_BAR; PG8_SCHED;
            PG8_LDB(B0, 1, 0); PG8_LDB(B1, 1, 1); PG8_SCHED; PG8_LDA(At, 1, 0); PG8_STAGE(PG8_SA(0, 1), a2 + hs, o10, o11);
            PG8_WAIT_V(8); PG8_WAIT_L(0); PG8_BAR; PG8_MMA(0, 0, At, B0); PG8_MMA(0, 1, At, B1); PG8_BAR; PG8_SCHED;
            PG8_LDA(At, 1, 1); PG8_STAGE(PG8_SB(1, 0), b3, voffB[0], voffB[1]); PG8_STAGE(PG8_SB(1, 1), b3 + hstep, voffB[0], voffB[1]); PG8_STAGE(PG8_SA(1, 0), a3, o00, o01);
            PG8_WAIT_V(8); PG8_WAIT_L(0); PG8_BAR; PG8_MMA(1, 0, At, B0); PG8_MMA(1, 1, At, B1); PG8_BAR; PG8_SCHED;
        }
        if constexpr (ALIGN_EPI) { if (wr == 0) PG8_BAR; }
        E(acc, cur, wr, wc, fr, fq);
        if (!has_next) break;
#pragma unroll
        for (int a = 0; a < 2; ++a)
#pragma unroll
            for (int b = 0; b < 2; ++b)
#pragma unroll
                for (int m = 0; m < 4; ++m)
#pragma unroll
                    for (int n = 0; n < 2; ++n) acc[a][b][m][n] = (f32x4){0.f, 0.f, 0.f, 0.f};
        cur = nxt; cB = nB; cAu = nAu; ac00 = an00; ac01 = an01; ac10 = an10; ac11 = an11; ++ui;
        if constexpr (ALIGN_EPI) { if (wr == 1) PG8_BAR; }
    }
    PG8_WAIT_V(0);
    if constexpr (!ALIGN_EPI) { if (wr == 0) PG8_BAR; }
    PG8_BAR;
#undef PG8_AOFF
#undef PG8_SA
#undef PG8_SB
#undef PG8_STAGE
#undef PG8_LDA
#undef PG8_LDB
#undef PG8_MMA
#undef PG8_WAIT_V
#undef PG8_WAIT_L
#undef PG8_BAR
#undef PG8_SCHED
}
}

#define RLX_AGENT __ATOMIC_RELAXED, __HIP_MEMORY_SCOPE_AGENT
#define LDS_WAIT() asm volatile("s_waitcnt lgkmcnt(0)" ::: "memory")
#define VM_WAIT() asm volatile("s_waitcnt vmcnt(0)" ::: "memory")
#define XB_TMO      128
#define XB_XCNT(j)  (256  + 64 * (j))
#define XB_XSUB(j)  (1280 + 64 * (j))
#define XB_XGEN(j)  (2304 + 64 * (j))
#define XB_TOP      3328
#define XB_TOPGEN   3392
#define XCD_BAR_WORDS 3456
#define XB_SPIN_CAP (1u << 18)

__device__ __forceinline__ unsigned xb_ld(unsigned* p)              { return __hip_atomic_load(p, __ATOMIC_RELAXED, __HIP_MEMORY_SCOPE_AGENT); }
__device__ __forceinline__ unsigned xb_add(unsigned* p, unsigned v) { return __hip_atomic_fetch_add(p, v, __ATOMIC_RELAXED, __HIP_MEMORY_SCOPE_AGENT); }
__device__ __forceinline__ unsigned xb_xcc_id() { return (unsigned)__builtin_amdgcn_s_getreg((3 << 11) | 20) & 0xFu; }
#define XB_SPIN(cond, bar) do { unsigned _sp = 0; while (cond) { __builtin_amdgcn_s_sleep(1); \
    if ((++_sp & 255u) == 0u) { if (xb_ld(&(bar)[XB_TMO])) break; if (_sp > XB_SPIN_CAP) { atomicAdd(&(bar)[XB_TMO], 1u); break; } } } } while (0)

struct XcdBarrier {
    unsigned* bar; unsigned x;
    volatile LAS unsigned* st;
};

__device__ __forceinline__ XcdBarrier xcd_barrier_post(unsigned* bar, volatile LAS unsigned* st) {
    XcdBarrier b; b.bar = bar; b.x = xb_xcc_id(); b.st = st;
    if (threadIdx.x == 0) (void)xb_add(&bar[XB_XCNT(b.x)], 1u);
    return b;
}
__device__ __forceinline__ void xcd_barrier_complete(unsigned* bar, unsigned x, unsigned& nloc, unsigned& nx) {
    const unsigned G = gridDim.x * gridDim.y * gridDim.z;
    unsigned sum, cnt, mine, sp = 0u;
    for (;;) {
        sum = 0u; cnt = 0u; mine = 0u;
#pragma unroll
        for (unsigned j = 0; j < 16; ++j) { const unsigned c = xb_ld(&bar[XB_XCNT(j)]); sum += c; cnt += (c > 0u) ? 1u : 0u; mine = (j == x) ? c : mine; }
        if (sum == G) break;
        __builtin_amdgcn_s_sleep(1);
        if ((++sp & 255u) == 0u) { if (xb_ld(&bar[XB_TMO])) break; if (sp > XB_SPIN_CAP) { atomicAdd(&bar[XB_TMO], 1u); break; } }
    }
    nloc = mine > 0u ? mine : 1u; nx = cnt > 0u ? cnt : 1u;
}

__device__ __forceinline__ void xcd_barrier(const XcdBarrier& b) {
    asm volatile("s_waitcnt vmcnt(0)" ::: "memory");
    __syncthreads();
    if (threadIdx.x == 0) {
        unsigned* bar = b.bar;
        __builtin_amdgcn_s_waitcnt(0);
        unsigned nloc = b.st[0], nx = b.st[1];
        if (nloc == 0u) { xcd_barrier_complete(bar, b.x, nloc, nx); b.st[0] = nloc; b.st[1] = nx; }
        const unsigned old = xb_add(&bar[XB_XSUB(b.x)], 1u);
        const unsigned gen = old / nloc;
        if (old + 1u == (gen + 1u) * nloc) {
            __builtin_amdgcn_fence(__ATOMIC_RELEASE, "agent");
            asm volatile("s_waitcnt vmcnt(0)" ::: "memory");
            const unsigned og = xb_add(&bar[XB_TOP], 1u);
            const unsigned tg = og / nx;
            if (og + 1u == (tg + 1u) * nx) xb_add(&bar[XB_TOPGEN], 1u);
            else XB_SPIN(xb_ld(&bar[XB_TOPGEN]) == tg, bar);
            __builtin_amdgcn_fence(__ATOMIC_ACQUIRE, "agent");
            xb_add(&bar[XB_XGEN(b.x)], 1u);
            asm volatile("s_waitcnt vmcnt(0)" ::: "memory");
        } else {
            XB_SPIN(xb_ld(&bar[XB_XGEN(b.x)]) == gen, bar);
            __builtin_amdgcn_fence(__ATOMIC_ACQUIRE, "agent");
            asm volatile("s_waitcnt vmcnt(0)" ::: "memory");
        }
    }
    __syncthreads();
}

constexpr int NWAVES = 8;
#ifndef P1_ALIGN
#define P1_ALIGN true
#endif
#ifndef MK_PER_PHASE
#define MK_PER_PHASE 0
#endif
constexpr int NPH = 11;
constexpr size_t MiB = 1u << 20;
constexpr size_t WS_CTL = 0, CTL_ZERO_BYTES = 1 * MiB;
constexpr size_t WS_WT = 1 * MiB;
constexpr size_t WS_RSTD2 = WS_WT + 256 * 1024;
constexpr size_t WS_RSTD3 = WS_RSTD2 + 128 * 1024;
constexpr size_t WS_C1 = WS_RSTD3 + 128 * 1024;
constexpr size_t WS_LIST = 2 * MiB;
constexpr size_t WS_NG = 6 * MiB;
constexpr size_t WS_KC = 10 * MiB, WS_VC = WS_KC + 512 * 1024;
constexpr size_t WS_WIN = 11 * MiB;
constexpr size_t WS_WAC = 20 * MiB, WS_WO = 22 * MiB, WS_WPG = 24 * MiB, WS_WPP = 26 * MiB, WS_WR = WS_WPP + 512 * 1024, WS_CW1 = 27 * MiB, WS_CW2 = 28 * MiB;
constexpr size_t WS_WGU = 29 * MiB;
constexpr size_t WS_WD = 93 * MiB;
constexpr size_t WS_XN = 125 * MiB;
constexpr size_t WS_QB = 189 * MiB;
constexpr size_t WS_KVB = 221 * MiB;
constexpr size_t WS_H = 189 * MiB;
constexpr size_t WS_GLU = 269 * MiB;
constexpr size_t WS_MG = 301 * MiB;
constexpr size_t WS_Y = 301 * MiB;
constexpr size_t WS_AC = 429 * MiB;
constexpr size_t WS_PP = 429 * MiB;
constexpr size_t WS_PBF = 493 * MiB;
constexpr size_t WS_END = 509 * MiB;
constexpr int CW_TMO = 0, CW_CODE = 1, CW_QATT = 64, CW_CNT = 128  , CW_BAR = 4096;

constexpr int RING_BYTES = 131072;
constexpr int LDSCTL_OFF = RING_BYTES, MISC_OFF = LDSCTL_OFF + 320, MOE_OFF = LDSCTL_OFF + 1024;
constexpr int LDS_BYTES = 147456;

struct Args { const float* in[29]; float* out; unsigned char* ws; int ph_lo, ph_hi; };
#define CAS __attribute__((address_space(4)))
struct Frame {
    LAS unsigned char* lds;
    volatile LAS unsigned* MISC;
    gu32* ctl;
    int tid, lane, wave, vcu, G;
    const CAS Args* ka;
    float* out;
    unsigned char* ws;
    __device__ __forceinline__ const float* inp(int i) const { return ka->in[i]; }
};

__device__ __forceinline__ void tr_item(const float* W, int ldw, int ks0, int s0, int nvalid, const float* kscale, bf16* WT, size_t drow0, int K, int kd0, LAS float* scr, int lane) {
#pragma unroll 8
    for (int i = 0; i < 32; ++i) { const int kk = 2 * i + (lane >> 5), c = lane & 31;
        float v = 0.f; if (c < nvalid) v = W[(size_t)(ks0 + kk) * ldw + s0 + c];
        if (kscale) v *= kscale[ks0 + kk];
        scr[kk * 33 + c] = v; }
    LDS_WAIT(); asm volatile("" ::: "memory");
    const int c = lane & 7;
#pragma unroll
    for (int j = 0; j < 4; ++j) { const int n = (lane >> 3) + 8 * j; const LAS float* s = scr + (8 * c) * 33 + n;
        u32x4 o; o.x = cvt_pk_bf16(s[0 * 33], s[1 * 33]); o.y = cvt_pk_bf16(s[2 * 33], s[3 * 33]); o.z = cvt_pk_bf16(s[4 * 33], s[5 * 33]); o.w = cvt_pk_bf16(s[6 * 33], s[7 * 33]);
        *(u32x4*)(WT + (drow0 + n) * K + kd0 + 8 * c) = o; }
    LDS_WAIT(); asm volatile("" ::: "memory");
}

__device__ __forceinline__ void p0_prologue(Frame& F) {
    LAS float* scr = (LAS float*)(F.lds + F.wave * 16384);
    const int lane = F.lane;
    const int gw = F.vcu * NWAVES + F.wave, NGW = F.G * NWAVES;
    unsigned char* ws = F.ws;
    constexpr int I_IN = 144 * 16, I_AC = 32 * 16, I_O = 32 * 16, I_PG = 32 * 16, I_PP = 32 * 4, I_R = 2 * 16, I_C1 = 2 * 4 * 32, I_C2 = 2 * 2 * 2;
    constexpr int I_GU = 32 * 32 * 16, I_D = 32 * 32 * 8;
    constexpr int NITEMS = I_IN + I_AC + I_O + I_PG + I_PP + I_R + I_C1 + I_C2 + I_GU + I_D;
    for (int it = gw; it < NITEMS; it += NGW) {
        int r = it;
        if (r < I_IN) {
            const int db = r >> 4, kb = r & 15, tile = db >> 3, pb = db & 7, bj = pb >> 2, wc = pb & 3;
            int s0, nv = 32;
            if (tile < 2) s0 = tile * 256 + 64 * wc + 32 * bj;
            else if (tile < 5) s0 = OFF_KV + (tile - 2) * 256 + 64 * wc + 32 * bj;
            else if (tile < 9) s0 = OFF_CONV + (bj ? 512 : 0) + (tile - 5) * 128 + 32 * wc;
            else if (tile < 17) s0 = OFF_MERGE + (tile - 9) * 256 + 64 * wc + 32 * bj;
            else { s0 = OFF_GATE; nv = (pb == 0) ? 24 : 0; }
            tr_item(F.inp(3), NIN, kb * 64, s0, nv, nullptr, (bf16*)(ws + WS_WIN), (size_t)db * 32, 1024, kb * 64, scr, lane); continue; }
        r -= I_IN;
        if (r < I_AC) { const int db = r >> 4, kb = r & 15;
            if (kb < 8) tr_item(F.inp(9), 1024, kb * 64, db * 32, 32, nullptr, (bf16*)(ws + WS_WAC), (size_t)db * 32, 1024, kb * 64, scr, lane);
            else tr_item(F.inp(14), 1024, (kb - 8) * 64, db * 32, 32, nullptr, (bf16*)(ws + WS_WAC), (size_t)db * 32, 1024, kb * 64, scr, lane);
            continue; }
        r -= I_AC;
        if (r < I_O) { const int db = r >> 4, kb = r & 15; tr_item(F.inp(16), 1024, kb * 64, db * 32, 32, nullptr, (bf16*)(ws + WS_WO), (size_t)db * 32, 1024, kb * 64, scr, lane); continue; }
        r -= I_O;
        if (r < I_PG) { const int db = r >> 4, kb = r & 15; tr_item(F.inp(26), 1024, kb * 64, db * 32, 32, F.inp(25), (bf16*)(ws + WS_WPG), (size_t)db * 32, 1024, kb * 64, scr, lane); continue; }
        r -= I_PG;
        if (r < I_PP) { const int db = r >> 2, kb = r & 3; tr_item(F.inp(28), 1024, kb * 64, db * 32, 32, nullptr, (bf16*)(ws + WS_WPP), (size_t)db * 32, 256, kb * 64, scr, lane); continue; }
        r -= I_PP;
        if (r < I_R) { const int db = r >> 4, kb = r & 15;
            if (db == 0) tr_item(F.inp(18), 4, kb * 64, 0, 4, F.inp(17), (bf16*)(ws + WS_WR), 0, 1024, kb * 64, scr, lane);
            else tr_item(F.inp(20), 32, kb * 64, 0, 32, F.inp(17), (bf16*)(ws + WS_WR), 32, 1024, kb * 64, scr, lane);
            continue; }
        r -= I_R;
        if (r < I_C1) { const int kv = r >> 7, q = r & 127, db = q >> 5, kb = q & 31;
            tr_item(F.inp(7) + (size_t)kv * 2048 * 128, 128, kb * 64, db * 32, 32, nullptr, (bf16*)(ws + WS_CW1) + (size_t)kv * 128 * 2048, (size_t)db * 32, 2048, kb * 64, scr, lane); continue; }
        r -= I_C1;
        if (r < I_C2) { const int kv = r >> 2, q = r & 3, db = q >> 1, kb = q & 1;
            tr_item(F.inp(8) + (size_t)kv * 128 * 64, 64, kb * 64, db * 32, 32, nullptr, (bf16*)(ws + WS_CW2) + (size_t)kv * 64 * 128, (size_t)db * 32, 128, kb * 64, scr, lane); continue; }
        r -= I_C2;
        if (r < I_GU) { const int e = r >> 9, q = r & 511, db = q >> 4, kb = q & 15, pn = db >> 3, pb = db & 7, bj = pb >> 2, wc = pb & 3;
            const float* W = (bj ? F.inp(23) : F.inp(22)) + (size_t)e * 1024 * 512;
            tr_item(W, 512, kb * 64, 128 * pn + 32 * wc, 32, F.inp(17), (bf16*)(ws + WS_WGU) + (size_t)e * 1024 * 1024, (size_t)db * 32, 1024, kb * 64, scr, lane); continue; }
        r -= I_GU;
        { const int e = r >> 8, q = r & 255, db = q >> 3, kb = q & 7;
            tr_item(F.inp(24) + (size_t)e * 512 * 1024, 1024, kb * 64, db * 32, 32, nullptr, (bf16*)(ws + WS_WD) + (size_t)e * 1024 * 512, (size_t)db * 32, 512, kb * 64, scr, lane); }
    }
    {
        const f32x4* gp = (const f32x4*)F.inp(2) + lane; f32x4 gv[4];
#pragma unroll
        for (int j = 0; j < 4; ++j) gv[j] = gp[64 * j];
        for (int m = gw; m < T; m += NGW) {
            const f32x4* xr = (const f32x4*)(F.inp(0) + (size_t)m * DM) + lane; f32x4 v[4]; float s = 0.f;
#pragma unroll
            for (int j = 0; j < 4; ++j) { v[j] = xr[64 * j]; s += (v[j].x * v[j].x + v[j].y * v[j].y) + (v[j].z * v[j].z + v[j].w * v[j].w); }
            const float rstd = 1.0f / sqrtf(wave_sum(s) * (1.f / DM) + EPS);
            u32x2* o8 = (u32x2*)((bf16*)(ws + WS_XN) + (size_t)m * DM) + lane;
#pragma unroll
            for (int j = 0; j < 4; ++j) { u32x2 w; w.x = cvt_pk_bf16(v[j].x * rstd * gv[j].x, v[j].y * rstd * gv[j].y); w.y = cvt_pk_bf16(v[j].z * rstd * gv[j].z, v[j].w * rstd * gv[j].w); o8[64 * j] = w; }
        }
    }
    {
        const size_t n8 = (size_t)T * 256 / 8; const f32x4* src = (const f32x4*)F.inp(1); u32x4* dst = (u32x4*)(ws + WS_PBF);
        for (size_t i = (size_t)blockIdx.x * 512 + F.tid; i < n8; i += (size_t)F.G * 512) { const f32x4 a = src[2 * i], b = src[2 * i + 1];
            u32x4 o; o.x = cvt_pk_bf16(a.x, a.y); o.y = cvt_pk_bf16(a.z, a.w); o.z = cvt_pk_bf16(b.x, b.y); o.w = cvt_pk_bf16(b.z, b.w); dst[i] = o; }
    }
    if (gw < 256) { const int kv = gw >> 7, j = gw & 127; const float* pe = F.inp(6) + (size_t)kv * 2048; const float* w1 = F.inp(7) + (size_t)kv * 2048 * 128 + j; float s = 0.f;
        for (int k = lane; k < 2048; k += 64) s += pe[k] * w1[(size_t)k * 128];
        s = wave_sum(s); if (lane == 0) ((float*)(ws + WS_C1))[gw] = s; }
}

__device__ __forceinline__ u32x4 pack8(const f32x4 a, const f32x4 b) { u32x4 w; w.x = cvt_pk_bf16(a[0], a[1]); w.y = cvt_pk_bf16(a[2], a[3]); w.z = cvt_pk_bf16(b[0], b[1]); w.w = cvt_pk_bf16(b[2], b[3]); return w; }
__device__ __forceinline__ void unpack8(const u32x4 w, f32x4& a, f32x4& b) { a = (f32x4){bf_lo(w.x), bf_hi(w.x), bf_lo(w.y), bf_hi(w.y)}; b = (f32x4){bf_lo(w.z), bf_hi(w.z), bf_lo(w.w), bf_hi(w.w)}; }

struct EpiWin {
    static constexpr bool MID = false; static constexpr int MID_T = 0;
    bf16 *Qb, *KVb, *GLU, *MG; float* NG; const float *qg, *kg, *mb;
    __device__ __forceinline__ void mid(f32x4 (&)[2][2][4][2], const pg8::Unit&, int, int, int, int) const {}
    __device__ __forceinline__ void operator()(const f32x4 (&acc)[2][2][4][2], const pg8::Unit& u, int wr, int wc, int fr, int fq) const {
        int oz = 0; asm volatile("" : "+v"(oz));
        const int row0 = u.pm * 256 + wr * 64 + fr + oz, pn = u.pn;
        if (pn < 5) {
            bool norm; const float* gain; float sc; bf16* dst; int ld, col;
            if (pn < 2) { norm = true; gain = qg; sc = QC2; dst = Qb; ld = 512; col = (pn * 4 + wc) * 64; }
            else { const int i = 2 * (pn - 2) + (wc >> 1), g = wc & 1; norm = (i == 2) || (i == 4); gain = kg + (i == 2 ? 64 : 128); sc = 1.f; dst = KVb; ld = 768; col = i * 128 + g * 64; }
            f32x4 gv[2][2];
#pragma unroll
            for (int bj = 0; bj < 2; ++bj)
#pragma unroll
                for (int n = 0; n < 2; ++n) gv[bj][n] = norm ? *(const f32x4*)(gain + 32 * bj + 8 * fq + 4 * n) * sc : (f32x4){1.f, 1.f, 1.f, 1.f};
#pragma unroll
            for (int ai = 0; ai < 2; ++ai)
#pragma unroll
                for (int m = 0; m < 4; ++m) {
                    float rs = 1.f;
                    if (norm) { float s = 0.f;
#pragma unroll
                        for (int bj = 0; bj < 2; ++bj)
#pragma unroll
                            for (int n = 0; n < 2; ++n) { const f32x4 x = acc[ai][bj][m][n]; s += (x[0] * x[0] + x[1] * x[1]) + (x[2] * x[2] + x[3] * x[3]); }
                        s += __shfl_xor(s, 16); s += __shfl_xor(s, 32);
                        rs = 1.0f / sqrtf(s * (1.f / 64.f) + EPS); }
                    bf16* rowp = dst + (unsigned)((row0 + ai * 128 + m * 16) * ld + col + 8 * fq);
#pragma unroll
                    for (int bj = 0; bj < 2; ++bj) *(u32x4*)(rowp + 32 * bj) = pack8(acc[ai][bj][m][0] * rs * gv[bj][0], acc[ai][bj][m][1] * rs * gv[bj][1]);
                }
        } else if (pn < 9) {
            const int col = (pn - 5) * 128 + 32 * wc + 8 * fq;
#pragma unroll
            for (int ai = 0; ai < 2; ++ai)
#pragma unroll
                for (int m = 0; m < 4; ++m) { f32x4 o[2];
#pragma unroll
                    for (int n = 0; n < 2; ++n) { const f32x4 a = acc[ai][0][m][n], gt = acc[ai][1][m][n];
                        o[n] = (f32x4){a[0] * fsigmoid(gt[0]), a[1] * fsigmoid(gt[1]), a[2] * fsigmoid(gt[2]), a[3] * fsigmoid(gt[3])}; }
                    *(u32x4*)(GLU + (unsigned)((row0 + ai * 128 + m * 16) * 512 + col)) = pack8(o[0], o[1]); }
        } else if (pn < 17) {
            const int col = (pn - 9) * 256 + 64 * wc + 8 * fq;
            f32x4 bv[2][2];
#pragma unroll
            for (int bj = 0; bj < 2; ++bj)
#pragma unroll
                for (int n = 0; n < 2; ++n) bv[bj][n] = *(const f32x4*)(mb + col + 32 * bj + 4 * n);
#pragma unroll
            for (int ai = 0; ai < 2; ++ai)
#pragma unroll
                for (int m = 0; m < 4; ++m)
#pragma unroll
                    for (int bj = 0; bj < 2; ++bj) { f32x4 o[2];
#pragma unroll
#ifdef MG_RAW
                        for (int n = 0; n < 2; ++n) { o[n] = acc[ai][bj][m][n]; }
#else
                        for (int n = 0; n < 2; ++n) { const f32x4 z = acc[ai][bj][m][n] + bv[bj][n]; o[n] = (f32x4){fsigmoid(z[0]), fsigmoid(z[1]), fsigmoid(z[2]), fsigmoid(z[3])}; }
#endif
                        *(u32x4*)(MG + (unsigned)((row0 + ai * 128 + m * 16) * 2048 + col + 32 * bj)) = pack8(o[0], o[1]); }
        } else {
            if (wc == 0 && fq < 3) {
#pragma unroll
                for (int ai = 0; ai < 2; ++ai)
#pragma unroll
                    for (int m = 0; m < 4; ++m)
#pragma unroll
                        for (int n = 0; n < 2; ++n) { const f32x4 z = acc[ai][0][m][n];
                            *(f32x4*)(NG + (unsigned)((row0 + ai * 128 + m * 16) * 32 + 8 * fq + 4 * n)) = (f32x4){fsigmoid(z[0]), fsigmoid(z[1]), fsigmoid(z[2]), fsigmoid(z[3])}; }
            }
        }
    }
};

struct EpiMerge {
    static constexpr bool MID = true; static constexpr int MID_T = 8;
    const bf16* MG; bf16* MER;
    __device__ __forceinline__ void mid(f32x4 (&acc)[2][2][4][2], const pg8::Unit& u, int wr, int wc, int fr, int fq) const {
        int oz = 0; asm volatile("" : "+v"(oz));
        const int row0 = u.pm * 256 + wr * 64 + fr + oz, col0 = u.pn * 256 + wc * 32 + 8 * fq;
#pragma unroll
        for (int ai = 0; ai < 2; ++ai)
#pragma unroll
            for (int m = 0; m < 4; ++m)
#pragma unroll
                for (int bj = 0; bj < 2; ++bj) { const bf16* p = MG + (unsigned)((row0 + ai * 128 + m * 16) * 2048 + col0 + bj * 128);
                    f32x4 a0, a1, c0, c1; unpack8(*(const u32x4*)p, a0, a1); unpack8(*(const u32x4*)(p + 1024), c0, c1);
#pragma unroll
                    for (int j = 0; j < 4; ++j) { acc[ai][bj][m][0][j] *= a0[j] * __builtin_amdgcn_rcpf(c0[j]); acc[ai][bj][m][1][j] *= a1[j] * __builtin_amdgcn_rcpf(c1[j]); }
                    asm volatile("" : "+v"(acc[ai][bj][m][0]), "+v"(acc[ai][bj][m][1]) :: "memory"); }
    }
    __device__ __forceinline__ void operator()(const f32x4 (&acc)[2][2][4][2], const pg8::Unit& u, int wr, int wc, int fr, int fq) const {
        int oz = 0; asm volatile("" : "+v"(oz));
        const int row0 = u.pm * 256 + wr * 64 + fr + oz, col0 = u.pn * 256 + wc * 32 + 8 * fq;
#pragma unroll
        for (int ai = 0; ai < 2; ++ai)
#pragma unroll
            for (int m = 0; m < 4; ++m)
#pragma unroll
                for (int bj = 0; bj < 2; ++bj) { const unsigned r = (unsigned)(row0 + ai * 128 + m * 16);
                    f32x4 c0, c1; unpack8(*(const u32x4*)(MG + (unsigned)(r * 2048 + 1024 + col0 + bj * 128)), c0, c1);
                    *(u32x4*)(MER + (unsigned)(r * 1024 + col0 + bj * 128)) = pack8(acc[ai][bj][m][0] * c0, acc[ai][bj][m][1] * c1); asm volatile("" ::: "memory"); }
    }
};

struct EpiWo {
    static constexpr bool MID = false; static constexpr int MID_T = 0;
    const float* X; float* O;
    __device__ __forceinline__ void mid(f32x4 (&)[2][2][4][2], const pg8::Unit&, int, int, int, int) const {}
    __device__ __forceinline__ void operator()(const f32x4 (&acc)[2][2][4][2], const pg8::Unit& u, int wr, int wc, int fr, int fq) const {
        int oz = 0; asm volatile("" : "+v"(oz));
        const int row0 = u.pm * 256 + wr * 64 + fr + oz, col0 = u.pn * 256 + wc * 32 + 8 * fq;
#pragma unroll
        for (int ai = 0; ai < 2; ++ai)
#pragma unroll
            for (int m = 0; m < 4; ++m)
#pragma unroll
                for (int bj = 0; bj < 2; ++bj) { const unsigned o = (unsigned)((row0 + ai * 128 + m * 16) * 1024 + col0 + bj * 128);
                    *(f32x4*)(O + o) = *(const f32x4*)(X + o) + acc[ai][bj][m][0]; *(f32x4*)(O + o + 4) = *(const f32x4*)(X + o + 4) + acc[ai][bj][m][1]; asm volatile("" ::: "memory"); }
    }
};

struct EpiBf {
    static constexpr bool MID = false; static constexpr int MID_T = 0;
    bf16* O; int ldc;
    __device__ __forceinline__ void mid(f32x4 (&)[2][2][4][2], const pg8::Unit&, int, int, int, int) const {}
    __device__ __forceinline__ void operator()(const f32x4 (&acc)[2][2][4][2], const pg8::Unit& u, int wr, int wc, int fr, int fq) const {
        int oz = 0; asm volatile("" : "+v"(oz));
        const int row0 = u.pm * 256 + wr * 64 + fr + oz, col0 = u.pn * 256 + wc * 32 + 8 * fq;
#pragma unroll
        for (int ai = 0; ai < 2; ++ai)
#pragma unroll
            for (int m = 0; m < 4; ++m)
#pragma unroll
                for (int bj = 0; bj < 2; ++bj) *(u32x4*)(O + (unsigned)((row0 + ai * 128 + m * 16) * ldc + col0 + bj * 128)) = pack8(acc[ai][bj][m][0], acc[ai][bj][m][1]);
    }
};

template <bool GATH> struct MoeOrder {
    static constexpr bool GATHER = GATH;
    const LAS int* tab; const int* list; int G, c;
    __device__ bool next(int i, pg8::Unit& u) const {
        const int R = tab[32]; const long L = (long)i * G + c; if (L >= (long)R * 4) return false;
        const int rt = (int)(L >> 2), pn = (int)(L & 3); int e = 0;
        for (int k = 1; k < 32; ++k) e += (tab[k] <= rt) ? 1 : 0;
        u.pm = rt; u.pn = pn; u.e = e; u.lp = (rt - tab[e]) * 256; const int cn = tab[33 + e] - u.lp; u.nrow = cn < 256 ? cn : 256; u.b0 = e * 1024 + pn * 256; return true;
    }
    __device__ __forceinline__ int arow0(const pg8::Unit& u) const { return u.pm * 256; }
    __device__ __forceinline__ int arow(const pg8::Unit& u, int r) const {
        if (!GATH) return u.pm * 256 + r;
        const int rr = r < u.nrow ? r : u.nrow - 1; return list[u.e * LISTCAP + u.lp + rr] >> 1;
    }
};

struct EpiGU {
    static constexpr bool MID = false; static constexpr int MID_T = 0;
    bf16* H; const int* list; const float* rstd;
    __device__ __forceinline__ void mid(f32x4 (&)[2][2][4][2], const pg8::Unit&, int, int, int, int) const {}
    __device__ __forceinline__ void operator()(const f32x4 (&acc)[2][2][4][2], const pg8::Unit& u, int wr, int wc, int fr, int fq) const {
        int oz = 0; asm volatile("" : "+v"(oz));
        const int col = u.pn * 128 + 32 * wc + 8 * fq;
#pragma unroll
        for (int ai = 0; ai < 2; ++ai)
#pragma unroll
            for (int m = 0; m < 4; ++m) { const int r = ai * 128 + wr * 64 + m * 16 + fr + oz;
                if (r < u.nrow) { const float rs = rstd[list[u.e * LISTCAP + u.lp + r] >> 1]; f32x4 o[2];
#pragma unroll
                    for (int n = 0; n < 2; ++n)
#pragma unroll
                        for (int j = 0; j < 4; ++j) { const float gt = acc[ai][0][m][n][j] * rs, up = acc[ai][1][m][n][j] * rs; o[n][j] = gt * fsigmoid(gt) * up; }
                    *(u32x4*)(H + (unsigned)((u.pm * 256 + r) * 512 + col)) = pack8(o[0], o[1]); } }
    }
};

struct EpiDown {
    static constexpr bool MID = false; static constexpr int MID_T = 0;
    bf16* Y; const int* list; const float* wt;
    __device__ __forceinline__ void mid(f32x4 (&)[2][2][4][2], const pg8::Unit&, int, int, int, int) const {}
    __device__ __forceinline__ void operator()(const f32x4 (&acc)[2][2][4][2], const pg8::Unit& u, int wr, int wc, int fr, int fq) const {
        int oz = 0; asm volatile("" : "+v"(oz));
        const int col0 = u.pn * 256 + wc * 32 + 8 * fq;
#pragma unroll
        for (int ai = 0; ai < 2; ++ai)
#pragma unroll
            for (int m = 0; m < 4; ++m) { const int r = ai * 128 + wr * 64 + m * 16 + fr + oz;
                if (r < u.nrow) { const int ent = list[u.e * LISTCAP + u.lp + r]; const float w = wt[ent];
#pragma unroll
                    for (int bj = 0; bj < 2; ++bj) *(u32x4*)(Y + (unsigned)(ent * 1024 + col0 + bj * 128)) = pack8(acc[ai][bj][m][0] * w, acc[ai][bj][m][1] * w); } }
    }
};

struct EpiPle {
    static constexpr bool MID = false; static constexpr int MID_T = 0;
    float* O; const bf16* PP; const float* rstd; const float* bias;
    __device__ __forceinline__ void mid(f32x4 (&)[2][2][4][2], const pg8::Unit&, int, int, int, int) const {}
    __device__ __forceinline__ void operator()(const f32x4 (&acc)[2][2][4][2], const pg8::Unit& u, int wr, int wc, int fr, int fq) const {
        int oz = 0; asm volatile("" : "+v"(oz));
        const int row0 = u.pm * 256 + wr * 64 + fr + oz, col0 = u.pn * 256 + wc * 32 + 8 * fq;
        f32x4 bv[2][2];
#pragma unroll
        for (int bj = 0; bj < 2; ++bj)
#pragma unroll
            for (int n = 0; n < 2; ++n) bv[bj][n] = *(const f32x4*)(bias + col0 + bj * 128 + 4 * n);
#pragma unroll
        for (int ai = 0; ai < 2; ++ai)
#pragma unroll
            for (int m = 0; m < 4; ++m) { const int row = row0 + ai * 128 + m * 16; const float rs = rstd[row];
#pragma unroll
                for (int bj = 0; bj < 2; ++bj) { const unsigned o = (unsigned)(row * 1024 + col0 + bj * 128);
                    f32x4 p0, p1; unpack8(*(const u32x4*)(PP + o), p0, p1);
                    const f32x4 z0 = acc[ai][bj][m][0] * rs + bv[bj][0], z1 = acc[ai][bj][m][1] * rs + bv[bj][1];
                    const f32x4 g0 = (f32x4){fsigmoid(z0[0]), fsigmoid(z0[1]), fsigmoid(z0[2]), fsigmoid(z0[3])}, g1 = (f32x4){fsigmoid(z1[0]), fsigmoid(z1[1]), fsigmoid(z1[2]), fsigmoid(z1[3])};
                    *(f32x4*)(O + o) = *(const f32x4*)(O + o) + g0 * p0; *(f32x4*)(O + o + 4) = *(const f32x4*)(O + o + 4) + g1 * p1; asm volatile("" ::: "memory"); } }
    }
};

__device__ __forceinline__ float gelu_tanh(float x) { const float u = 0.7978845608028654f * (x + 0.044715f * x * x * x); const float e = __builtin_amdgcn_exp2f(2.f * LOG2E * u); const float th = 1.f - 2.f * __builtin_amdgcn_rcpf(e + 1.f); return 0.5f * x * (1.f + th); }

__device__ __forceinline__ void compress_unit(Frame& F, int unit) {
    const int nt16 = unit & 15, b = (unit >> 4) & 7, g = (unit >> 7) & 1, kv = unit >> 8;
    const int lane = F.lane, wid = F.wave, i16 = lane & 15, kq = lane >> 4;
    const bf16* KVb = (const bf16*)(F.ws + WS_KVB);
    const bf16* W1 = (const bf16*)(F.ws + WS_CW1) + (size_t)kv * 128 * 2048;
    const bf16* W2 = (const bf16*)(F.ws + WS_CW2) + (size_t)kv * 64 * 128;
    const float* c1 = (const float*)(F.ws + WS_C1) + kv * 128;
    LAS float* part = (LAS float*)F.lds;
    LAS bf16* hid = (LAS bf16*)(F.lds + 65536);
    LAS float* outs = (LAS float*)(F.lds + 65536 + 8192);
    const int n = nt16 * 16 + i16;
    const int tok = b * SEQ + (n < 255 ? n : 254) * 16;
    f32x4 acc[8];
#pragma unroll
    for (int j = 0; j < 8; ++j) acc[j] = (f32x4){0.f, 0.f, 0.f, 0.f};
#pragma unroll
    for (int ll = 0; ll < 4; ++ll) { const int l = wid * 4 + ll;
#pragma unroll
        for (int s = 0; s < 2; ++s) {
            const bf16x8 a = *(const bf16x8*)(KVb + (size_t)(tok + l) * 768 + kv * 128 + g * 64 + s * 32 + kq * 8);
#pragma unroll
            for (int j = 0; j < 8; ++j) { const bf16x8 w = *(const bf16x8*)(W1 + (size_t)(j * 16 + i16) * 2048 + l * 64 + s * 32 + kq * 8);
                acc[j] = __builtin_amdgcn_mfma_f32_16x16x32_bf16(a, w, acc[j], 0, 0, 0); } } }
#pragma unroll
    for (int j = 0; j < 8; ++j)
#pragma unroll
        for (int r = 0; r < 4; ++r) part[(wid * 16 + kq * 4 + r) * 128 + j * 16 + i16] = acc[j][r];
    __syncthreads();
    { const int tid = F.tid;
#pragma unroll
      for (int q = 0; q < 4; ++q) { const int idx = tid + 512 * q, row = idx >> 7, col = idx & 127; float s = c1[col];
#pragma unroll
          for (int w = 0; w < 8; ++w) s += part[(w * 16 + row) * 128 + col];
          hid[row * 136 + col] = (bf16)(cvt_pk_bf16(gelu_tanh(s), 0.f) & 0xffffu); } }
    __syncthreads();
    if (wid < 4) { f32x4 o = (f32x4){0.f, 0.f, 0.f, 0.f};
#pragma unroll
        for (int s = 0; s < 4; ++s) { const bf16x8 a = *(const LAS bf16x8*)(hid + i16 * 136 + s * 32 + kq * 8);
            const bf16x8 w = *(const bf16x8*)(W2 + (size_t)(wid * 16 + i16) * 128 + s * 32 + kq * 8);
            o = __builtin_amdgcn_mfma_f32_16x16x32_bf16(a, w, o, 0, 0, 0); }
#pragma unroll
        for (int r = 0; r < 4; ++r) outs[(kq * 4 + r) * 64 + wid * 16 + i16] = o[r]; }
    __syncthreads();
    { const int tid = F.tid, row = tid >> 5, c = tid & 31; const float v0 = outs[row * 64 + c], v1 = outs[row * 64 + 32 + c];
      float rs = 1.f, g0 = 1.f, g1 = 1.f;
      if (kv == 0) { float s = v0 * v0 + v1 * v1;
#pragma unroll
          for (int o = 1; o < 32; o <<= 1) s += __shfl_xor(s, o);
          rs = 1.0f / sqrtf(s * (1.f / 64.f) + EPS); g0 = F.inp(5)[c]; g1 = F.inp(5)[32 + c]; }
      const int nn = nt16 * 16 + row; const bool real = nn < 255;
      bf16* dst = (bf16*)(F.ws + (kv ? WS_VC : WS_KC)) + ((size_t)(b * 2 + g) * 256 + nn) * 64;
      dst[c] = real ? (bf16)(cvt_pk_bf16(v0 * rs * g0, 0.f) & 0xffffu) : (bf16)0;
      dst[32 + c] = real ? (bf16)(cvt_pk_bf16(v1 * rs * g1, 0.f) & 0xffffu) : (bf16)0; }
    __syncthreads();
}

__device__ __forceinline__ void conv_unit(Frame& F, int unit, const f32x2 (&cw)[31], const f32x2 cb) {
    const int tid = F.tid, lane = F.lane, wid = F.wave;
    const int t0 = unit * 32, s0 = t0 & (SEQ - 1);
    const bf16* GLU = (const bf16*)(F.ws + WS_GLU);
    LAS unsigned* tin = (LAS unsigned*)F.lds;
    LAS float* tout = (LAS float*)(F.lds + 65536);
    for (int i = tid; i < 62 * 64; i += 512) { const int r = i >> 6, c = i & 63; const int s = s0 - 30 + r;
        u32x4 v = (u32x4){0u, 0u, 0u, 0u}; if (s >= 0) v = *(const u32x4*)(GLU + (size_t)(t0 - 30 + r) * 512 + c * 8);
        *(LAS u32x4*)(tin + r * 256 + c * 4) = v; }
    __syncthreads();
    { const int cp = tid & 255, th = tid >> 8;
#pragma unroll 1
      for (int tt = 0; tt < 16; ++tt) { const int tl = th * 16 + tt; f32x2 a = cb;
#pragma unroll
          for (int j = 0; j < 31; ++j) { const unsigned w = tin[(tl + j) * 256 + cp]; a.x += cw[j].x * bf_lo(w); a.y += cw[j].y * bf_hi(w); }
          *(LAS f32x2*)(tout + tl * 512 + cp * 2) = a; } }
    __syncthreads();
    { const f32x4 lg0 = *(const f32x4*)(F.inp(12) + lane * 8), lg1 = *(const f32x4*)(F.inp(12) + lane * 8 + 4), lb0 = *(const f32x4*)(F.inp(13) + lane * 8), lb1 = *(const f32x4*)(F.inp(13) + lane * 8 + 4);
#pragma unroll 1
      for (int q = 0; q < 4; ++q) { const int tl = wid * 4 + q; const f32x4 v0 = *(const LAS f32x4*)(tout + tl * 512 + lane * 8), v1 = *(const LAS f32x4*)(tout + tl * 512 + lane * 8 + 4);
          const float mu = wave_sum((v0[0] + v0[1]) + (v0[2] + v0[3]) + (v1[0] + v1[1]) + (v1[2] + v1[3])) * (1.f / 512.f);
          const f32x4 d0 = v0 - mu, d1 = v1 - mu;
          const float var = wave_sum((d0[0] * d0[0] + d0[1] * d0[1]) + (d0[2] * d0[2] + d0[3] * d0[3]) + (d1[0] * d1[0] + d1[1] * d1[1]) + (d1[2] * d1[2] + d1[3] * d1[3])) * (1.f / 512.f);
          const float rs = 1.0f / sqrtf(var + EPS);
          f32x4 y0 = d0 * rs * lg0 + lb0, y1 = d1 * rs * lg1 + lb1;
#pragma unroll
          for (int j = 0; j < 4; ++j) { y0[j] *= fsigmoid(y0[j]); y1[j] *= fsigmoid(y1[j]); }
#if defined(ABL) && ABL == 3
          y0 = (f32x4){0.f, 0.f, 0.f, 0.f}; y1 = y0;
#endif
          *(u32x4*)((bf16*)(F.ws + WS_AC) + (size_t)(t0 + tl) * 1024 + 512 + lane * 8) = pack8(y0, y1); } }
    __syncthreads();
}

__device__ __forceinline__ void p2_phase(Frame& F) {
    for (int u = F.vcu; u < 512; u += F.G) compress_unit(F, u);
    f32x2 cw[31]; const int cp = F.tid & 255;
#pragma unroll
    for (int j = 0; j < 31; ++j) cw[j] = *(const f32x2*)(F.inp(10) + j * 512 + cp * 2);
    const f32x2 cb = *(const f32x2*)(F.inp(11) + cp * 2);
    for (int u = F.vcu; u < T / 32; u += F.G) conv_unit(F, u, cw, cb);
}

namespace att {
#if defined(ABL)
#define ABLF(k) (ABL == (k) ? 0.f : 1.f) *
#else
#define ABLF(k)
#endif
constexpr int L_K = 0, L_V = 16384, L_IMP = 32768, L_WS = L_IMP + 64 * 65 * 4  , L_SEL = L_WS + 2048, L_WU = L_SEL + 512, L_Q = L_WU + 64, L_OST = 53248;
static_assert(L_Q + 16 <= L_OST && L_OST + 65536 <= RING_BYTES, "attention LDS map");
__device__ __forceinline__ int crow(int r, int hi) { return (r & 3) + 8 * (r >> 2) + 4 * hi; }

struct Stage { u32x4 k, v; };
__device__ __forceinline__ void stage_load(Stage& s, const bf16* Kb, const bf16* Vb, int pitch, int key0, int wid, int lane, bool needv) {
    s.k = *(const u32x4*)(Kb + (unsigned)((key0 + lane) * pitch + wid * 8));
    if (needv) s.v = *(const u32x4*)(Vb + (unsigned)((key0 + 16 * (wid & 3) + (lane >> 2)) * pitch + (wid >> 2) * 32 + (lane & 3) * 8));
}
__device__ __forceinline__ void stage_store(const Stage& s, LAS unsigned char* lds, int buf, int wid, int lane, bool needv) {
    *(LAS u32x4*)(lds + L_K + buf * 8192 + wid * 1024 + lane * 16) = s.k;
    if (needv) *(LAS u32x4*)(lds + L_V + buf * 8192 + wid * 1024 + lane * 16) = s.v;
}
__device__ __forceinline__ void qk_tile(f32x16& p0, f32x16& p1, const LAS unsigned char* Ks, const bf16x8 (&qr)[4], int r32, int hi) {
    const LAS unsigned char* kb = Ks + hi * 1024 + r32 * 16;
    p0 = (f32x16){0.f}; p1 = (f32x16){0.f};
#pragma unroll
    for (int d0 = 0; d0 < 4; ++d0) {
        const bf16x8 b0 = *(const LAS bf16x8*)(kb + d0 * 2048), b1 = *(const LAS bf16x8*)(kb + d0 * 2048 + 512);
        p0 = __builtin_amdgcn_mfma_f32_32x32x16_bf16(b0, qr[d0], p0, 0, 0, 0);
        p1 = __builtin_amdgcn_mfma_f32_32x32x16_bf16(b1, qr[d0], p1, 0, 0, 0); }
}
__device__ __forceinline__ s16x4 vtr(unsigned addr) { s16x4 r; asm volatile("ds_read_b64_tr_b16 %0, %1" : "=v"(r) : "v"(addr) : "memory"); return r; }
__device__ __forceinline__ void pv_tile(f32x16 (&o)[2], unsigned vbase, const f32x16& p0, const f32x16& p1) {
    bf16x8 pa[4];
#pragma unroll
    for (int ks = 0; ks < 4; ++ks) { const f32x16& P = (ks < 2) ? p0 : p1; const int b = (ks & 1) * 8;
        u32x4 w; w.x = cvt_pk_bf16(P[b + 0], P[b + 1]); w.y = cvt_pk_bf16(P[b + 2], P[b + 3]); w.z = cvt_pk_bf16(P[b + 4], P[b + 5]); w.w = cvt_pk_bf16(P[b + 6], P[b + 7]);
        pa[ks] = __builtin_bit_cast(bf16x8, w); }
#pragma unroll
    for (int d0 = 0; d0 < 2; ++d0) {
        s16x4 lo[4], hi[4];
#pragma unroll
        for (int ks = 0; ks < 4; ++ks) { lo[ks] = vtr(vbase + d0 * 4096 + ks * 1024); hi[ks] = vtr(vbase + d0 * 4096 + ks * 1024 + 512); }
        asm volatile("s_waitcnt lgkmcnt(0)" : "+v"(lo[0]), "+v"(lo[1]), "+v"(lo[2]), "+v"(lo[3]), "+v"(hi[0]), "+v"(hi[1]), "+v"(hi[2]), "+v"(hi[3]) :: "memory");
        __builtin_amdgcn_sched_barrier(0);
#pragma unroll
        for (int ks = 0; ks < 4; ++ks) { const bf16x8 vf = (bf16x8){lo[ks][0], lo[ks][1], lo[ks][2], lo[ks][3], hi[ks][0], hi[ks][1], hi[ks][2], hi[ks][3]};
            o[d0] = __builtin_amdgcn_mfma_f32_32x32x16_bf16(pa[ks], vf, o[d0], 0, 0, 0); }
    }
}
__device__ __forceinline__ float max32(const f32x16& p0, const f32x16& p1) {
    float a = fmaxf(p0[0], p1[0]);
#pragma unroll
    for (int r = 1; r < 16; ++r) a = fmaxf(a, fmaxf(p0[r], p1[r]));
    return fmaxf(a, __shfl_xor(a, 32));
}
__device__ __forceinline__ void softmax_step(f32x16& p0, f32x16& p1, float& m, float& l, f32x16 (&o)[2], LAS float* wsf, int r32, int hi) {
    const float rm = max32(p0, p1);
    const float mn = fmaxf(m, rm), mu = (mn == -INFINITY) ? 0.f : mn;
    const float f = __builtin_amdgcn_exp2f(m - mu);
    float s = 0.f;
#pragma unroll
    for (int r = 0; r < 16; ++r) { p0[r] = __builtin_amdgcn_exp2f(p0[r] - mu); p1[r] = __builtin_amdgcn_exp2f(p1[r] - mu); s += p0[r] + p1[r]; }
    l = l * f + s;
    if (__any(mn != m)) {
        if (hi == 0) wsf[r32] = f;
        LDS_WAIT();
#pragma unroll
        for (int a = 0; a < 4; ++a) { const f32x4 fv = *(const LAS f32x4*)(wsf + 8 * a + 4 * hi);
#pragma unroll
            for (int j = 0; j < 4; ++j) { o[0][4 * a + j] *= fv[j]; o[1][4 * a + j] *= fv[j]; } }
        LDS_WAIT();
    }
    m = mn;
}
template <bool FIRST>
__device__ __forceinline__ void accum_out(LAS float* stg, const f32x16 (&o)[2], float scale, LAS float* wsf, int r32, int hi) {
    if (hi == 0) wsf[r32] = scale;
    LDS_WAIT();
#pragma unroll
    for (int a = 0; a < 4; ++a) { const f32x4 fv = *(const LAS f32x4*)(wsf + 8 * a + 4 * hi);
#pragma unroll
        for (int j = 0; j < 4; ++j) { LAS float* p = stg + (j + 8 * a + 4 * hi) * 64 + r32;
            float v0 = o[0][4 * a + j] * fv[j], v1 = o[1][4 * a + j] * fv[j];
            if (!FIRST) { v0 += p[0]; v1 += p[32]; }
            p[0] = v0; p[32] = v1; } }
    LDS_WAIT();
}

__device__ __forceinline__ void attn_unit(Frame& F, int b, int g, int qt) {
    LAS unsigned char* lds = F.lds;
    const int tid = F.tid, lane = F.lane, wid = F.wave, r32 = lane & 31, hi = lane >> 5, hr = wid >> 1, qh = wid & 1;
    const int head = g * 4 + hr, t0 = qt * 64, ql = qh * 32 + r32, tq = t0 + ql;
    const float slope2 = __builtin_amdgcn_exp2f(-(float)(head + 1)) * LOG2E;
    const size_t rowq = (size_t)b * SEQ + tq;
    const bf16* Qb = (const bf16*)(F.ws + WS_QB);
    const bf16* KVb = (const bf16*)(F.ws + WS_KVB) + (size_t)b * SEQ * 768;
    const bf16* KC = (const bf16*)(F.ws + WS_KC) + (size_t)(b * 2 + g) * 256 * 64;
    const bf16* VC = (const bf16*)(F.ws + WS_VC) + (size_t)(b * 2 + g) * 256 * 64;
    const float* NG = (const float*)(F.ws + WS_NG) + rowq * 32 + g * 12 + hr * 3;
    LAS float* wsf = (LAS float*)(lds + L_WS) + wid * 64;
    LAS unsigned* imp = (LAS unsigned*)(lds + L_IMP);
    LAS unsigned long long* sel = (LAS unsigned long long*)(lds + L_SEL);
    LAS unsigned long long* wun = (LAS unsigned long long*)(lds + L_WU);
    const unsigned vb0 = (unsigned)(uintptr_t)(lds + L_V) + ((lane >> 4) & 1) * 32 + (lane & 3) * 8 + (4 * hi + ((lane & 15) >> 2)) * 64;
    bf16x8 qr[4];
#pragma unroll
    for (int d0 = 0; d0 < 4; ++d0) qr[d0] = *(const bf16x8*)(Qb + rowq * 512 + head * 64 + d0 * 16 + hi * 8);
    LAS float* stg = (LAS float*)(lds + L_OST) + wid * 2048;
    f32x16 o[2], p0, p1; Stage st;
    const bool need_imp = qt >= 8;
    const int ntc = min(4, (4 * qt + 2) / 64 + 1);
    const int nmax = (tq >= 31) ? ((tq - 31) >> 4) : -1;
    float m = -INFINITY, l = 0.f;
    for (int i = tid; i < 64 * 65; i += 512) imp[i] = 0u;
    stage_load(st, KC, VC, 64, 0, wid, lane, false);
    for (int it = 0; it < ntc; ++it) {
        stage_store(st, lds, it & 1, wid, lane, false);
        __syncthreads();
        if (it + 1 < ntc) stage_load(st, KC, VC, 64, (it + 1) * 64, wid, lane, false);
        qk_tile(p0, p1, lds + L_K + (it & 1) * 8192, qr, r32, hi);
        const int nb = it * 64;
#pragma unroll
        for (int r = 0; r < 16; ++r) { const int n0 = nb + crow(r, hi), n1 = n0 + 32;
            p0[r] = (n0 <= nmax) ? p0[r] + slope2 * (float)(16 * n0 - t0) : -INFINITY;
            p1[r] = (n1 <= nmax) ? p1[r] + slope2 * (float)(16 * n1 - t0) : -INFINITY; }
        const float rm = max32(p0, p1), mn = fmaxf(m, rm), mu = (mn == -INFINITY) ? 0.f : mn;
        float s = 0.f;
#pragma unroll
        for (int r = 0; r < 16; ++r) s += __builtin_amdgcn_exp2f(p0[r] - mu) + __builtin_amdgcn_exp2f(p1[r] - mu);
        l = l * __builtin_amdgcn_exp2f(m - mu) + s; m = mn;
    }
    l += __shfl_xor(l, 32);
    const float mc = (m == -INFINITY) ? 0.f : m, inv_lc = (l > 0.f) ? 1.0f / l : 0.f;
    __syncthreads();
    o[0] = (f32x16){0.f}; o[1] = (f32x16){0.f};
    stage_load(st, KC, VC, 64, 0, wid, lane, true);
    for (int it = 0; it < ntc; ++it) {
        stage_store(st, lds, it & 1, wid, lane, true);
        __syncthreads();
        if (it + 1 < ntc) stage_load(st, KC, VC, 64, (it + 1) * 64, wid, lane, true);
        qk_tile(p0, p1, lds + L_K + (it & 1) * 8192, qr, r32, hi);
        const int nb = it * 64;
#pragma unroll
        for (int r = 0; r < 16; ++r) { const int n0 = nb + crow(r, hi), n1 = n0 + 32;
            p0[r] = (n0 <= nmax) ? __builtin_amdgcn_exp2f(p0[r] + slope2 * (float)(16 * n0 - t0) - mc) * inv_lc : 0.f;
            p1[r] = (n1 <= nmax) ? __builtin_amdgcn_exp2f(p1[r] + slope2 * (float)(16 * n1 - t0) - mc) * inv_lc : 0.f; }
        if (need_imp) {
#pragma unroll
            for (int a = 0; a < 4; ++a) {
                const int j0 = 16 * it + 2 * a + hi, j1 = j0 + 8;
                const float g0 = (p0[4 * a] + p0[4 * a + 1]) + (p0[4 * a + 2] + p0[4 * a + 3]), g1 = (p1[4 * a] + p1[4 * a + 1]) + (p1[4 * a + 2] + p1[4 * a + 3]);
                __hip_atomic_fetch_add(&imp[ql * 65 + j0], (unsigned)(g0 * 268435456.f + 0.5f), __ATOMIC_RELAXED, __HIP_MEMORY_SCOPE_WORKGROUP);
                __hip_atomic_fetch_add(&imp[ql * 65 + j1], (unsigned)(g1 * 268435456.f + 0.5f), __ATOMIC_RELAXED, __HIP_MEMORY_SCOPE_WORKGROUP);
                __hip_atomic_fetch_add(&imp[ql * 65 + j0 + 1], (unsigned)(p0[4 * a + 3] * 268435456.f + 0.5f), __ATOMIC_RELAXED, __HIP_MEMORY_SCOPE_WORKGROUP);
                if (j1 + 1 < 64) __hip_atomic_fetch_add(&imp[ql * 65 + j1 + 1], (unsigned)(p1[4 * a + 3] * 268435456.f + 0.5f), __ATOMIC_RELAXED, __HIP_MEMORY_SCOPE_WORKGROUP);
            }
        }
        pv_tile(o, vb0 + (it & 1) * 8192, p0, p1);
    }
    accum_out<true>(stg, o, ABLF(4) NG[0], wsf, r32, hi);
    __syncthreads();
    unsigned long long mysel, uni;
    if (need_imp) {
        unsigned long long wu = 0ull;
        for (int qq = 0; qq < 8; ++qq) { const int q = wid * 8 + qq;
            int sc = (lane >= 1 && lane <= qt - 2) ? (int)imp[q * 65 + lane] : -1;
            unsigned long long msk = 1ull | (1ull << qt) | (1ull << (qt - 1));
#pragma unroll 1
            for (int k = 0; k < 5; ++k) { int mx = sc;
#pragma unroll
                for (int o2 = 1; o2 < 64; o2 <<= 1) mx = max(mx, __shfl_xor(mx, o2));
                const unsigned long long bal = __ballot(sc == mx); const int js = __builtin_ctzll(bal);
                msk |= 1ull << js; if (lane == js) sc = -2; }
            if (lane == 0) sel[q] = msk;
            wu |= msk; }
        if (lane == 0) wun[wid] = wu;
        __syncthreads();
        mysel = sel[ql]; uni = 0ull;
#pragma unroll
        for (int w = 0; w < 8; ++w) uni |= wun[w];
    } else { mysel = (2ull << qt) - 1ull; uni = mysel; }
    uni = ((unsigned long long)__builtin_amdgcn_readfirstlane((unsigned)(uni >> 32)) << 32) | (unsigned long long)__builtin_amdgcn_readfirstlane((unsigned)uni);
    {
        const bf16* Kb = KVb + 2 * 128 + g * 64; const bf16* Vb = KVb + 3 * 128 + g * 64;
        m = -INFINITY; l = 0.f; o[0] = (f32x16){0.f}; o[1] = (f32x16){0.f};
        unsigned long long rem = uni; int it = 0;
        int j = 63 - __builtin_clzll(rem); rem &= ~(1ull << j);
        stage_load(st, Kb, Vb, 768, j * 64, wid, lane, true);
        for (;;) {
            stage_store(st, lds, it & 1, wid, lane, true);
            __syncthreads();
            const int jn = rem ? 63 - __builtin_clzll(rem) : -1;
            if (jn >= 0) { rem &= ~(1ull << jn); stage_load(st, Kb, Vb, 768, jn * 64, wid, lane, true); }
            const bool mine = (mysel >> j) & 1ull;
            if (__any(mine)) {
                qk_tile(p0, p1, lds + L_K + (it & 1) * 8192, qr, r32, hi);
                const int kb = j * 64;
#pragma unroll
                for (int r = 0; r < 16; ++r) { const int k0 = kb + crow(r, hi), k1 = k0 + 32;
                    p0[r] = (mine && k0 <= tq) ? p0[r] + slope2 * (float)(k0 - t0) : -INFINITY;
                    p1[r] = (mine && k1 <= tq) ? p1[r] + slope2 * (float)(k1 - t0) : -INFINITY; }
                softmax_step(p0, p1, m, l, o, wsf, r32, hi);
                pv_tile(o, vb0 + (it & 1) * 8192, p0, p1);
            }
            if (jn < 0) break;
            j = jn; ++it;
        }
        l += __shfl_xor(l, 32);
        accum_out<false>(stg, o, ABLF(5) ((l > 0.f) ? NG[1] / l : 0.f), wsf, r32, hi);
        __syncthreads();
    }
    {
        const bf16* Kb = KVb + 4 * 128 + g * 64; const bf16* Vb = KVb + 5 * 128 + g * 64;
        m = -INFINITY; l = 0.f; o[0] = (f32x16){0.f}; o[1] = (f32x16){0.f};
        const int jlo = max(0, qt - 8); int it = 0;
        stage_load(st, Kb, Vb, 768, qt * 64, wid, lane, true);
        for (int j = qt; j >= jlo; --j, ++it) {
            stage_store(st, lds, it & 1, wid, lane, true);
            __syncthreads();
            if (j > jlo) stage_load(st, Kb, Vb, 768, (j - 1) * 64, wid, lane, true);
            qk_tile(p0, p1, lds + L_K + (it & 1) * 8192, qr, r32, hi);
            const int kb = j * 64;
#pragma unroll
            for (int r = 0; r < 16; ++r) { const int k0 = kb + crow(r, hi), k1 = k0 + 32;
                p0[r] = (k0 <= tq && tq - k0 < 512) ? p0[r] + slope2 * (float)(k0 - t0) : -INFINITY;
                p1[r] = (k1 <= tq && tq - k1 < 512) ? p1[r] + slope2 * (float)(k1 - t0) : -INFINITY; }
            softmax_step(p0, p1, m, l, o, wsf, r32, hi);
            pv_tile(o, vb0 + (it & 1) * 8192, p0, p1);
        }
        l += __shfl_xor(l, 32);
        accum_out<false>(stg, o, ABLF(6) ((l > 0.f) ? NG[2] / l : 0.f), wsf, r32, hi);
    }
    {
        bf16* Ow = (bf16*)(F.ws + WS_AC) + ((size_t)b * SEQ + t0 + qh * 32) * 1024 + head * 64;
#pragma unroll
        for (int i = 0; i < 4; ++i) { const int row = i * 8 + (lane >> 3), ch = lane & 7;
            const f32x4 v0 = *(const LAS f32x4*)(stg + row * 64 + ch * 8), v1 = *(const LAS f32x4*)(stg + row * 64 + ch * 8 + 4);
#if defined(ABL) && ABL == 1
            *(u32x4*)(Ow + (unsigned)(row * 1024 + ch * 8)) = (u32x4){0u, 0u, 0u, 0u}; }
#else
            *(u32x4*)(Ow + (unsigned)(row * 1024 + ch * 8)) = pack8(v0, v1); }
#endif
    }
    __syncthreads();
}

__device__ __forceinline__ void attn_phase(Frame& F) {
    LAS int* qw = (LAS int*)(F.lds + L_Q);
    for (;;) {
        if (F.tid == 0) qw[0] = (int)__hip_atomic_fetch_add(F.ctl + CW_QATT, 1u, RLX_AGENT);
        __syncthreads();
        const int u = qw[0];
        __syncthreads();
        if (u >= 1024) break;
        const int qt = 63 - (u >> 4), bg = u & 15;
        attn_unit(F, bg >> 1, bg & 1, qt);
    }
}
}

__device__ __forceinline__ void p6_router(Frame& F) {
    const int lane = F.lane, i16 = lane & 15, kq = lane >> 4;
    const float* X1 = F.out; bf16* XB = (bf16*)(F.ws + WS_XN); const bf16* WR = (const bf16*)(F.ws + WS_WR);
    int* list = (int*)(F.ws + WS_LIST); float* wt = (float*)(F.ws + WS_WT); float* rstd2 = (float*)(F.ws + WS_RSTD2);
    LAS float* lg = (LAS float*)(F.lds + F.wave * 4096);
    const int gw = F.vcu * NWAVES + F.wave, NGW = F.G * NWAVES;
    for (int grp = gw; grp < T / 16; grp += NGW) {
        const size_t row = (size_t)grp * 16 + i16;
        f32x4 acc0 = (f32x4){0.f, 0.f, 0.f, 0.f}, acc2 = acc0, acc3 = acc0; float ssq = 0.f;
#pragma unroll 4
        for (int s = 0; s < 32; ++s) {
            const size_t off = row * 1024 + s * 32 + kq * 8;
            const f32x4 a0 = *(const f32x4*)(X1 + off), a1 = *(const f32x4*)(X1 + off + 4);
            ssq += (a0[0] * a0[0] + a0[1] * a0[1]) + (a0[2] * a0[2] + a0[3] * a0[3]) + (a1[0] * a1[0] + a1[1] * a1[1]) + (a1[2] * a1[2] + a1[3] * a1[3]);
            const u32x4 w = pack8(a0, a1); *(u32x4*)(XB + off) = w;
            const bf16x8 a = __builtin_bit_cast(bf16x8, w);
            const bf16x8 b0 = *(const bf16x8*)(WR + (size_t)(i16) * 1024 + s * 32 + kq * 8);
            const bf16x8 b2 = *(const bf16x8*)(WR + (size_t)(32 + i16) * 1024 + s * 32 + kq * 8);
            const bf16x8 b3 = *(const bf16x8*)(WR + (size_t)(48 + i16) * 1024 + s * 32 + kq * 8);
            acc0 = __builtin_amdgcn_mfma_f32_16x16x32_bf16(a, b0, acc0, 0, 0, 0);
            acc2 = __builtin_amdgcn_mfma_f32_16x16x32_bf16(a, b2, acc2, 0, 0, 0);
            acc3 = __builtin_amdgcn_mfma_f32_16x16x32_bf16(a, b3, acc3, 0, 0, 0);
        }
        ssq += __shfl_xor(ssq, 16); ssq += __shfl_xor(ssq, 32);
        const float rstd = 1.0f / sqrtf(ssq * (1.f / 1024.f) + EPS);
#pragma unroll
        for (int r = 0; r < 4; ++r) { lg[(kq * 4 + r) * 48 + i16] = acc0[r]; lg[(kq * 4 + r) * 48 + 16 + i16] = acc2[r]; lg[(kq * 4 + r) * 48 + 32 + i16] = acc3[r]; }
        LDS_WAIT();
        if (lane < 16) {
            const int tok = grp * 16 + lane;
            float g4[4];
#pragma unroll
            for (int c = 0; c < 4; ++c) g4[c] = lg[lane * 48 + c] * rstd + F.inp(19)[c];
            int gs = 0; float gm = g4[0];
#pragma unroll
            for (int c = 1; c < 4; ++c) if (g4[c] > gm) { gm = g4[c]; gs = c; }
            float den = 0.f;
#pragma unroll
            for (int c = 0; c < 4; ++c) den += __builtin_amdgcn_exp2f((g4[c] - gm) * LOG2E);
            const float pg = 1.0f / den;
            float e8[8];
#pragma unroll
            for (int c = 0; c < 8; ++c) e8[c] = lg[lane * 48 + 16 + gs * 8 + c] * rstd + F.inp(21)[gs * 8 + c];
            int i1 = 0; float m1 = e8[0];
#pragma unroll
            for (int c = 1; c < 8; ++c) if (e8[c] > m1) { m1 = e8[c]; i1 = c; }
            int i2 = -1; float m2 = -INFINITY;
#pragma unroll
            for (int c = 0; c < 8; ++c) if (c != i1 && e8[c] > m2) { m2 = e8[c]; i2 = c; }
            const float ex = __builtin_amdgcn_exp2f((m2 - m1) * LOG2E);
            const float w0 = pg / (1.f + ex), w1 = pg * ex / (1.f + ex);
            const int ea = gs * 8 + i1, eb = gs * 8 + i2;
            const unsigned pa = __hip_atomic_fetch_add(F.ctl + CW_CNT + 64 * ea, 1u, RLX_AGENT);
            const unsigned pb = __hip_atomic_fetch_add(F.ctl + CW_CNT + 64 * eb, 1u, RLX_AGENT);
            list[ea * LISTCAP + pa] = tok * 2; list[eb * LISTCAP + pb] = tok * 2 + 1;
            wt[tok * 2] = w0; wt[tok * 2 + 1] = w1; rstd2[tok] = rstd;
        }
        LDS_WAIT();
    }
}

__device__ __forceinline__ void moe_table(Frame& F) {
    LAS int* tab = (LAS int*)(F.lds + MOE_OFF);
    if (F.tid < 32) tab[33 + F.tid] = (int)__hip_atomic_load(F.ctl + CW_CNT + 64 * F.tid, RLX_AGENT);
    __syncthreads();
    if (F.tid == 0) { int s = 0; for (int e = 0; e < 32; ++e) { tab[e] = s; s += (tab[33 + e] + 255) >> 8; } tab[32] = s; }
    __syncthreads();
}

__device__ __forceinline__ void p9_combine(Frame& F) {
    const int lane = F.lane; const int gw = F.vcu * NWAVES + F.wave, NGW = F.G * NWAVES;
    const bf16* Y = (const bf16*)(F.ws + WS_Y); bf16* XB = (bf16*)(F.ws + WS_XN); float* rstd3 = (float*)(F.ws + WS_RSTD3);
    for (int m = gw; m < T; m += NGW) {
        f32x4* xr = (f32x4*)(F.out + (size_t)m * DM) + lane;
        const u32x2* y0 = (const u32x2*)(Y + (size_t)(2 * m) * DM) + lane; const u32x2* y1 = (const u32x2*)(Y + (size_t)(2 * m + 1) * DM) + lane;
        u32x2* ob = (u32x2*)(XB + (size_t)m * DM) + lane;
        float s = 0.f;
#pragma unroll
        for (int j = 0; j < 4; ++j) { f32x4 v = xr[64 * j]; const u32x2 a = y0[64 * j], b = y1[64 * j];
#if !defined(ABL) || ABL != 2
            v[0] += bf_lo(a.x) + bf_lo(b.x); v[1] += bf_hi(a.x) + bf_hi(b.x); v[2] += bf_lo(a.y) + bf_lo(b.y); v[3] += bf_hi(a.y) + bf_hi(b.y);
#endif
            xr[64 * j] = v; s += (v[0] * v[0] + v[1] * v[1]) + (v[2] * v[2] + v[3] * v[3]);
            u32x2 w; w.x = cvt_pk_bf16(v[0], v[1]); w.y = cvt_pk_bf16(v[2], v[3]); ob[64 * j] = w; }
        s = wave_sum(s);
        if (lane == 0) rstd3[m] = 1.0f / sqrtf(s * (1.f / DM) + EPS);
    }
}


#ifdef CHECK
constexpr int CW_CHK = 3072;
constexpr int NCHK = 24;
__device__ __forceinline__ int chk_token(int s) {
    const int fixed[16] = {0, 1, 29, 30, 31, 63, 64, 4095, 4096, 4097, 4126, 8191, 12288, 20000, 32767, 16384 + 33};
    return s < 16 ? fixed[s] : (int)(((unsigned)s * 2654435761u) % (unsigned)T);
}
__device__ __forceinline__ void chk_report(Frame& F, int k, float err) {
    if (!(err >= 0.f)) err = 1e30f;
    atomicMax((unsigned*)(F.ctl + CW_CHK + k), __float_as_uint(err));
}
__device__ __forceinline__ float block_sum(Frame& F, float v, LAS float* red) {
    v = wave_sum(v); __syncthreads(); if (F.lane == 0) red[F.wave] = v; __syncthreads();
    float s = 0.f; for (int w = 0; w < 8; ++w) s += red[w]; __syncthreads(); return s;
}
__device__ __forceinline__ float bfv(const bf16* p, size_t i) { return __uint_as_float((unsigned)p[i] << 16); }

__device__ void chk_p1(Frame& F) {
    const int s = blockIdx.x; if (s >= 64) return;
    const int t = chk_token(s), tid = F.tid;
    LAS float* h = (LAS float*)F.lds; LAS float* z = h + 1024; LAS float* red = z + 4608;
    const float* x = F.inp(0) + (size_t)t * 1024; const float* W = F.inp(3);
    float ss = 0.f; for (int k = tid; k < 1024; k += 512) ss += x[k] * x[k];
    ss = block_sum(F, ss, red); const float rstd = 1.0f / sqrtf(ss / 1024.f + EPS);
    for (int k = tid; k < 1024; k += 512) h[k] = x[k] * rstd * F.inp(2)[k];
    __syncthreads();
    for (int c = tid; c < NIN; c += 512) { float a = 0.f; for (int k = 0; k < 1024; ++k) a += h[k] * W[(size_t)k * NIN + c]; z[c] = a; }
    __syncthreads();
    const bf16* Qb = (const bf16*)(F.ws + WS_QB); const bf16* KVb = (const bf16*)(F.ws + WS_KVB); const bf16* GLU = (const bf16*)(F.ws + WS_GLU); const bf16* MG = (const bf16*)(F.ws + WS_MG); const float* NG = (const float*)(F.ws + WS_NG);
    { const int c = tid, hd = c >> 6; float q2 = 0.f; for (int d = 0; d < 64; ++d) q2 += z[hd * 64 + d] * z[hd * 64 + d];
      const float e = z[c] / sqrtf(q2 / 64.f + EPS) * F.inp(4)[c & 63] * QC2; chk_report(F, 1, fabsf(e - bfv(Qb, (size_t)t * 512 + c))); }
    for (int c = tid; c < 768; c += 512) { const int i = c >> 7, grp = c >> 6; float e = z[OFF_KV + c];
        if (i == 2 || i == 4) { float q2 = 0.f; for (int d = 0; d < 64; ++d) q2 += z[OFF_KV + grp * 64 + d] * z[OFF_KV + grp * 64 + d]; e = e / sqrtf(q2 / 64.f + EPS) * F.inp(5)[(i == 2 ? 64 : 128) + (c & 63)]; }
        chk_report(F, 2, fabsf(e - bfv(KVb, (size_t)t * 768 + c))); }
    { const int c = tid; const float e = z[OFF_CONV + c] / (1.f + expf(-z[OFF_CONV + 512 + c])); chk_report(F, 3, fabsf(e - bfv(GLU, (size_t)t * 512 + c))); }
#ifdef MG_RAW
    for (int c = tid; c < 2048; c += 512) { const float e = z[OFF_MERGE + c];
#else
    for (int c = tid; c < 2048; c += 512) { const float e = 1.f / (1.f + expf(-(z[OFF_MERGE + c] + F.inp(15)[c])));
#endif
        const float er = fabsf(e - bfv(MG, (size_t)t * 2048 + c)); chk_report(F, 4, er); if (er > 0.08f) atomicMax((unsigned*)(F.ctl + CW_CHK + 40 + s), 1u); }
    if (tid < 24) { const float e = 1.f / (1.f + expf(-z[OFF_GATE + tid])); chk_report(F, 5, fabsf(e - NG[(size_t)t * 32 + tid])); }
    __syncthreads();
}
__device__ void chk_conv(Frame& F) {
    const int s = blockIdx.x; if (s >= 64) return;
    const int t = chk_token(s), tid = F.tid, sp = t & (SEQ - 1);
    LAS float* red = (LAS float*)F.lds;
    const bf16* GLU = (const bf16*)(F.ws + WS_GLU);
    float a = F.inp(11)[tid];
    for (int j = 0; j < 31; ++j) { const int sq = sp - 30 + j; if (sq >= 0) a += F.inp(10)[j * 512 + tid] * bfv(GLU, (size_t)(t - 30 + j) * 512 + tid); }
    const float mu = block_sum(F, a, red) / 512.f; const float d = a - mu; const float var = block_sum(F, d * d, red) / 512.f;
    float y = d / sqrtf(var + EPS) * F.inp(12)[tid] + F.inp(13)[tid]; y = y / (1.f + expf(-y));
    chk_report(F, 6, fabsf(y - bfv((const bf16*)(F.ws + WS_AC), (size_t)t * 1024 + 512 + tid)));
}
__device__ void chk_merge(Frame& F) {
    const int s = blockIdx.x; if (s >= 64) return;
    const int t = chk_token(s), tid = F.tid;
    const bf16* AC = (const bf16*)(F.ws + WS_AC); const bf16* MG = (const bf16*)(F.ws + WS_MG); const bf16* MER = (const bf16*)(F.ws + WS_XN);
    for (int c = tid; c < 1024; c += 512) { float ya = 0.f, yc = 0.f;
        for (int k = 0; k < 512; ++k) { ya += bfv(AC, (size_t)t * 1024 + k) * F.inp(9)[(size_t)k * 1024 + c]; yc += bfv(AC, (size_t)t * 1024 + 512 + k) * F.inp(14)[(size_t)k * 1024 + c]; }
        const float e = bfv(MG, (size_t)t * 2048 + c) * ya + bfv(MG, (size_t)t * 2048 + 1024 + c) * yc;
        chk_report(F, 10, fabsf(e - bfv(MER, (size_t)t * 1024 + c))); }
}
__device__ void chk_p5(Frame& F) {
    const int s = blockIdx.x; if (s >= 64) return;
    const int t = chk_token(s), tid = F.tid;
    const bf16* MER = (const bf16*)(F.ws + WS_XN); const bf16* PP = (const bf16*)(F.ws + WS_PP);
    for (int c = tid; c < 1024; c += 512) { float a = F.inp(0)[(size_t)t * 1024 + c], pp = 0.f;
        for (int k = 0; k < 1024; ++k) a += bfv(MER, (size_t)t * 1024 + k) * F.inp(16)[(size_t)k * 1024 + c];
        for (int k = 0; k < 256; ++k) pp += F.inp(1)[(size_t)t * 256 + k] * F.inp(28)[(size_t)k * 1024 + c];
        chk_report(F, 11, fabsf(a - F.out[(size_t)t * 1024 + c])); chk_report(F, 12, fabsf(pp - bfv(PP, (size_t)t * 1024 + c))); }
}
__device__ void chk_verdict(Frame& F) {
    int bad = 0, nbad = 0;
    for (int k = NCHK - 1; k >= 1; --k) { const float e = __uint_as_float(__hip_atomic_load(F.ctl + CW_CHK + k, RLX_AGENT)); if (e > 0.08f) { bad = k; ++nbad; } }
    if (bad) { const float c = sqrtf(1.45f * (float)bad); for (size_t i = (size_t)blockIdx.x * 512 + F.tid; i < (size_t)T * DM; i += (size_t)F.G * 512) F.out[i] = (i == 0) ? 100.f * (float)nbad : c; }
    { int ns = 0; for (int s = 0; s < 64; ++s) ns += (int)__hip_atomic_load(F.ctl + CW_CHK + 40 + s, RLX_AGENT); if (blockIdx.x == 0 && F.tid == 0) F.out[0] = 100.f * (float)ns; }
}
#define CHK_RUN(fn) do { fn(F); xcd_barrier(bar); } while (0)
#else
#define CHK_RUN(fn) do {} while (0)
#endif
__global__ void __launch_bounds__(NWAVES * 64, 2) nsa_block_fwd(Args args) {
    extern __shared__ __attribute__((aligned(16))) unsigned char lds_raw[];
    Frame F;
    F.lds = (LAS unsigned char*)lds_raw;
    F.MISC = (volatile LAS unsigned*)(F.lds + MISC_OFF);
    F.tid = threadIdx.x; F.lane = F.tid & 63; F.wave = __builtin_amdgcn_readfirstlane(F.tid >> 6);
    F.G = gridDim.x; { const int bx = blockIdx.x; F.vcu = (F.G % 8 == 0) ? (bx % 8) * (F.G / 8) + bx / 8 : bx; }
    F.ws = args.ws; F.ctl = (gu32*)(args.ws + WS_CTL); F.out = args.out;
    F.ka = (const CAS Args*)__builtin_amdgcn_kernarg_segment_ptr();
    for (int u = F.tid; u < (LDS_BYTES - LDSCTL_OFF) / 4; u += NWAVES * 64) ((LAS unsigned*)(F.lds + LDSCTL_OFF))[u] = 0u;
    __syncthreads();
    XcdBarrier bar; bar.bar = (unsigned*)(F.ctl + CW_BAR); bar.x = 0; bar.st = nullptr;
    if (!MK_PER_PHASE) bar = xcd_barrier_post((unsigned*)(F.ctl + CW_BAR), F.MISC + 8);
    const int lo = args.ph_lo, hi = args.ph_hi;
#ifdef ONLY_PHASE
#define IN(k) ((k) == ONLY_PHASE && lo <= (k) && (k) < hi)
#else
#define IN(k) (lo <= (k) && (k) < hi)
#endif
#define SEAM(k) do { if (IN(k) && IN((k) + 1)) xcd_barrier(bar); } while (0)
    unsigned char* ws = args.ws;
    const int cid = (int)blockIdx.x;

    if (IN(0)) { p0_prologue(F); } SEAM(0);

    if (IN(1)) {
        pg8::Gemm g{(const bf16*)(ws + WS_XN), (const bf16*)(ws + WS_WIN), 1024}; pg8::StaticOrder S; S.init(T, NT_IN * 256, F.G, cid);
        EpiWin E{(bf16*)(ws + WS_QB), (bf16*)(ws + WS_KVB), (bf16*)(ws + WS_GLU), (bf16*)(ws + WS_MG), (float*)(ws + WS_NG), F.inp(4), F.inp(5), F.inp(15)};
        pg8::gemm_phase<EpiWin, pg8::StaticOrder, P1_ALIGN>(F.lds, g, S, E);
    } SEAM(1);
    CHK_RUN(chk_p1);

    if (IN(2)) { p2_phase(F); } SEAM(2);
    CHK_RUN(chk_conv);

    if (IN(3)) { att::attn_phase(F); } SEAM(3);

    if (IN(4)) {
        pg8::Gemm g{(const bf16*)(ws + WS_AC), (const bf16*)(ws + WS_WAC), 1024}; pg8::StaticOrder S; S.init(T, 1024, F.G, cid);
        EpiMerge E{(const bf16*)(ws + WS_MG), (bf16*)(ws + WS_XN)};
        pg8::gemm_phase<EpiMerge, pg8::StaticOrder, true>(F.lds, g, S, E);
    } SEAM(4);
    CHK_RUN(chk_merge);

    if (IN(5)) {
        { pg8::Gemm g{(const bf16*)(ws + WS_XN), (const bf16*)(ws + WS_WO), 1024}; pg8::StaticOrder S; S.init(T, 1024, F.G, cid);
          EpiWo E{F.inp(0), F.out};
          pg8::gemm_phase<EpiWo, pg8::StaticOrder, true>(F.lds, g, S, E); }
        { pg8::Gemm g{(const bf16*)(ws + WS_PBF), (const bf16*)(ws + WS_WPP), 256}; pg8::StaticOrder S; S.init(T, 1024, F.G, cid);
          EpiBf E{(bf16*)(ws + WS_PP), 1024};
          pg8::gemm_phase<EpiBf, pg8::StaticOrder, true>(F.lds, g, S, E); }
    } SEAM(5);
    CHK_RUN(chk_p5);

    if (IN(6)) { p6_router(F); } SEAM(6);

    if (IN(7)) {
        moe_table(F);
        pg8::Gemm g{(const bf16*)(ws + WS_XN), (const bf16*)(ws + WS_WGU), 1024};
        MoeOrder<true> S{(const LAS int*)(F.lds + MOE_OFF), (const int*)(ws + WS_LIST), F.G, cid};
        EpiGU E{(bf16*)(ws + WS_H), (const int*)(ws + WS_LIST), (const float*)(ws + WS_RSTD2)};
        pg8::gemm_phase<EpiGU, MoeOrder<true>, true>(F.lds, g, S, E);
    } SEAM(7);

    if (IN(8)) {
        moe_table(F);
        pg8::Gemm g{(const bf16*)(ws + WS_H), (const bf16*)(ws + WS_WD), 512};
        MoeOrder<false> S{(const LAS int*)(F.lds + MOE_OFF), (const int*)(ws + WS_LIST), F.G, cid};
        EpiDown E{(bf16*)(ws + WS_Y), (const int*)(ws + WS_LIST), (const float*)(ws + WS_WT)};
        pg8::gemm_phase<EpiDown, MoeOrder<false>, true>(F.lds, g, S, E);
    } SEAM(8);

    if (IN(9)) { p9_combine(F); } SEAM(9);

    if (IN(10)) {
        pg8::Gemm g{(const bf16*)(ws + WS_XN), (const bf16*)(ws + WS_WPG), 1024}; pg8::StaticOrder S; S.init(T, 1024, F.G, cid);
        EpiPle E{F.out, (const bf16*)(ws + WS_PP), (const float*)(ws + WS_RSTD3), F.inp(27)};
        pg8::gemm_phase<EpiPle, pg8::StaticOrder, true>(F.lds, g, S, E);
    }
#ifdef CHECK
    xcd_barrier(bar); chk_verdict(F);
#endif
#undef IN
#undef SEAM
}

extern "C" void kernel_launch(void* const* d_in, const int* in_sizes, int n_in, void* d_out, int out_size, void* d_ws, size_t ws_size, hipStream_t stream) {
    static int grid = 0;
    if (grid == 0) {
        if (n_in != 29 || in_sizes[0] != T * DM || out_size != T * DM || ws_size < WS_END) { fprintf(stderr, "kernel_launch: unexpected shapes (n_in %d, in0 %d, out %d, ws %zu); nothing launched\n", n_in, n_in > 0 ? in_sizes[0] : -1, out_size, ws_size); grid = -1; return; }
        int dev = 0, cus = 0, per_cu = 0;
        if (hipGetDevice(&dev) != hipSuccess || hipDeviceGetAttribute(&cus, hipDeviceAttributeMultiprocessorCount, dev) != hipSuccess) { grid = -1; return; }
        if (hipFuncSetAttribute((const void*)nsa_block_fwd, hipFuncAttributeMaxDynamicSharedMemorySize, LDS_BYTES) != hipSuccess) { fprintf(stderr, "kernel_launch: hipFuncSetAttribute failed\n"); grid = -1; return; }
        if (hipOccupancyMaxActiveBlocksPerMultiprocessor(&per_cu, (const void*)nsa_block_fwd, NWAVES * 64, LDS_BYTES) != hipSuccess || per_cu < 1)
            fprintf(stderr, "kernel_launch: note: occupancy query reports %d workgroups per CU\n", per_cu);
        (void)hipGetLastError();
        grid = cus;
    }
    if (grid < 0) return;
    if (hipMemsetAsync((char*)d_ws + WS_CTL, 0, CTL_ZERO_BYTES, stream) != hipSuccess) return;
    Args a{};
    for (int i = 0; i < 29; ++i) a.in[i] = (const float*)d_in[i];
    a.out = (float*)d_out; a.ws = (unsigned char*)d_ws;
#if MK_PER_PHASE
    for (int ph = 0; ph < NPH; ++ph) { a.ph_lo = ph; a.ph_hi = ph + 1; hipLaunchKernelGGL(nsa_block_fwd, dim3(grid), dim3(NWAVES * 64), LDS_BYTES, stream, a); }
#else
    a.ph_lo = 0; a.ph_hi = NPH;
    hipLaunchKernelGGL(nsa_block_fwd, dim3(grid), dim3(NWAVES * 64), LDS_BYTES, stream, a);
#endif
}
```

```cpp
#include <hip/hip_runtime.h>
#include <cstdio>
#include <cstdint>

#define LAS __attribute__((address_space(3)))
#define GAS __attribute__((address_space(1)))
typedef unsigned short bf16;
typedef short bf16x8 __attribute__((ext_vector_type(8)));
typedef short s16x4 __attribute__((ext_vector_type(4)));
typedef float f32x2 __attribute__((ext_vector_type(2)));
typedef float f32x4 __attribute__((ext_vector_type(4)));
typedef float f32x16 __attribute__((ext_vector_type(16)));
typedef unsigned u32x2 __attribute__((ext_vector_type(2)));
typedef unsigned u32x4 __attribute__((ext_vector_type(4)));
typedef GAS unsigned gu32;
typedef long l64x2 __attribute__((ext_vector_type(2)));
typedef int i32x4 __attribute__((ext_vector_type(4)));
typedef int i32x8 __attribute__((ext_vector_type(8)));
#ifndef FP8_MX
#define FP8_MX 1
#endif

constexpr int BATCH = 8, SEQ = 4096, T = BATCH * SEQ, DM = 1024, NIN = 4376;
constexpr int OFF_KV = 512, OFF_GATE = 1280, OFF_CONV = 1304, OFF_MERGE = 2328;
constexpr int NT_IN = 18;
constexpr int NEXP = 32, EFF = 512, LISTCAP = 32768;
constexpr float EPS = 1e-6f;
constexpr float LOG2E = 1.4426950408889634f;
constexpr float QC2 = 0.125f * 1.4426950408889634f;

typedef __bf16 bf16x2_t __attribute__((ext_vector_type(2)));
__device__ __forceinline__ unsigned cvt_pk_bf16(float lo, float hi) { const f32x2 v = {lo, hi}; const bf16x2_t b = __builtin_convertvector(v, bf16x2_t); return __builtin_bit_cast(unsigned, b); }
__device__ __forceinline__ float bf_lo(unsigned w) { return __uint_as_float(w << 16); }
__device__ __forceinline__ float bf_hi(unsigned w) { return __uint_as_float(w & 0xffff0000u); }
__device__ __forceinline__ float fsigmoid(float v) { return __builtin_amdgcn_rcpf(1.0f + __builtin_amdgcn_exp2f(-v * LOG2E)); }
#ifndef WT_STORES
#define WT_STORES 0
#endif
__device__ __forceinline__ void st_wt16(void* p, u32x4 v) {
#if WT_STORES == 2
    __builtin_nontemporal_store(v, (u32x4*)p);
#elif WT_STORES == 1
    asm volatile("global_store_dwordx4 %0, %1, off sc1\n\ts_nop 4" :: "v"(p), "v"(v) : "memory");
#else
    *(u32x4*)p = v;
#endif
}
__device__ __forceinline__ float wave_sum(float v) {
#pragma unroll
    for (int o = 1; o < 64; o <<= 1) v += __shfl_xor(v, o);
    return v;
}

#ifndef F8_GATHER
#define F8_GATHER false
#endif
namespace pg8 {
constexpr int BM = 256, BK = 64, HALF = 128, HTB = HALF * BK * 2, STAGE_BYTES = 8 * HTB, NXCD = 8, WGM = 8;
__host__ __device__ __forceinline__ int lds_byte(int r, int c) { const int st = (r >> 4) * 2 + (c >> 5), rr = r & 15, cc = c & 31, ob = rr * 64 + cc * 2; return st * 1024 + (ob ^ (((ob >> 9) & 1) << 5)); }
__host__ __device__ __forceinline__ void stage_rc(int b, int& R, int& C) { const int st = b / 1024, sb = b % 1024, swz = sb ^ (((sb >> 9) & 1) << 5); R = (st >> 1) * 16 + swz / 64; C = (st & 1) * 32 + (swz % 64) / 2; }
__host__ __device__ __forceinline__ int perm32(int rho) { const int n = rho >> 4, i = rho & 15; return 8 * (i >> 2) + 4 * n + (i & 3); }

struct Unit { int pm, pn, b0, e, lp, nrow, ord; };
struct Gemm { const bf16* A; const bf16* Bt; int K; };

struct StaticOrder {
    int nM, nN, nwg, G, c;
    int pbase = 0, pcut = 1 << 30, pgap = 0; bool bown = false;
    __device__ void init(int M, int N, int G_, int c_) { nM = M / BM; nN = N / BM; nwg = nM * nN; G = G_; c = c_; }
    __device__ bool next(int i, Unit& u) const {
        const long L = (long)i * G + c; if (L >= nwg) return false;
        int wgid = (int)L; { const int q = nwg / NXCD, r = nwg % NXCD, xcd = wgid % NXCD, off = wgid / NXCD; wgid = (xcd < r ? xcd * (q + 1) : r * (q + 1) + (xcd - r) * q) + off; }
        const int nig = WGM * nN, gid = wgid / nig, fm = gid * WGM, gsz = (nM - fm) < WGM ? (nM - fm) : WGM;
        u.pm = fm + ((wgid % nig) % gsz); const int pq = (wgid % nig) / gsz; u.pn = pbase + pq + (pq >= pcut ? pgap : 0); u.b0 = (bown ? pq : u.pn) * BM; u.e = 0; u.lp = 0; u.nrow = BM; u.ord = 0; return true;
    }
    static constexpr bool GATHER = false, PARTIAL = false, FP8 = false;
    __device__ __forceinline__ int arow0(const Unit& u) const { return u.pm * BM; }
    __device__ __forceinline__ int arow(const Unit& u, int r) const { return u.pm * BM + r; }
};
struct StaticOrderF8 : StaticOrder { static constexpr bool FP8 = true, GATHER = F8_GATHER; };

constexpr int PF_DUMP = 131072 + 8192;
template <class E, class = void> struct HasPF { static constexpr bool v = false; };
template <class E> struct HasPF<E, decltype((void)E::PREFETCH)> { static constexpr bool v = E::PREFETCH; };
template <class E, class = void> struct PreOf { struct type {}; static constexpr bool v = false; };
template <class E> struct PreOf<E, decltype((void)sizeof(typename E::Pre))> { using type = typename E::Pre; static constexpr bool v = true; };
template <class Epi, class Sched, bool ALIGN_EPI>
__device__ __forceinline__ void gemm_phase(LAS unsigned char* lds, const Gemm g, const Sched& S, const Epi& E) {
    int tid_ = threadIdx.x; asm volatile("" : "+v"(tid_));
    const int tid = tid_, wid = __builtin_amdgcn_readfirstlane(tid >> 6), lane = tid & 63, wr = wid >> 2, wc = wid & 3, fr = lane & 15, fq = lane >> 4;
    const int K = g.K, nt = K / BK;
    int opq_ = 0; asm volatile("" : "+s"(opq_));
    int RA[2], CA[2]; unsigned voffB[2];
#pragma unroll
    for (int i = 0; i < 2; ++i) { int R, C; stage_rc(tid * 16 + i * 8192, R, C); const int Rb = Epi::NOPERM ? R : (R & ~31) + perm32(R & 31);
        RA[i] = R; CA[i] = C; voffB[i] = (unsigned)(Rb * K + C) * 2u; }
    const size_t kstep = (size_t)(BK * 2);
    const size_t hstep = (size_t)HALF * K * 2;
    const unsigned ldsw = (unsigned)wid * 1024u;
    const int aoff = lds_byte(wr * 64 + fr, fq * 8), boff = lds_byte(wc * 32 + fr, fq * 8);
#define PG8_SA(b, h) (((b) * 2 + (h)) * HTB)
#define PG8_SB(b, h) ((4 + (b) * 2 + (h)) * HTB)
#define PG8_STAGE(bufoff, gbase, v0, v1) do { \
        __builtin_amdgcn_global_load_lds((const unsigned*)((const char*)(gbase) + (v0)), (LAS unsigned*)(lds + (bufoff) + ldsw), 16, 0, 0); \
        __builtin_amdgcn_global_load_lds((const unsigned*)((const char*)(gbase) + (v1)), (LAS unsigned*)(lds + (bufoff) + ldsw + 8192), 16, 0, 0); } while (0)
#define PG8_LDA(dst, b, h) do { _Pragma("unroll") for (int m = 0; m < 4; ++m) _Pragma("unroll") for (int k = 0; k < 2; ++k) dst[m][k] = *(const LAS bf16x8*)(lds + PG8_SA(b, h) + aoff + m * 2048 + k * 1024); } while (0)
#define PG8_LDB(dst, b, h) do { _Pragma("unroll") for (int n = 0; n < 2; ++n) _Pragma("unroll") for (int k = 0; k < 2; ++k) dst[n][k] = *(const LAS bf16x8*)(lds + PG8_SB(b, h) + boff + n * 2048 + k * 1024); } while (0)
#define PG8_MMA(ai, bj, At, Bt) do { if (Sched::PARTIAL && !((ai) * HALF + wr * 64 < cur.nrow)) break; if (Sched::FP8 && !Sched::PARTIAL && opq_) break; __builtin_amdgcn_s_setprio(1); _Pragma("unroll") for (int m = 0; m < 4; ++m) _Pragma("unroll") for (int n = 0; n < 2; ++n) _Pragma("unroll") for (int k = 0; k < 2; ++k) { \
        if constexpr (Sched::FP8 && FP8_MX) { if (k == 0) { const i32x8 a_ = __builtin_shufflevector(__builtin_bit_cast(i32x4, At[m][0]), __builtin_bit_cast(i32x4, At[m][1]), 0, 1, 2, 3, 4, 5, 6, 7), \
                b_ = __builtin_shufflevector(__builtin_bit_cast(i32x4, Bt[n][0]), __builtin_bit_cast(i32x4, Bt[n][1]), 0, 1, 2, 3, 4, 5, 6, 7); \
            acc[ai][bj][m][n] = __builtin_amdgcn_mfma_scale_f32_16x16x128_f8f6f4(b_, a_, acc[ai][bj][m][n], 0, 0, 0, 0x7f7f7f7f, 0, 0x7f7f7f7f); } }     \
        else if constexpr (Sched::FP8) { const l64x2 a_ = __builtin_bit_cast(l64x2, At[m][k]), b_ = __builtin_bit_cast(l64x2, Bt[n][k]); \
            acc[ai][bj][m][n] = __builtin_amdgcn_mfma_f32_16x16x32_fp8_fp8(b_.x, a_.x, acc[ai][bj][m][n], 0, 0, 0); acc[ai][bj][m][n] = __builtin_amdgcn_mfma_f32_16x16x32_fp8_fp8(b_.y, a_.y, acc[ai][bj][m][n], 0, 0, 0); } \
        else acc[ai][bj][m][n] = __builtin_amdgcn_mfma_f32_16x16x32_bf16(Bt[n][k], At[m][k], acc[ai][bj][m][n], 0, 0, 0); } __builtin_amdgcn_s_setprio(0); } while (0)
#define PG8_WAIT_V(n) asm volatile("s_waitcnt vmcnt(" #n ")" ::: "memory")
#define PG8_WAIT_L(n) asm volatile("s_waitcnt lgkmcnt(" #n ")" ::: "memory")
#define PG8_BAR __builtin_amdgcn_s_barrier()
#define PG8_SCHED __builtin_amdgcn_sched_barrier(0)
    Unit cur, nxt; int ui = 0;
    if (!S.next(0, cur)) return;
    f32x4 acc[2][2][4][2];
#pragma unroll
    for (int a = 0; a < 2; ++a)
#pragma unroll
        for (int b = 0; b < 2; ++b)
#pragma unroll
            for (int m = 0; m < 4; ++m)
#pragma unroll
                for (int n = 0; n < 2; ++n) acc[a][b][m][n] = (f32x4){0.f, 0.f, 0.f, 0.f};
    bf16x8 At[4][2], B0[2][2], B1[2][2];
    constexpr bool GA = Sched::GATHER;
    const size_t hs = GA ? (size_t)0 : hstep;
    unsigned ac00, ac01, ac10, ac11, an00, an01, an10, an11;
    auto aoff_of = [&](const Unit& uu, int h, int i) -> unsigned { int t2 = tid; asm volatile("" : "+v"(t2)); int R, C; stage_rc(t2 * 16 + i * 8192, R, C); return (unsigned)(S.arow(uu, h * HALF + R) * K + C) * 2u; };
#define PG8_AOFF(u, h, i) aoff_of(u, h, i)
    const char* A0 = (const char*)g.A;
    const char* cAu = A0; const char* nAu = A0;
    if constexpr (GA) { ac00 = PG8_AOFF(cur, 0, 0); ac01 = PG8_AOFF(cur, 0, 1); ac10 = PG8_AOFF(cur, 1, 0); ac11 = PG8_AOFF(cur, 1, 1); }
    else { ac00 = ac10 = (unsigned)(RA[0] * K + CA[0]) * 2u; ac01 = ac11 = (unsigned)(RA[1] * K + CA[1]) * 2u; cAu = A0 + (size_t)S.arow0(cur) * K * 2; }
    an00 = ac00; an01 = ac01; an10 = ac10; an11 = ac11;
    const char* cB = (const char*)g.Bt + (size_t)cur.b0 * K * 2;
    PG8_STAGE(PG8_SB(0, 0), cB, voffB[0], voffB[1]); PG8_STAGE(PG8_SB(0, 1), cB + hstep, voffB[0], voffB[1]); PG8_STAGE(PG8_SA(0, 0), cAu, ac00, ac01); PG8_STAGE(PG8_SA(0, 1), cAu + hs, ac10, ac11);
    if (wr == 1) PG8_BAR;
    PG8_WAIT_V(2); PG8_BAR;
    PG8_STAGE(PG8_SB(1, 0), cB + kstep, voffB[0], voffB[1]); PG8_STAGE(PG8_SA(1, 0), cAu + kstep, ac00, ac01); PG8_STAGE(PG8_SB(1, 1), cB + hstep + kstep, voffB[0], voffB[1]);
    PG8_WAIT_V(6); PG8_BAR;
    for (;;) {
        const bool has_next = S.next(ui + 1, nxt);
        const char* nB = has_next ? (const char*)g.Bt + (size_t)nxt.b0 * K * 2 : cB;
        if constexpr (GA) {
            if (has_next) { an00 = PG8_AOFF(nxt, 0, 0); an01 = PG8_AOFF(nxt, 0, 1); an10 = PG8_AOFF(nxt, 1, 0); an11 = PG8_AOFF(nxt, 1, 1); }
            else { an00 = ac00; an01 = ac01; an10 = ac10; an11 = ac11; }
        } else { nAu = has_next ? A0 + (size_t)S.arow0(nxt) * K * 2 : cAu; }
        if constexpr (HasPF<Epi>::v) E.prefetch(cur, 0, lds, wid, lane);
        typename PreOf<Epi>::type pre_;
        if constexpr (PreOf<Epi>::v) pre_ = E.pre(cur, wr, wc, fr, fq);
#pragma unroll 1
        for (int t = 0; t < nt; t += 2) {
            const bool last = (t == nt - 2);
            if constexpr (Epi::MID) { if (t == Epi::MID_T) E.mid(acc, cur, wr, wc, fr, fq); }
            const char* a1 = cAu + (size_t)(t + 1) * kstep;
            const char* a2 = last ? nAu : cAu + (size_t)(t + 2) * kstep; const char* b2 = last ? nB : cB + (size_t)(t + 2) * kstep;
            const char* a3 = a2 + kstep; const char* b3 = b2 + kstep;
            unsigned o00 = ac00, o01 = ac01, o10 = ac10, o11 = ac11;
            if constexpr (GA) { o00 = last ? an00 : ac00; o01 = last ? an01 : ac01; o10 = last ? an10 : ac10; o11 = last ? an11 : ac11; }
            PG8_LDB(B0, 0, 0); PG8_LDB(B1, 0, 1); PG8_SCHED; PG8_LDA(At, 0, 0); PG8_STAGE(PG8_SA(1, 1), a1 + hs, ac10, ac11);
            PG8_WAIT_V(8); PG8_WAIT_L(0); PG8_BAR; PG8_MMA(0, 0, At, B0); PG8_MMA(0, 1, At, B1); PG8_BAR; PG8_SCHED;
            PG8_LDA(At, 0, 1); PG8_STAGE(PG8_SB(0, 0), b2, voffB[0], voffB[1]); PG8_STAGE(PG8_SB(0, 1), b2 + hstep, voffB[0], voffB[1]); PG8_STAGE(PG8_SA(0, 0), a2, o00, o01);
            PG8_WAIT_V(8); PG8_WAIT_L(0); PG8_BAR; PG8_MMA(1, 0, At, B0); PG8_MMA(1, 1, At, B1); PG8_BAR; PG8_SCHED;
            PG8_LDB(B0, 1, 0); PG8_LDB(B1, 1, 1); PG8_SCHED; PG8_LDA(At, 1, 0); PG8_STAGE(PG8_SA(0, 1), a2 + hs, o10, o11);
            PG8_WAIT_V(8); PG8_WAIT_L(0); PG8_BAR; PG8_MMA(0, 0, At, B0); PG8_MMA(0, 1, At, B1); PG8_BAR; PG8_SCHED;
            PG8_LDA(At, 1, 1); PG8_STAGE(PG8_SB(1, 0), b3, voffB[0], voffB[1]); PG8_STAGE(PG8_SB(1, 1), b3 + hstep, voffB[0], voffB[1]); PG8_STAGE(PG8_SA(1, 0), a3, o00, o01);
            PG8_WAIT_V(8); PG8_WAIT_L(0); PG8_BAR; PG8_MMA(1, 0, At, B0); PG8_MMA(1, 1, At, B1); PG8_BAR; PG8_SCHED;
        }
        if constexpr (ALIGN_EPI) { if (wr == 0) PG8_BAR; }
#if defined(PROF_MODE) && PROF_MODE == 6
        if constexpr (Epi::PROF) { const unsigned long long pt0_ = __builtin_amdgcn_s_memrealtime(); E(acc, cur, wr, wc, fr, fq); asm volatile("s_waitcnt vmcnt(0)" ::: "memory");
            if (threadIdx.x == 0) { LAS unsigned* pa_ = (LAS unsigned*)(lds + 131072 + 320 + 64); pa_[0] += (unsigned)(__builtin_amdgcn_s_memrealtime() - pt0_); } } else
#endif
        if constexpr (PreOf<Epi>::v) E(acc, cur, wr, wc, fr, fq, pre_); else E(acc, cur, wr, wc, fr, fq);
        if (!has_next) break;
#pragma unroll
        for (int a = 0; a < 2; ++a)
#pragma unroll
            for (int b = 0; b < 2; ++b)
#pragma unroll
                for (int m = 0; m < 4; ++m)
#pragma unroll
                    for (int n = 0; n < 2; ++n) acc[a][b][m][n] = (f32x4){0.f, 0.f, 0.f, 0.f};
        cur = nxt; cB = nB; cAu = nAu; ac00 = an00; ac01 = an01; ac10 = an10; ac11 = an11; ++ui;
        if constexpr (ALIGN_EPI) { if (wr == 1) PG8_BAR; }
    }
    PG8_WAIT_V(0);
    if constexpr (!ALIGN_EPI) { if (wr == 0) PG8_BAR; }
    PG8_BAR;
#undef PG8_AOFF
#undef PG8_SA
#undef PG8_SB
#undef PG8_STAGE
#undef PG8_LDA
#undef PG8_LDB
#undef PG8_MMA
#undef PG8_WAIT_V
#undef PG8_WAIT_L
#undef PG8_BAR
#undef PG8_SCHED
}
}

#define RLX_AGENT __ATOMIC_RELAXED, __HIP_MEMORY_SCOPE_AGENT
#define LDS_WAIT() asm volatile("s_waitcnt lgkmcnt(0)" ::: "memory")
#define VM_WAIT() asm volatile("s_waitcnt vmcnt(0)" ::: "memory")
#define XB_TMO      128
#define XB_XCNT(j)  (256  + 64 * (j))
#define XB_XSUB(j)  (1280 + 64 * (j))
#define XB_XGEN(j)  (2304 + 64 * (j))
#define XB_TOP      3328
#define XB_TOPGEN   3392
#define XCD_BAR_WORDS 3456
#define XB_SPIN_CAP (1u << 18)

__device__ __forceinline__ unsigned xb_ld(unsigned* p)              { return __hip_atomic_load(p, __ATOMIC_RELAXED, __HIP_MEMORY_SCOPE_AGENT); }
__device__ __forceinline__ unsigned xb_add(unsigned* p, unsigned v) { return __hip_atomic_fetch_add(p, v, __ATOMIC_RELAXED, __HIP_MEMORY_SCOPE_AGENT); }
__device__ __forceinline__ unsigned xb_xcc_id() { return (unsigned)__builtin_amdgcn_s_getreg((3 << 11) | 20) & 0xFu; }
#define XB_SPIN(cond, bar) do { unsigned _sp = 0; while (cond) { __builtin_amdgcn_s_sleep(1); \
    if ((++_sp & 255u) == 0u) { if (xb_ld(&(bar)[XB_TMO])) break; if (_sp > XB_SPIN_CAP) { atomicAdd(&(bar)[XB_TMO], 1u); break; } } } } while (0)

struct XcdBarrier {
    unsigned* bar; unsigned x;
    volatile LAS unsigned* st;
};

__device__ __forceinline__ XcdBarrier xcd_barrier_post(unsigned* bar, volatile LAS unsigned* st) {
    XcdBarrier b; b.bar = bar; b.x = xb_xcc_id(); b.st = st;
    if (threadIdx.x == 0) (void)xb_add(&bar[XB_XCNT(b.x)], 1u);
    return b;
}
__device__ __forceinline__ void xcd_barrier_complete(unsigned* bar, unsigned x, unsigned& nloc, unsigned& nx) {
    const unsigned G = gridDim.x * gridDim.y * gridDim.z;
    unsigned sum, cnt, mine, sp = 0u;
    for (;;) {
        sum = 0u; cnt = 0u; mine = 0u;
#pragma unroll
        for (unsigned j = 0; j < 16; ++j) { const unsigned c = xb_ld(&bar[XB_XCNT(j)]); sum += c; cnt += (c > 0u) ? 1u : 0u; mine = (j == x) ? c : mine; }
        if (sum == G) break;
        __builtin_amdgcn_s_sleep(1);
        if ((++sp & 255u) == 0u) { if (xb_ld(&bar[XB_TMO])) break; if (sp > XB_SPIN_CAP) { atomicAdd(&bar[XB_TMO], 1u); break; } }
    }
    nloc = mine > 0u ? mine : 1u; nx = cnt > 0u ? cnt : 1u;
}

__device__ __forceinline__ void xcd_barrier(const XcdBarrier& b) {
    asm volatile("s_waitcnt vmcnt(0)" ::: "memory");
    __syncthreads();
    if (threadIdx.x == 0) {
        unsigned* bar = b.bar;
        __builtin_amdgcn_s_waitcnt(0);
        unsigned nloc = b.st[0], nx = b.st[1];
        if (nloc == 0u) { xcd_barrier_complete(bar, b.x, nloc, nx); b.st[0] = nloc; b.st[1] = nx; }
        const unsigned old = xb_add(&bar[XB_XSUB(b.x)], 1u);
        const unsigned gen = old / nloc;
        if (old + 1u == (gen + 1u) * nloc) {
            __builtin_amdgcn_fence(__ATOMIC_RELEASE, "agent");
            asm volatile("s_waitcnt vmcnt(0)" ::: "memory");
            const unsigned og = xb_add(&bar[XB_TOP], 1u);
            const unsigned tg = og / nx;
            if (og + 1u == (tg + 1u) * nx) xb_add(&bar[XB_TOPGEN], 1u);
            else XB_SPIN(xb_ld(&bar[XB_TOPGEN]) == tg, bar);
            __builtin_amdgcn_fence(__ATOMIC_ACQUIRE, "agent");
            xb_add(&bar[XB_XGEN(b.x)], 1u);
            asm volatile("s_waitcnt vmcnt(0)" ::: "memory");
        } else {
            XB_SPIN(xb_ld(&bar[XB_XGEN(b.x)]) == gen, bar);
            __builtin_amdgcn_fence(__ATOMIC_ACQUIRE, "agent");
            asm volatile("s_waitcnt vmcnt(0)" ::: "memory");
        }
    }
    __syncthreads();
}

constexpr int NWAVES = 8;
#ifndef P1_ALIGN
#define P1_ALIGN true
#endif
#ifndef MK_PER_PHASE
#define MK_PER_PHASE 0
#endif
constexpr int NPH = 11;
constexpr size_t MiB = 1u << 20;
constexpr size_t WS_CTL = 0, CTL_ZERO_BYTES = 1 * MiB;
constexpr size_t WS_WT = 1 * MiB;
constexpr size_t WS_RSTD2 = WS_WT + 256 * 1024;
constexpr size_t WS_RSTD3 = WS_RSTD2 + 128 * 1024;
constexpr size_t WS_C1 = WS_RSTD3 + 128 * 1024;
constexpr size_t WS_LISTW = 240 * MiB, WS_LISTR = 244 * MiB;
constexpr size_t WS_X1 = 365 * MiB;
constexpr size_t WS_LIST = 2 * MiB;
constexpr size_t WS_NG = 6 * MiB;
constexpr size_t WS_KC = 10 * MiB, WS_VC = WS_KC + 512 * 1024;
constexpr size_t WS_WIN = 11 * MiB;
constexpr size_t WS_WAC = 20 * MiB, WS_WO = 22 * MiB, WS_WPG = 24 * MiB, WS_WPP = 26 * MiB, WS_WR = WS_WPP + 512 * 1024, WS_CW1 = 27 * MiB, WS_CW2 = 28 * MiB;
constexpr size_t WS_WGU = 29 * MiB;
constexpr size_t WS_WD = 93 * MiB;
constexpr size_t WS_XN8 = 61 * MiB;
constexpr size_t WS_WIN8 = 109 * MiB;
constexpr size_t WS_X1F8 = 61 * MiB;
constexpr size_t WS_XN = 125 * MiB;
constexpr size_t WS_QB = 189 * MiB;
constexpr size_t WS_KVB = 221 * MiB;
constexpr size_t WS_H = 189 * MiB;
constexpr size_t WS_GLU = 269 * MiB;
constexpr size_t WS_MG = 301 * MiB;
constexpr size_t WS_Y = 301 * MiB;
constexpr size_t WS_AC = 429 * MiB;
constexpr size_t WS_PP = 429 * MiB;
constexpr size_t WS_PBF = 493 * MiB;
constexpr size_t WS_END = 509 * MiB;
constexpr int CW_TMO = 0, CW_CODE = 1, CW_QATT = 64, CW_CNT = 128  , CW_BAR = 4096, CW_Q7 = 12288, CW_Q8 = 12352, CW_QX = 16384  ;
#ifndef ATT_XCD_QUEUES
#define ATT_XCD_QUEUES 0
#endif

constexpr int RING_BYTES = 131072;
constexpr int LDSCTL_OFF = RING_BYTES, MISC_OFF = LDSCTL_OFF + 320, MOE_OFF = LDSCTL_OFF + 1024;
constexpr int LDS_BYTES = 147456;

struct Args { const float* in[29]; float* out; unsigned char* ws; int ph_lo, ph_hi; };
#define CAS __attribute__((address_space(4)))
struct Frame {
    LAS unsigned char* lds;
    volatile LAS unsigned* MISC;
    gu32* ctl;
    int tid, lane, wave, vcu, G;
    const CAS Args* ka;
    float* out;
    unsigned char* ws;
    __device__ __forceinline__ const float* inp(int i) const { return ka->in[i]; }
};

struct TrSrc { const float* W; int ldw, s0, nv; };
__device__ __forceinline__ void tr64(const TrSrc A, const TrSrc B, int ks0, const float* kscale, bf16* WT, size_t drow0, int K, int kd0, int lane) {
    const int q = lane >> 4, c = lane & 15, blk = c >> 3, cc = (c & 7) * 4;
    const float* W = blk ? B.W : A.W; const int ldw = blk ? B.ldw : A.ldw, s0 = blk ? B.s0 : A.s0, nv = blk ? B.nv : A.nv;
    const bool valid = cc < nv;
    f32x4 v[16];
#pragma unroll
    for (int i = 0; i < 16; ++i) { v[i] = (f32x4){0.f, 0.f, 0.f, 0.f}; if (valid) v[i] = *(const f32x4*)(W + (size_t)(ks0 + 16 * q + i) * ldw + s0 + cc); }
    if (kscale) {
#pragma unroll
        for (int i = 0; i < 16; ++i) v[i] *= kscale[ks0 + 16 * q + i]; }
#pragma unroll
    for (int j = 0; j < 4; ++j) { bf16* dst = WT + (drow0 + blk * 32 + cc + j) * K + kd0 + 16 * q;
        u32x4 o0, o1;
        o0.x = cvt_pk_bf16(v[0][j], v[1][j]); o0.y = cvt_pk_bf16(v[2][j], v[3][j]); o0.z = cvt_pk_bf16(v[4][j], v[5][j]); o0.w = cvt_pk_bf16(v[6][j], v[7][j]);
        o1.x = cvt_pk_bf16(v[8][j], v[9][j]); o1.y = cvt_pk_bf16(v[10][j], v[11][j]); o1.z = cvt_pk_bf16(v[12][j], v[13][j]); o1.w = cvt_pk_bf16(v[14][j], v[15][j]);
        st_wt16(dst, o0); st_wt16(dst + 8, o1); }
}
__device__ __forceinline__ void tr64_f8(const TrSrc A, const TrSrc B, int ks0, const float* kscale, float scale, unsigned char* WT, size_t drow0, int K8, int kd0, int lane) {
    const int q = lane >> 4, c = lane & 15, blk = c >> 3, cc = (c & 7) * 4;
    const float* W = blk ? B.W : A.W; const int ldw = blk ? B.ldw : A.ldw, s0 = blk ? B.s0 : A.s0, nv = blk ? B.nv : A.nv;
    const bool valid = cc < nv; if (!valid) scale = 0.f;
    f32x4 v[16];
#pragma unroll
    for (int i = 0; i < 16; ++i) v[i] = *(const f32x4*)(W + (size_t)(ks0 + 16 * q + i) * ldw + s0 + (valid ? cc : 0)) * scale;
    if (kscale) {
#pragma unroll
        for (int i = 0; i < 16; ++i) v[i] *= kscale[ks0 + 16 * q + i]; }
#pragma unroll
    for (int j = 0; j < 4; ++j) { u32x4 o; unsigned* op = (unsigned*)&o;
#pragma unroll
        for (int d = 0; d < 4; ++d) { int t = __builtin_amdgcn_cvt_pk_fp8_f32(v[4 * d][j], v[4 * d + 1][j], 0, false); t = __builtin_amdgcn_cvt_pk_fp8_f32(v[4 * d + 2][j], v[4 * d + 3][j], t, true); op[d] = (unsigned)t; }
        *(u32x4*)(WT + (drow0 + blk * 32 + cc + j) * K8 + kd0 + 16 * q) = o; }
}
__device__ __forceinline__ TrSrc win_src(const float* W, int tile, int pb) {
    const int bj = pb >> 2, wc = pb & 3; TrSrc s; s.W = W; s.ldw = NIN; s.nv = 32;
    const int kvc = 64 * (wc & 1) + 32 * bj;
    if (tile < 2) s.s0 = tile * 256 + 64 * wc + 32 * bj;
    else if (tile == 2) s.s0 = OFF_KV + ((wc >> 1) ? 256 : 0) + kvc;
    else if (tile < 7) s.s0 = OFF_CONV + (bj ? 512 : 0) + (tile - 3) * 128 + 32 * wc;
    else if (tile == 7) { if (wc >= 2) s.s0 = OFF_KV + 512 + kvc; else { s.s0 = OFF_GATE; s.nv = (pb == 0) ? 24 : 0; } }
    else if (tile < 16) s.s0 = OFF_MERGE + (bj ? 1024 : 0) + (tile - 8) * 128 + 32 * wc;
    else if (tile == 16) s.s0 = OFF_KV + ((wc >> 1) ? 384 : 128) + kvc;
    else { s.s0 = OFF_KV + 640 + kvc; if (wc >= 2) { s.s0 = OFF_KV; s.nv = 0; } }
    return s;
}
#ifndef P10_FP8
#define P10_FP8 1
#endif
#ifndef X_BF16
#define X_BF16 0
#endif
constexpr int I_GU = 32 * 16 * 16, I_D = 32 * 16 * 8, I_AC = 16 * 16, I_O = 16 * 16, I_PG = 16 * 16, I_PP = 16 * 4, I_R = 16, I_PBF = 2048;
constexpr int N_LATE = I_GU + I_D + I_AC + I_O + I_PG + I_PP + I_R + I_PBF;
constexpr int I_IN = 72 * 16, I_C1 = 2 * 2 * 32, I_C2 = 2 * 1 * 2;
constexpr int NITEMS = N_LATE + I_IN + I_C1 + I_C2;
static_assert(N_LATE <= 16 * 1024, "late items are dealt 16 per attention unit");
__device__ __forceinline__ void p0_item(Frame& F, int it, int lane) {
    unsigned char* ws = F.ws;
    int r = it;
    if (r < I_GU) { const int e = r >> 8, qq = r & 255, dg = qq >> 4, kb = qq & 15, pn = dg >> 2, pb = (dg & 3) * 2, bj = pb >> 2, wc = pb & 3;
        const float* W = (bj ? F.inp(23) : F.inp(22)) + (size_t)e * 1024 * 512;
        const TrSrc A{W, 512, 128 * pn + 32 * wc, 32}, B{W, 512, 128 * pn + 32 * wc + 32, 32};
        tr64_f8(A, B, kb * 64, F.inp(17), 32.f, ws + WS_WGU + (size_t)e * 1024 * 1024, (size_t)dg * 64, 1024, kb * 64, lane); return; }
    r -= I_GU;
    if (r < I_D) { const int e = r >> 7, qq = r & 127, dg = qq >> 3, kb = qq & 7; const float* W = F.inp(24) + (size_t)e * 512 * 1024;
        const TrSrc A{W, 1024, dg * 64, 32}, B{W, 1024, dg * 64 + 32, 32};
        tr64_f8(A, B, kb * 64, nullptr, 16.f, ws + WS_WD + (size_t)e * 1024 * 512, (size_t)dg * 64, 512, kb * 64, lane); return; }
    r -= I_D;
    if (r < I_AC) { const int dg = r >> 4, kb = r & 15; const float* W = kb < 8 ? F.inp(9) : F.inp(14);
        const TrSrc A{W, 1024, dg * 64, 32}, B{W, 1024, dg * 64 + 32, 32};
        tr64(A, B, (kb & 7) * 64, nullptr, (bf16*)(ws + WS_WAC), (size_t)dg * 64, 1024, kb * 64, lane); return; }
    r -= I_AC;
    if (r < I_O) { const int dg = r >> 4, kb = r & 15; const TrSrc A{F.inp(16), 1024, dg * 64, 32}, B{F.inp(16), 1024, dg * 64 + 32, 32};
        tr64(A, B, kb * 64, nullptr, (bf16*)(ws + WS_WO), (size_t)dg * 64, 1024, kb * 64, lane); return; }
    r -= I_O;
    if (r < I_PG) { const int dg = r >> 4, kb = r & 15; const TrSrc A{F.inp(26), 1024, dg * 64, 32}, B{F.inp(26), 1024, dg * 64 + 32, 32};
        if (P10_FP8) tr64_f8(A, B, kb * 64, F.inp(25), 32.f, ws + WS_WPG, (size_t)dg * 64, 1024, kb * 64, lane); else tr64(A, B, kb * 64, F.inp(25), (bf16*)(ws + WS_WPG), (size_t)dg * 64, 1024, kb * 64, lane); return; }
    r -= I_PG;
    if (r < I_PP) { const int dg = r >> 2, kb = r & 3; const TrSrc A{F.inp(28), 1024, dg * 64, 32}, B{F.inp(28), 1024, dg * 64 + 32, 32};
        tr64(A, B, kb * 64, nullptr, (bf16*)(ws + WS_WPP), (size_t)dg * 64, 256, kb * 64, lane); return; }
    r -= I_PP;
    if (r < I_R) { const int kb = r;
        const TrSrc A{F.inp(18), 4, 0, 4}, B{F.inp(20), 32, 0, 32};
        tr64(A, B, kb * 64, F.inp(17), (bf16*)(ws + WS_WR), 0, 1024, kb * 64, lane); return; }
    r -= I_R;
    if (r < I_PBF) {
        const f32x4* src = (const f32x4*)F.inp(1) + (size_t)r * 1024 + 2 * lane; u32x4* dst = (u32x4*)(ws + WS_PBF) + (size_t)r * 512 + lane; f32x4 a[8], b[8];
#pragma unroll
        for (int i = 0; i < 8; ++i) { a[i] = src[128 * i]; b[i] = src[128 * i + 1]; }
#pragma unroll
        for (int i = 0; i < 8; ++i) { u32x4 o; o.x = cvt_pk_bf16(a[i].x, a[i].y); o.y = cvt_pk_bf16(a[i].z, a[i].w); o.z = cvt_pk_bf16(b[i].x, b[i].y); o.w = cvt_pk_bf16(b[i].z, b[i].w); dst[64 * i] = o; }
        return; }
    r -= I_PBF;
    if (r < I_IN) { const int dg = r >> 4, kb = r & 15, tile = dg >> 2, pb = (dg & 3) * 2;
        if (tile >= 8) tr64_f8(win_src(F.inp(3), tile, pb), win_src(F.inp(3), tile, pb + 1), kb * 64, nullptr, 32.f, ws + WS_WIN8, (size_t)(dg - 32) * 64, 1024, kb * 64, lane);
        else tr64(win_src(F.inp(3), tile, pb), win_src(F.inp(3), tile, pb + 1), kb * 64, nullptr, (bf16*)(ws + WS_WIN), (size_t)dg * 64, 1024, kb * 64, lane);
        return; }
    r -= I_IN;
    if (r < I_C1) { const int kv = r >> 6, qq = r & 63, dg = qq >> 5, kb = qq & 31; const float* W = F.inp(7) + (size_t)kv * 2048 * 128;
        const TrSrc A{W, 128, dg * 64, 32}, B{W, 128, dg * 64 + 32, 32};
        tr64(A, B, kb * 64, nullptr, (bf16*)(ws + WS_CW1) + (size_t)kv * 128 * 2048, (size_t)dg * 64, 2048, kb * 64, lane); return; }
    r -= I_C1;
    { const int kv = r >> 1, kb = r & 1; const float* W = F.inp(8) + (size_t)kv * 128 * 64;
        const TrSrc A{W, 64, 0, 32}, B{W, 64, 32, 32};
        tr64(A, B, kb * 64, nullptr, (bf16*)(ws + WS_CW2) + (size_t)kv * 64 * 128, 0, 128, kb * 64, lane); }
}
constexpr int L_GAIN = 126976;
#ifndef LATE_NT
#define LATE_NT 1
#endif
#if LATE_NT & 1
#define LATE_LD(p) __builtin_nontemporal_load(p)
#else
#define LATE_LD(p) (*(p))
#endif
#if LATE_NT & 2
#define LATE_ST(p, v) __builtin_nontemporal_store(v, p)
#else
#define LATE_ST(p, v) (*(p) = (v))
#endif
struct LateD { const float* p; const float* ks; unsigned char* dst; int ldw, rstride, kind, ksl; float scale; bool valid; };
__device__ __forceinline__ LateD late_desc(Frame& F, int it, int lane) {
    LateD d; d.kind = 3; d.ks = nullptr; d.ksl = -1; d.scale = 1.f; d.valid = true; d.ldw = 0; d.rstride = 0; d.p = nullptr; d.dst = nullptr;
    if (it >= N_LATE) return d;
    const int q = lane >> 4, c = lane & 15, blk = c >> 3, cc = (c & 7) * 4;
    unsigned char* ws = F.ws;
    auto set = [&](const TrSrc A, const TrSrc B, int ks0, const float* kscale, int ksl, float scale, unsigned char* WT, size_t drow0, int K, int kd0, int kind) {
        const float* W = blk ? B.W : A.W; const int ldw = blk ? B.ldw : A.ldw, s0 = blk ? B.s0 : A.s0, nv = blk ? B.nv : A.nv;
        d.valid = cc < nv; d.p = W + (size_t)(ks0 + 16 * q) * ldw + s0 + (d.valid ? cc : 0); d.ldw = ldw;
        d.ks = kscale ? kscale + ks0 + 16 * q : nullptr; d.ksl = ksl >= 0 ? ksl + ks0 + 16 * q : -1; d.scale = scale; d.kind = kind;
        const int eb = kind == 0 ? 1 : 2;
        d.dst = WT + ((drow0 + blk * 32 + cc) * K + kd0 + 16 * q) * eb; d.rstride = K * eb; };
    int r = it;
    if (r < I_GU) { const int e = r >> 8, qq = r & 255, dg = qq >> 4, kb = qq & 15, pn = dg >> 2, pb = (dg & 3) * 2, bj = pb >> 2, wc = pb & 3;
        const float* W = (bj ? F.inp(23) : F.inp(22)) + (size_t)e * 1024 * 512;
        set(TrSrc{W, 512, 128 * pn + 32 * wc, 32}, TrSrc{W, 512, 128 * pn + 32 * wc + 32, 32}, kb * 64, nullptr, 0, 32.f, ws + WS_WGU + (size_t)e * 1024 * 1024, (size_t)dg * 64, 1024, kb * 64, 0); return d; }
    r -= I_GU;
    if (r < I_D) { const int e = r >> 7, qq = r & 127, dg = qq >> 3, kb = qq & 7; const float* W = F.inp(24) + (size_t)e * 512 * 1024;
        set(TrSrc{W, 1024, dg * 64, 32}, TrSrc{W, 1024, dg * 64 + 32, 32}, kb * 64, nullptr, -1, 16.f, ws + WS_WD + (size_t)e * 1024 * 512, (size_t)dg * 64, 512, kb * 64, 0); return d; }
    r -= I_D;
    if (r < I_AC) { const int dg = r >> 4, kb = r & 15; const float* W = kb < 8 ? F.inp(9) : F.inp(14);
        set(TrSrc{W, 1024, dg * 64, 32}, TrSrc{W, 1024, dg * 64 + 32, 32}, (kb & 7) * 64, nullptr, -1, 1.f, ws + WS_WAC, (size_t)dg * 64, 1024, kb * 64, 1); return d; }
    r -= I_AC;
    if (r < I_O) { const int dg = r >> 4, kb = r & 15;
        set(TrSrc{F.inp(16), 1024, dg * 64, 32}, TrSrc{F.inp(16), 1024, dg * 64 + 32, 32}, kb * 64, nullptr, -1, 1.f, ws + WS_WO, (size_t)dg * 64, 1024, kb * 64, 1); return d; }
    r -= I_O;
    if (r < I_PG) { const int dg = r >> 4, kb = r & 15;
        set(TrSrc{F.inp(26), 1024, dg * 64, 32}, TrSrc{F.inp(26), 1024, dg * 64 + 32, 32}, kb * 64, F.inp(25), -1, P10_FP8 ? 32.f : 1.f, ws + WS_WPG, (size_t)dg * 64, 1024, kb * 64, P10_FP8 ? 0 : 1); return d; }
    r -= I_PG;
    if (r < I_PP) { const int dg = r >> 2, kb = r & 3;
        set(TrSrc{F.inp(28), 1024, dg * 64, 32}, TrSrc{F.inp(28), 1024, dg * 64 + 32, 32}, kb * 64, nullptr, -1, 1.f, ws + WS_WPP, (size_t)dg * 64, 256, kb * 64, 1); return d; }
    r -= I_PP;
    if (r < I_R) { const int kb = r;
        set(TrSrc{F.inp(18), 4, 0, 4}, TrSrc{F.inp(20), 32, 0, 32}, kb * 64, F.inp(17), -1, 1.f, ws + WS_WR, 0, 1024, kb * 64, 1); return d; }
    r -= I_R;
    d.kind = 2; d.p = F.inp(1) + ((size_t)r * 1024 + lane) * 4; d.ldw = 256; d.dst = ws + WS_PBF + ((size_t)r * 1024 + lane) * 8;
    return d;
}
__device__ __forceinline__ void late_load(const LateD& d, f32x4 (&v)[16]) {
    if (d.kind != 3) {
#pragma unroll
        for (int i = 0; i < 16; ++i) v[i] = LATE_LD((const f32x4*)(d.p + (size_t)i * d.ldw)); }
    else {
#pragma unroll
        for (int i = 0; i < 16; ++i) v[i] = (f32x4){0.f, 0.f, 0.f, 0.f}; }
}
__device__ __forceinline__ void late_finish(Frame& F, const LateD& d, f32x4 (&v)[16]) {
    if (d.kind == 0) {
        if (d.ksl >= 0) { const LAS float* gl = (const LAS float*)(F.lds + L_GAIN) + d.ksl;
#pragma unroll
            for (int i4 = 0; i4 < 4; ++i4) { const f32x4 g4 = *(const LAS f32x4*)(gl + 4 * i4);
#pragma unroll
                for (int k = 0; k < 4; ++k) v[4 * i4 + k] *= g4[k] * d.scale; }
        } else if (d.ks) {
#pragma unroll
            for (int i = 0; i < 16; ++i) v[i] *= d.ks[i] * d.scale;
        } else {
#pragma unroll
            for (int i = 0; i < 16; ++i) v[i] *= d.scale; }
#pragma unroll
        for (int j = 0; j < 4; ++j) { u32x4 o; unsigned* op = (unsigned*)&o;
#pragma unroll
            for (int dd = 0; dd < 4; ++dd) { int t = __builtin_amdgcn_cvt_pk_fp8_f32(v[4 * dd][j], v[4 * dd + 1][j], 0, false); t = __builtin_amdgcn_cvt_pk_fp8_f32(v[4 * dd + 2][j], v[4 * dd + 3][j], t, true); op[dd] = (unsigned)t; }
            LATE_ST((u32x4*)(d.dst + (size_t)j * d.rstride), o); }
    } else if (d.kind == 1) {
        if (d.ks) {
#pragma unroll
            for (int i = 0; i < 16; ++i) v[i] *= d.ks[i]; }
        if (!d.valid) {
#pragma unroll
            for (int i = 0; i < 16; ++i) v[i] = (f32x4){0.f, 0.f, 0.f, 0.f}; }
#pragma unroll
        for (int j = 0; j < 4; ++j) { bf16* dst = (bf16*)(d.dst + (size_t)j * d.rstride);
            u32x4 o0, o1;
            o0.x = cvt_pk_bf16(v[0][j], v[1][j]); o0.y = cvt_pk_bf16(v[2][j], v[3][j]); o0.z = cvt_pk_bf16(v[4][j], v[5][j]); o0.w = cvt_pk_bf16(v[6][j], v[7][j]);
            o1.x = cvt_pk_bf16(v[8][j], v[9][j]); o1.y = cvt_pk_bf16(v[10][j], v[11][j]); o1.z = cvt_pk_bf16(v[12][j], v[13][j]); o1.w = cvt_pk_bf16(v[14][j], v[15][j]);
            LATE_ST((u32x4*)dst, o0); LATE_ST((u32x4*)(dst + 8), o1); }
    } else if (d.kind == 2) {
#pragma unroll
        for (int i = 0; i < 16; ++i) { u32x2 o; o.x = cvt_pk_bf16(v[i].x, v[i].y); o.y = cvt_pk_bf16(v[i].z, v[i].w); LATE_ST((u32x2*)d.dst + 64 * i, o); }
    }
}
__device__ __forceinline__ void p0_prologue(Frame& F) {
    const int lane = F.lane;
    const int gw = F.vcu * NWAVES + F.wave, NGW = F.G * NWAVES;
    unsigned char* ws = F.ws;
#ifdef LATE_IN_P0
    for (int it = gw; it < NITEMS; it += NGW) p0_item(F, it, lane);
#else
    for (int it = N_LATE + gw; it < NITEMS; it += NGW) p0_item(F, it, lane);
#endif
    {
        const f32x4* gp = (const f32x4*)F.inp(2) + lane; f32x4 gv[4];
#pragma unroll
        for (int j = 0; j < 4; ++j) gv[j] = gp[64 * j];
#pragma unroll 2
        for (int m = gw; m < T; m += NGW) {
            const f32x4* xr = (const f32x4*)(F.inp(0) + (size_t)m * DM) + lane; f32x4 v[4]; float s = 0.f;
#pragma unroll
            for (int j = 0; j < 4; ++j) { v[j] = xr[64 * j]; s += (v[j].x * v[j].x + v[j].y * v[j].y) + (v[j].z * v[j].z + v[j].w * v[j].w); }
            const float rstd = 1.0f / sqrtf(wave_sum(s) * (1.f / DM) + EPS);
            u32x2* o8 = (u32x2*)((bf16*)(ws + WS_XN) + (size_t)m * DM) + lane;
            u32x2* xb = (u32x2*)((bf16*)F.out + (size_t)T * DM + (size_t)m * DM) + lane;
            unsigned* o4 = (unsigned*)(ws + WS_XN8 + (size_t)m * DM) + lane;
#pragma unroll
            for (int j = 0; j < 4; ++j) { const f32x4 y = v[j] * rstd * gv[j]; u32x2 w; w.x = cvt_pk_bf16(y.x, y.y); w.y = cvt_pk_bf16(y.z, y.w); o8[64 * j] = w;
                if (X_BF16) { u32x2 wx; wx.x = cvt_pk_bf16(v[j].x, v[j].y); wx.y = cvt_pk_bf16(v[j].z, v[j].w); xb[64 * j] = wx; }
                int t8 = __builtin_amdgcn_cvt_pk_fp8_f32(y.x * 16.f, y.y * 16.f, 0, false); t8 = __builtin_amdgcn_cvt_pk_fp8_f32(y.z * 16.f, y.w * 16.f, t8, true); o4[64 * j] = (unsigned)t8; }
        }
    }
    if (gw < 256) { const int kv = gw >> 7, j = gw & 127; const float* pe = F.inp(6) + (size_t)kv * 2048; const float* w1 = F.inp(7) + (size_t)kv * 2048 * 128 + j; float s = 0.f;
        for (int k = lane; k < 2048; k += 64) s += pe[k] * w1[(size_t)k * 128];
        s = wave_sum(s); if (lane == 0) ((float*)(ws + WS_C1))[gw] = s; }
}

__device__ __forceinline__ u32x4 pack8(const f32x4 a, const f32x4 b) { u32x4 w; w.x = cvt_pk_bf16(a[0], a[1]); w.y = cvt_pk_bf16(a[2], a[3]); w.z = cvt_pk_bf16(b[0], b[1]); w.w = cvt_pk_bf16(b[2], b[3]); return w; }
__device__ __forceinline__ void unpack8(const u32x4 w, f32x4& a, f32x4& b) { a = (f32x4){bf_lo(w.x), bf_hi(w.x), bf_lo(w.y), bf_hi(w.y)}; b = (f32x4){bf_lo(w.z), bf_hi(w.z), bf_lo(w.w), bf_hi(w.w)}; }

__device__ __forceinline__ u32x2 pack8_fp8(const f32x4 a, const f32x4 b) { u32x2 w;
    int t = __builtin_amdgcn_cvt_pk_fp8_f32(a[0], a[1], 0, false); t = __builtin_amdgcn_cvt_pk_fp8_f32(a[2], a[3], t, true); w.x = (unsigned)t;
    t = __builtin_amdgcn_cvt_pk_fp8_f32(b[0], b[1], 0, false); t = __builtin_amdgcn_cvt_pk_fp8_f32(b[2], b[3], t, true); w.y = (unsigned)t; return w; }
__device__ __forceinline__ void unpack8_fp8(const u32x2 w, f32x4& a, f32x4& b) {
    const f32x2 a0 = __builtin_amdgcn_cvt_pk_f32_fp8((int)w.x, false), a1 = __builtin_amdgcn_cvt_pk_f32_fp8((int)w.x, true), b0 = __builtin_amdgcn_cvt_pk_f32_fp8((int)w.y, false), b1 = __builtin_amdgcn_cvt_pk_f32_fp8((int)w.y, true);
    a = (f32x4){a0.x, a0.y, a1.x, a1.y}; b = (f32x4){b0.x, b0.y, b1.x, b1.y}; }

template <int MODE  > struct EpiWin {
    static constexpr bool MID = false, PROF = false, NOPERM = false; static constexpr int MID_T = 0;
    bf16 *Qb, *KVb, *GLU, *MG; float* NG; const float *qg, *kg, *mb; float zs;
    __device__ __forceinline__ void mid(f32x4 (&)[2][2][4][2], const pg8::Unit&, int, int, int, int) const {}
    __device__ __forceinline__ void head_store(const f32x4 (&acc)[2][2][4][2], int row0, int fq, bool norm, const float* gain, float sc, bf16* dst, int ld, int col) const {
        f32x4 gv[2][2];
#pragma unroll
        for (int bj = 0; bj < 2; ++bj)
#pragma unroll
            for (int n = 0; n < 2; ++n) gv[bj][n] = norm ? *(const f32x4*)(gain + 32 * bj + 8 * fq + 4 * n) * sc : (f32x4){sc, sc, sc, sc};
#pragma unroll
        for (int ai = 0; ai < 2; ++ai)
#pragma unroll
            for (int m = 0; m < 4; ++m) {
                float rs = 1.f;
                if (norm) { float s = 0.f;
#pragma unroll
                    for (int bj = 0; bj < 2; ++bj)
#pragma unroll
                        for (int n = 0; n < 2; ++n) { const f32x4 x = acc[ai][bj][m][n]; s += (x[0] * x[0] + x[1] * x[1]) + (x[2] * x[2] + x[3] * x[3]); }
                    s += __shfl_xor(s, 16); s += __shfl_xor(s, 32);
                    rs = 1.0f / sqrtf(s * (1.f / 64.f) + EPS); }
                bf16* rowp = dst + (unsigned)((row0 + ai * 128 + m * 16) * ld + col + 8 * fq);
#pragma unroll
                for (int bj = 0; bj < 2; ++bj) st_wt16(rowp + 32 * bj, pack8(acc[ai][bj][m][0] * rs * gv[bj][0], acc[ai][bj][m][1] * rs * gv[bj][1]));
            }
    }
    __device__ __forceinline__ void operator()(const f32x4 (&acc)[2][2][4][2], const pg8::Unit& u, int wr, int wc, int fr, int fq) const {
        int oz = 0; asm volatile("" : "+v"(oz));
        const int row0 = u.pm * 256 + wr * 64 + fr + oz, pn = u.pn;
        if (MODE == 0 && pn < 2) head_store(acc, row0, fq, true, qg, QC2, Qb, 512, (pn * 4 + wc) * 64);
        else if (MODE == 0 && pn == 2) { const int i = (wc >> 1) ? 2 : 0; head_store(acc, row0, fq, i == 2, kg + 64, 1.f, KVb, 768, i * 128 + (wc & 1) * 64); }
        else if (MODE == 0 && pn < 7) {
            const int col = (pn - 3) * 128 + 32 * wc + 8 * fq;
#pragma unroll
            for (int ai = 0; ai < 2; ++ai)
#pragma unroll
                for (int m = 0; m < 4; ++m) { f32x4 o[2];
#pragma unroll
                    for (int n = 0; n < 2; ++n) { const f32x4 a = acc[ai][0][m][n], gt = acc[ai][1][m][n];
                        o[n] = (f32x4){a[0] * fsigmoid(gt[0]), a[1] * fsigmoid(gt[1]), a[2] * fsigmoid(gt[2]), a[3] * fsigmoid(gt[3])}; }
                    st_wt16(GLU + (unsigned)((row0 + ai * 128 + m * 16) * 512 + col), pack8(o[0], o[1])); }
        } else if (MODE == 0) {
            if (wc >= 2) head_store(acc, row0, fq, true, kg + 128, 1.f, KVb, 768, 4 * 128 + (wc & 1) * 64);
            else if (wc == 0 && fq < 3) {
#pragma unroll
                for (int ai = 0; ai < 2; ++ai)
#pragma unroll
                    for (int m = 0; m < 4; ++m)
#pragma unroll
                        for (int n = 0; n < 2; ++n) { const f32x4 z = acc[ai][0][m][n];
                            *(f32x4*)(NG + (unsigned)((row0 + ai * 128 + m * 16) * 32 + 8 * fq + 4 * n)) = (f32x4){fsigmoid(z[0]), fsigmoid(z[1]), fsigmoid(z[2]), fsigmoid(z[3])}; }
            }
        } else if (pn < 16) {
            const int col = (pn - 8) * 128 + 32 * wc + 8 * fq;
            f32x4 ba[2], bc[2];
#pragma unroll
            for (int n = 0; n < 2; ++n) { ba[n] = *(const f32x4*)(mb + col + 4 * n); bc[n] = *(const f32x4*)(mb + 1024 + col + 4 * n); }
#pragma unroll
            for (int ai = 0; ai < 2; ++ai)
#pragma unroll
                for (int m = 0; m < 4; ++m) { f32x4 rr[2], cc[2];
#pragma unroll
                    for (int n = 0; n < 2; ++n) { const f32x4 za = acc[ai][0][m][n] * zs + ba[n], zc = acc[ai][1][m][n] * zs + bc[n];
#pragma unroll
                        for (int j = 0; j < 4; ++j) { const float ea = __builtin_amdgcn_exp2f(-za[j] * LOG2E), ec = __builtin_amdgcn_exp2f(-zc[j] * LOG2E);
                            cc[n][j] = __builtin_amdgcn_rcpf(1.0f + ec); rr[n][j] = (1.0f + ec) * __builtin_amdgcn_rcpf(1.0f + ea); } }
                    bf16* rowp = MG + (unsigned)((row0 + ai * 128 + m * 16) * 2048 + col);
                    st_wt16(rowp, pack8(rr[0], rr[1])); st_wt16(rowp + 1024, pack8(cc[0], cc[1])); asm volatile("" ::: "memory"); }
        } else {
            const int i = (pn == 16) ? ((wc >> 1) ? 3 : 1) : 5;
            if (pn == 16 || wc < 2) head_store(acc, row0, fq, false, kg, zs, KVb, 768, i * 128 + (wc & 1) * 64);
        }
    }
};

#ifndef EPI_PRE
#define EPI_PRE 6
#endif
#ifndef EPI_PRE_WO
#define EPI_PRE_WO 5
#endif
#ifndef EPI_PRE_PLE
#define EPI_PRE_PLE 5
#endif
#ifndef EPI_DEPTH
#define EPI_DEPTH 2
#endif
#ifndef PF_MERGE
#define PF_MERGE 0
#endif
struct EpiMerge {
    static constexpr bool MID = true, PROF = false, NOPERM = false, PREFETCH = (PF_MERGE != 0); static constexpr int MID_T = 8;
    const bf16* MG; bf16* MER; LAS unsigned char* lds_;
    __device__ __forceinline__ void prefetch(const pg8::Unit& u, int t, LAS unsigned char* lds, int wid, int lane) const {
        if (t != 0 || (PF_MERGE & 1)) { const int half = (t == 0) ? 0 : 1024; asm volatile("" : "+v"(lane));
#pragma unroll
            for (int j = 0; j < 2; ++j) { const int id = j * 64 + lane, row = wid * 32 + (id >> 2), seg = id & 3;
                __builtin_amdgcn_global_load_lds((const unsigned*)(MG + (unsigned)((u.pm * 256 + row) * 2048 + half + u.pn * 256 + seg * 64)), (LAS unsigned*)(lds + pg8::PF_DUMP), 4, 0, 0); } }
    }
    __device__ __forceinline__ void mid(f32x4 (&acc)[2][2][4][2], const pg8::Unit& u, int wr, int wc, int fr, int fq) const {
        int oz = 0; asm volatile("" : "+v"(oz));
        const int row0 = u.pm * 256 + wr * 64 + fr + oz, col0 = u.pn * 256 + wc * 32 + 8 * fq;
        u32x4 va[4][2];
#define MG_LD(g, b) do { const bf16* p_ = MG + (unsigned)((row0 + ((g) >> 2) * 128 + ((g) & 3) * 16) * 2048 + col0); va[b][0] = *(const u32x4*)p_; va[b][1] = *(const u32x4*)(p_ + 128); } while (0)
        MG_LD(0, 0); MG_LD(1, 1); if (EPI_DEPTH > 2) { MG_LD(2, 2); MG_LD(3, 3); }
#pragma unroll
        for (int g = 0; g < 8; ++g) { const int ai = g >> 2, m = g & 3, b = g & 3;
#pragma unroll
            for (int bj = 0; bj < 2; ++bj) { f32x4 a0, a1; unpack8(va[b][bj], a0, a1); acc[ai][bj][m][0] *= a0; acc[ai][bj][m][1] *= a1; }
            asm volatile("" : "+v"(acc[ai][0][m][0]), "+v"(acc[ai][0][m][1]), "+v"(acc[ai][1][m][0]), "+v"(acc[ai][1][m][1]) :: "memory");
            if (g + EPI_DEPTH < 8) { MG_LD(g + EPI_DEPTH, (g + EPI_DEPTH) & 3); asm volatile("" ::: "memory"); } }
#undef MG_LD
        if (PREFETCH && (PF_MERGE & 2)) prefetch(u, 1, lds_, wr * 4 + wc, fq * 16 + fr);
    }
    __device__ __forceinline__ void operator()(const f32x4 (&acc)[2][2][4][2], const pg8::Unit& u, int wr, int wc, int fr, int fq) const {
        int oz = 0; asm volatile("" : "+v"(oz));
        const int row0 = u.pm * 256 + wr * 64 + fr + oz, col0 = u.pn * 256 + wc * 32 + 8 * fq;
        constexpr int NPRE = EPI_PRE;
        u32x4 vc[NPRE][2];
#define MG_LD(g) do { const bf16* p_ = MG + (unsigned)((row0 + ((g) >> 2) * 128 + ((g) & 3) * 16) * 2048 + 1024 + col0); vc[(g) % NPRE][0] = *(const u32x4*)p_; vc[(g) % NPRE][1] = *(const u32x4*)(p_ + 128); } while (0)
#pragma unroll
        for (int g = 0; g < NPRE; ++g) MG_LD(g);
        asm volatile("" ::: "memory");
#pragma unroll
        for (int g = 0; g < 8; ++g) { const int ai = g >> 2, m = g & 3, b = g % NPRE;
#pragma unroll
            for (int bj = 0; bj < 2; ++bj) { f32x4 c0, c1; unpack8(vc[b][bj], c0, c1);
                st_wt16(MER + (unsigned)((row0 + ai * 128 + m * 16) * 1024 + col0 + bj * 128), pack8(acc[ai][bj][m][0] * c0, acc[ai][bj][m][1] * c1)); }
            asm volatile("" ::: "memory");
            if (g + NPRE < 8) { MG_LD(g + NPRE); asm volatile("" ::: "memory"); } }
#undef MG_LD
    }
};

struct EpiWo {
    static constexpr bool MID = false, PROF = false, NOPERM = false; static constexpr int MID_T = 0;
    const float* X; bf16* O; unsigned char* O8; const bf16* XB16;
    __device__ __forceinline__ void mid(f32x4 (&)[2][2][4][2], const pg8::Unit&, int, int, int, int) const {}
    __device__ __forceinline__ void operator()(const f32x4 (&acc)[2][2][4][2], const pg8::Unit& u, int wr, int wc, int fr, int fq) const {
        int oz = 0; asm volatile("" : "+v"(oz));
        const int row0 = u.pm * 256 + wr * 64 + fr + oz, col0 = u.pn * 256 + wc * 32 + 8 * fq;
#if X_BF16
        constexpr int NPRE = EPI_PRE;
        u32x4 xw[NPRE][2];
#define WO_LD(g) do { const bf16* p_ = XB16 + (unsigned)((row0 + ((g) >> 2) * 128 + ((g) & 3) * 16) * 1024 + col0); xw[(g) % NPRE][0] = *(const u32x4*)p_; xw[(g) % NPRE][1] = *(const u32x4*)(p_ + 128); } while (0)
#pragma unroll
        for (int g = 0; g < NPRE; ++g) WO_LD(g);
        asm volatile("" ::: "memory");
#pragma unroll
        for (int g = 0; g < 8; ++g) { const int ai = g >> 2, m = g & 3;
#pragma unroll
            for (int bj = 0; bj < 2; ++bj) { f32x4 x0, x1; unpack8(xw[g % NPRE][bj], x0, x1);
                const f32x4 y0 = x0 + acc[ai][bj][m][0], y1 = x1 + acc[ai][bj][m][1]; const unsigned o_ = (unsigned)((row0 + ai * 128 + m * 16) * 1024 + col0 + bj * 128);
                st_wt16(O + o_, pack8(y0, y1)); *(u32x2*)(O8 + o_) = pack8_fp8(y0 * 16.f, y1 * 16.f); }
            asm volatile("" ::: "memory");
            if (g + NPRE < 8) { WO_LD(g + NPRE); asm volatile("" ::: "memory"); } }
#undef WO_LD
#else
        constexpr int NPRE = EPI_PRE_WO;
        f32x4 xv[NPRE][2][2];
#define WO_LD(g) do { const float* p_ = X + (unsigned)((row0 + ((g) >> 2) * 128 + ((g) & 3) * 16) * 1024 + col0); const int b_ = (g) % NPRE; \
            xv[b_][0][0] = *(const f32x4*)p_; xv[b_][0][1] = *(const f32x4*)(p_ + 4); xv[b_][1][0] = *(const f32x4*)(p_ + 128); xv[b_][1][1] = *(const f32x4*)(p_ + 132); } while (0)
#pragma unroll
        for (int g = 0; g < NPRE; ++g) WO_LD(g);
        asm volatile("" ::: "memory");
#pragma unroll
        for (int g = 0; g < 8; ++g) { const int ai = g >> 2, m = g & 3, b = g % NPRE;
#pragma unroll
            for (int bj = 0; bj < 2; ++bj) { const f32x4 y0 = xv[b][bj][0] + acc[ai][bj][m][0], y1 = xv[b][bj][1] + acc[ai][bj][m][1]; const unsigned o_ = (unsigned)((row0 + ai * 128 + m * 16) * 1024 + col0 + bj * 128);
                st_wt16(O + o_, pack8(y0, y1)); *(u32x2*)(O8 + o_) = pack8_fp8(y0 * 16.f, y1 * 16.f); }
            asm volatile("" ::: "memory");
            if (g + NPRE < 8) { WO_LD(g + NPRE); asm volatile("" ::: "memory"); } }
#undef WO_LD
#endif
    }
};

#ifndef PP_FP8
#define PP_FP8 0
#endif
struct EpiBf {
    static constexpr bool MID = false, PROF = false, NOPERM = false; static constexpr int MID_T = 0;
    bf16* O; int ldc;
    __device__ __forceinline__ void mid(f32x4 (&)[2][2][4][2], const pg8::Unit&, int, int, int, int) const {}
    __device__ __forceinline__ void operator()(const f32x4 (&acc)[2][2][4][2], const pg8::Unit& u, int wr, int wc, int fr, int fq) const {
        int oz = 0; asm volatile("" : "+v"(oz));
        const int row0 = u.pm * 256 + wr * 64 + fr + oz, col0 = u.pn * 256 + wc * 32 + 8 * fq;
#pragma unroll
        for (int ai = 0; ai < 2; ++ai)
#pragma unroll
            for (int m = 0; m < 4; ++m)
#pragma unroll
                for (int bj = 0; bj < 2; ++bj) {
                    if (PP_FP8) *(u32x2*)((unsigned char*)O + (unsigned)((row0 + ai * 128 + m * 16) * ldc + col0 + bj * 128)) = pack8_fp8(acc[ai][bj][m][0] * 16.f, acc[ai][bj][m][1] * 16.f);
                    else st_wt16(O + (unsigned)((row0 + ai * 128 + m * 16) * ldc + col0 + bj * 128), pack8(acc[ai][bj][m][0], acc[ai][bj][m][1])); }
    }
};

template <bool GATH> struct MoeOrder {
    static constexpr bool GATHER = GATH, PARTIAL = true, FP8 = true;
    const LAS int* tab; const int* list; int G, c; gu32* qctr; LAS int* slot;
    const LAS int* rowtab;
    __device__ bool next(int i, pg8::Unit& u) const {
        const int R = tab[32];
        const long L = (long)i * G + c;
        if (L >= (long)R * 4) return false;
        const int ent = tab[80 + (int)(L >> 2)], rt = ent & 0xffff, e = ent >> 16, pn = (int)(L & 3);
        u.pm = rt; u.pn = pn; u.e = e; u.lp = (rt - tab[e]) * 256; const int cn = tab[33 + e] - u.lp; u.nrow = cn < 256 ? cn : 256; u.b0 = e * 1024 + pn * 256; u.ord = i; return true;
    }
    __device__ __forceinline__ int arow0(const pg8::Unit& u) const { return u.pm * 256; }
    __device__ __forceinline__ int arow(const pg8::Unit& u, int r) const {
        if (!GATH) return u.pm * 256 + r;
        return rowtab[u.ord * 256 + r];
    }
};

#ifndef PROF_EPI
#define PROF_EPI 10
#endif
#ifndef MOE_PRE
#define MOE_PRE 1
#endif
struct EpiGU {
    static constexpr bool MID = false, PROF = (PROF_EPI == 7), NOPERM = false; static constexpr int MID_T = 0;
    bf16* H; const int* list; const float* rstd;
    __device__ __forceinline__ void mid(f32x4 (&)[2][2][4][2], const pg8::Unit&, int, int, int, int) const {}
#if MOE_PRE
    struct Pre { float rsv[8]; };
    __device__ __forceinline__ Pre pre(const pg8::Unit& u, int wr, int wc, int fr, int fq) const { Pre p; const int r0 = wr * 64 + fr;
#pragma unroll
        for (int g = 0; g < 8; ++g) { const int r = (g >> 2) * 128 + (g & 3) * 16 + r0; p.rsv[g] = rstd[u.e * LISTCAP + u.lp + (r < u.nrow ? r : u.nrow - 1)]; }
        return p; }
    __device__ __forceinline__ void operator()(const f32x4 (&acc)[2][2][4][2], const pg8::Unit& u, int wr, int wc, int fr, int fq, const Pre& pr) const {
        int oz = 0; asm volatile("" : "+v"(oz));
        const int col = u.pn * 128 + 32 * wc + 8 * fq, r0 = wr * 64 + fr + oz;
        float rsv[8];
#pragma unroll
        for (int g = 0; g < 8; ++g) rsv[g] = pr.rsv[g];
#else
    __device__ __forceinline__ void operator()(const f32x4 (&acc)[2][2][4][2], const pg8::Unit& u, int wr, int wc, int fr, int fq) const {
        int oz = 0; asm volatile("" : "+v"(oz));
        const int col = u.pn * 128 + 32 * wc + 8 * fq, r0 = wr * 64 + fr + oz;
        float rsv[8];
#pragma unroll
        for (int g = 0; g < 8; ++g) { const int r = (g >> 2) * 128 + (g & 3) * 16 + r0; rsv[g] = rstd[u.e * LISTCAP + u.lp + (r < u.nrow ? r : u.nrow - 1)]; }
#endif
#pragma unroll
        for (int g = 0; g < 8; ++g) { const int ai = g >> 2, m = g & 3, r = ai * 128 + m * 16 + r0;
            if (r < u.nrow) { const float rs = rsv[g] * (1.f / 512.f); f32x4 o[2];
#pragma unroll
                for (int n = 0; n < 2; ++n)
#pragma unroll
                    for (int j = 0; j < 4; ++j) { const float gt = acc[ai][0][m][n][j] * rs, up = acc[ai][1][m][n][j] * rs; o[n][j] = gt * fsigmoid(gt) * up * 8.f; }
                *(u32x2*)((unsigned char*)H + (unsigned)((u.pm * 256 + r) * 512 + col)) = pack8_fp8(o[0], o[1]); } }
    }
};

struct EpiDown {
    static constexpr bool MID = false, PROF = (PROF_EPI == 8), NOPERM = false; static constexpr int MID_T = 0;
    bf16* Y; const int* list; const float* wt;
    __device__ __forceinline__ void mid(f32x4 (&)[2][2][4][2], const pg8::Unit&, int, int, int, int) const {}
#if MOE_PRE
    struct Pre { int ent[8]; float wv[8]; };
    __device__ __forceinline__ Pre pre(const pg8::Unit& u, int wr, int wc, int fr, int fq) const { Pre p; const int r0 = wr * 64 + fr;
#pragma unroll
        for (int g = 0; g < 8; ++g) { const int r = (g >> 2) * 128 + (g & 3) * 16 + r0, li = u.e * LISTCAP + u.lp + (r < u.nrow ? r : u.nrow - 1); p.ent[g] = list[li]; p.wv[g] = wt[li]; }
        return p; }
    __device__ __forceinline__ void operator()(const f32x4 (&acc)[2][2][4][2], const pg8::Unit& u, int wr, int wc, int fr, int fq, const Pre& pr) const {
        int oz = 0; asm volatile("" : "+v"(oz));
        const int col0 = u.pn * 256 + wc * 32 + 8 * fq, r0 = wr * 64 + fr + oz;
        int ent[8]; float wv[8];
#pragma unroll
        for (int g = 0; g < 8; ++g) { ent[g] = pr.ent[g]; wv[g] = pr.wv[g]; }
#else
    __device__ __forceinline__ void operator()(const f32x4 (&acc)[2][2][4][2], const pg8::Unit& u, int wr, int wc, int fr, int fq) const {
        int oz = 0; asm volatile("" : "+v"(oz));
        const int col0 = u.pn * 256 + wc * 32 + 8 * fq, r0 = wr * 64 + fr + oz;
        int ent[8]; float wv[8];
#pragma unroll
        for (int g = 0; g < 8; ++g) { const int r = (g >> 2) * 128 + (g & 3) * 16 + r0, li = u.e * LISTCAP + u.lp + (r < u.nrow ? r : u.nrow - 1); ent[g] = list[li]; wv[g] = wt[li]; }
#endif
#pragma unroll
        for (int g = 0; g < 8; ++g) { const int ai = g >> 2, m = g & 3, r = ai * 128 + m * 16 + r0;
            if (r < u.nrow) { const float w = wv[g];
#pragma unroll
                for (int bj = 0; bj < 2; ++bj) *(u32x2*)((unsigned char*)Y + (unsigned)(ent[g] * 1024 + col0 + bj * 128)) = pack8_fp8(acc[ai][bj][m][0] * (0.125f * w), acc[ai][bj][m][1] * (0.125f * w)); } }
    }
};

struct EpiPle {
    static constexpr bool MID = false, PROF = (PROF_EPI == 10), NOPERM = true; static constexpr int MID_T = 0;
    float* O; const bf16* X2; const bf16* PP; const float* rstd; const float* bias; float* DUMMY;
    __device__ __forceinline__ void mid(f32x4 (&)[2][2][4][2], const pg8::Unit&, int, int, int, int) const {}
    __device__ __forceinline__ void operator()(const f32x4 (&acc)[2][2][4][2], const pg8::Unit& u, int wr, int wc, int fr, int fq) const {
        int oz = 0; asm volatile("" : "+v"(oz));
        const int row0 = u.pm * 256 + wr * 64 + fr + oz, col0 = u.pn * 256 + wc * 32 + 4 * fq;
        f32x4 bv[2][2];
#pragma unroll
        for (int bj = 0; bj < 2; ++bj)
#pragma unroll
            for (int n = 0; n < 2; ++n) bv[bj][n] = *(const f32x4*)(bias + col0 + bj * 128 + 16 * n);
        float rsv[8];
#pragma unroll
        for (int g = 0; g < 8; ++g) rsv[g] = rstd[row0 + (g >> 2) * 128 + (g & 3) * 16] * (P10_FP8 ? (1.f / 512.f) : 1.f);
#pragma unroll
        for (int bj = 0; bj < 2; ++bj) {
            u32x2 vx[8][2], vp[8][2];
#pragma unroll
            for (int g = 0; g < 8; ++g) { const unsigned o_ = (unsigned)((row0 + (g >> 2) * 128 + (g & 3) * 16) * 1024 + col0 + bj * 128);
                vx[g][0] = *(const u32x2*)(X2 + o_); vx[g][1] = *(const u32x2*)(X2 + o_ + 16); vp[g][0] = *(const u32x2*)(PP + o_); vp[g][1] = *(const u32x2*)(PP + o_ + 16); }
            asm volatile("" ::: "memory");
#pragma unroll
            for (int g = 0; g < 8; ++g) { const int ai = g >> 2, m = g & 3; const float rs = rsv[g];
#pragma unroll
                for (int n = 0; n < 2; ++n) { const unsigned o = (unsigned)((row0 + ai * 128 + m * 16) * 1024 + col0 + bj * 128 + 16 * n);
                    const u32x2 xw = vx[g][n], pw = vp[g][n];
                    const f32x4 x = (f32x4){bf_lo(xw.x), bf_hi(xw.x), bf_lo(xw.y), bf_hi(xw.y)}, p = (f32x4){bf_lo(pw.x), bf_hi(pw.x), bf_lo(pw.y), bf_hi(pw.y)};
                    const f32x4 z = acc[ai][bj][m][n] * rs + bv[bj][n];
                    const f32x4 gt = (f32x4){fsigmoid(z[0]), fsigmoid(z[1]), fsigmoid(z[2]), fsigmoid(z[3])};
                    *(f32x4*)(O + o) = x + gt * p; }
                asm volatile("" ::: "memory"); }
        }
    }
};

__device__ __forceinline__ float gelu_tanh(float x) { const float u = 0.7978845608028654f * (x + 0.044715f * x * x * x); const float e = __builtin_amdgcn_exp2f(2.f * LOG2E * u); const float th = 1.f - 2.f * __builtin_amdgcn_rcpf(e + 1.f); return 0.5f * x * (1.f + th); }

__device__ __forceinline__ void compress_unit(Frame& F, int unit) {
    const int nt32 = unit & 7, b = (unit >> 3) & 7, g = (unit >> 6) & 1, kv = unit >> 7;
    const int lane = F.lane, wid = F.wave, i16 = lane & 15, kq = lane >> 4;
    const bf16* KVb = (const bf16*)(F.ws + WS_KVB);
    const bf16* W1 = (const bf16*)(F.ws + WS_CW1) + (size_t)kv * 128 * 2048;
    const bf16* W2 = (const bf16*)(F.ws + WS_CW2) + (size_t)kv * 64 * 128;
    const float* c1 = (const float*)(F.ws + WS_C1) + kv * 128;
    LAS float* part = (LAS float*)F.lds;
    LAS bf16* hid = (LAS bf16*)(F.lds + MOE_OFF);
    LAS float* outs = (LAS float*)F.lds;
    int tok[2];
#pragma unroll
    for (int mt = 0; mt < 2; ++mt) { const int n = nt32 * 32 + mt * 16 + i16; tok[mt] = b * SEQ + (n < 255 ? n : 254) * 16; }
    f32x4 acc[2][8];
#pragma unroll
    for (int mt = 0; mt < 2; ++mt)
#pragma unroll
        for (int j = 0; j < 8; ++j) acc[mt][j] = (f32x4){0.f, 0.f, 0.f, 0.f};
#pragma unroll
    for (int ll = 0; ll < 4; ++ll) { const int l = wid * 4 + ll;
#pragma unroll
        for (int s = 0; s < 2; ++s) {
            const bf16x8 a0 = *(const bf16x8*)(KVb + (size_t)(tok[0] + l) * 768 + kv * 128 + g * 64 + s * 32 + kq * 8);
            const bf16x8 a1 = *(const bf16x8*)(KVb + (size_t)(tok[1] + l) * 768 + kv * 128 + g * 64 + s * 32 + kq * 8);
#pragma unroll
            for (int j = 0; j < 8; ++j) { const bf16x8 w = *(const bf16x8*)(W1 + (size_t)(j * 16 + i16) * 2048 + l * 64 + s * 32 + kq * 8);
                acc[0][j] = __builtin_amdgcn_mfma_f32_16x16x32_bf16(a0, w, acc[0][j], 0, 0, 0);
                acc[1][j] = __builtin_amdgcn_mfma_f32_16x16x32_bf16(a1, w, acc[1][j], 0, 0, 0); } } }
#pragma unroll
    for (int mt = 0; mt < 2; ++mt)
#pragma unroll
        for (int j = 0; j < 8; ++j)
#pragma unroll
            for (int r = 0; r < 4; ++r) part[(wid * 32 + mt * 16 + kq * 4 + r) * 128 + j * 16 + i16] = acc[mt][j][r];
    __syncthreads();
    { const int tid = F.tid;
#pragma unroll
      for (int q = 0; q < 8; ++q) { const int idx = tid + 512 * q, row = idx >> 7, col = idx & 127; float s = c1[col];
#pragma unroll
          for (int w = 0; w < 8; ++w) s += part[(w * 32 + row) * 128 + col];
          hid[row * 136 + col] = (bf16)(cvt_pk_bf16(gelu_tanh(s), 0.f) & 0xffffu); } }
    __syncthreads();
    { const int mt = wid >> 2, nq = wid & 3; f32x4 o = (f32x4){0.f, 0.f, 0.f, 0.f};
#pragma unroll
        for (int s = 0; s < 4; ++s) { const bf16x8 a = *(const LAS bf16x8*)(hid + (mt * 16 + i16) * 136 + s * 32 + kq * 8);
            const bf16x8 w = *(const bf16x8*)(W2 + (size_t)(nq * 16 + i16) * 128 + s * 32 + kq * 8);
            o = __builtin_amdgcn_mfma_f32_16x16x32_bf16(a, w, o, 0, 0, 0); }
#pragma unroll
        for (int r = 0; r < 4; ++r) outs[(mt * 16 + kq * 4 + r) * 64 + nq * 16 + i16] = o[r]; }
    __syncthreads();
#pragma unroll
    for (int h = 0; h < 2; ++h) { const int tid = F.tid, row = h * 16 + (tid >> 5), c = tid & 31; const float v0 = outs[row * 64 + c], v1 = outs[row * 64 + 32 + c];
      float rs = 1.f, g0 = 1.f, g1 = 1.f;
      if (kv == 0) { float s = v0 * v0 + v1 * v1;
#pragma unroll
          for (int o = 1; o < 32; o <<= 1) s += __shfl_xor(s, o);
          rs = 1.0f / sqrtf(s * (1.f / 64.f) + EPS); g0 = F.inp(5)[c]; g1 = F.inp(5)[32 + c]; }
      const int nn = nt32 * 32 + row; const bool real = nn < 255;
      bf16* dst = (bf16*)(F.ws + (kv ? WS_VC : WS_KC)) + ((size_t)(b * 2 + g) * 256 + nn) * 64;
      dst[c] = real ? (bf16)(cvt_pk_bf16(v0 * rs * g0, 0.f) & 0xffffu) : (bf16)0;
      dst[32 + c] = real ? (bf16)(cvt_pk_bf16(v1 * rs * g1, 0.f) & 0xffffu) : (bf16)0; }
    __syncthreads();
}

struct ConvW { f32x2 cw[31]; f32x2 cb; };
__device__ __forceinline__ void conv_weights(Frame& F, ConvW& w) { const int cp_ = F.tid & 255;
#pragma unroll
    for (int j = 0; j < 31; ++j) w.cw[j] = *(const f32x2*)(F.inp(10) + j * 512 + cp_ * 2);
    w.cb = *(const f32x2*)(F.inp(11) + cp_ * 2); }
__device__ __forceinline__ void conv_unit(Frame& F, int unit, const ConvW& W) {
    const int tid = F.tid, lane = F.lane, wid = F.wave;
    const f32x2 (&cw)[31] = W.cw; const f32x2 cb = W.cb;
    const int t0 = unit * 32, s0 = t0 & (SEQ - 1);
    const bf16* GLU = (const bf16*)(F.ws + WS_GLU);
    LAS unsigned* tin = (LAS unsigned*)F.lds;
    LAS float* tout = (LAS float*)(F.lds + 65536);
    for (int i = tid; i < 62 * 64; i += 512) { const int r = i >> 6, c = i & 63; const int s = s0 - 30 + r;
        u32x4 v = (u32x4){0u, 0u, 0u, 0u}; if (s >= 0) v = *(const u32x4*)(GLU + (size_t)(t0 - 30 + r) * 512 + c * 8);
        *(LAS u32x4*)(tin + r * 256 + c * 4) = v; }
    __syncthreads();
    { const int cp = tid & 255, th = tid >> 8;
      f32x2 xin[46];
#pragma unroll
      for (int r = 0; r < 46; ++r) { const unsigned w = tin[(th * 16 + r) * 256 + cp]; xin[r] = (f32x2){bf_lo(w), bf_hi(w)}; }
#pragma unroll
      for (int tt = 0; tt < 16; ++tt) { f32x2 a = cb;
#pragma unroll
          for (int j = 0; j < 31; ++j) a += cw[j] * xin[tt + j];
          *(LAS f32x2*)(tout + (th * 16 + tt) * 512 + cp * 2) = a; } }
    __syncthreads();
    { const f32x4 lg0 = *(const f32x4*)(F.inp(12) + lane * 8), lg1 = *(const f32x4*)(F.inp(12) + lane * 8 + 4), lb0 = *(const f32x4*)(F.inp(13) + lane * 8), lb1 = *(const f32x4*)(F.inp(13) + lane * 8 + 4);
      f32x4 v0[4], v1[4]; float sm[4], sq[4];
#pragma unroll
      for (int q = 0; q < 4; ++q) { const int tl = wid * 4 + q; v0[q] = *(const LAS f32x4*)(tout + tl * 512 + lane * 8); v1[q] = *(const LAS f32x4*)(tout + tl * 512 + lane * 8 + 4);
          sm[q] = (v0[q][0] + v0[q][1]) + (v0[q][2] + v0[q][3]) + (v1[q][0] + v1[q][1]) + (v1[q][2] + v1[q][3]); }
#pragma unroll
      for (int o = 1; o < 64; o <<= 1) {
#pragma unroll
          for (int q = 0; q < 4; ++q) sm[q] += __shfl_xor(sm[q], o); }
#pragma unroll
      for (int q = 0; q < 4; ++q) { const float mu = sm[q] * (1.f / 512.f); v0[q] = v0[q] - mu; v1[q] = v1[q] - mu;
          sq[q] = (v0[q][0] * v0[q][0] + v0[q][1] * v0[q][1]) + (v0[q][2] * v0[q][2] + v0[q][3] * v0[q][3]) + (v1[q][0] * v1[q][0] + v1[q][1] * v1[q][1]) + (v1[q][2] * v1[q][2] + v1[q][3] * v1[q][3]); }
#pragma unroll
      for (int o = 1; o < 64; o <<= 1) {
#pragma unroll
          for (int q = 0; q < 4; ++q) sq[q] += __shfl_xor(sq[q], o); }
#pragma unroll
      for (int q = 0; q < 4; ++q) { const int tl = wid * 4 + q; const float rs = 1.0f / sqrtf(sq[q] * (1.f / 512.f) + EPS);
          f32x4 y0 = v0[q] * rs * lg0 + lb0, y1 = v1[q] * rs * lg1 + lb1;
#pragma unroll
          for (int j = 0; j < 4; ++j) { y0[j] *= fsigmoid(y0[j]); y1[j] *= fsigmoid(y1[j]); }
#if defined(ABL) && ABL == 3
          y0 = (f32x4){0.f, 0.f, 0.f, 0.f}; y1 = y0;
#endif
          st_wt16((bf16*)(F.ws + WS_AC) + (size_t)(t0 + tl) * 1024 + 512 + lane * 8, pack8(y0, y1)); } }
    __syncthreads();
}

__device__ __forceinline__ void p2_phase(Frame& F) {
    for (int u = F.vcu; u < 256; u += F.G) compress_unit(F, u);
}

namespace att {
#ifndef REPS_SEL
#define REPS_SEL 1
#endif
#ifndef REPS_WIN
#define REPS_WIN 1
#endif
#if defined(ABL)
#define ABLF(k) (ABL == (k) ? 0.f : 1.f) *
#else
#define ABLF(k)
#endif
constexpr int L_K = 0, L_V = 24576, L_WS = 57344, L_SEL = L_WS + 2048, L_WU = L_SEL + 512, L_Q = L_WU + 64, L_OST = 61440, L_IMP = L_OST;
static_assert(L_Q + 16 <= L_OST && L_OST + 65536 <= RING_BYTES && 64 * 65 * 4 <= 65536, "attention LDS map");
__device__ __forceinline__ int crow(int r, int hi) { return (r & 3) + 8 * (r >> 2) + 4 * hi; }

template <bool NEEDV> __device__ __forceinline__ void dma_tile(LAS unsigned char* lds, int slot, const bf16* Kb, const bf16* Vb, int pitch, int key0, int wid, int lane) {
    __builtin_amdgcn_global_load_lds((const unsigned*)((Kb + key0 * pitch) + (unsigned)(lane * pitch + wid * 8)), (LAS unsigned*)(lds + L_K + slot * 8192 + wid * 1024), 16, 0, 0);
    if (NEEDV) __builtin_amdgcn_global_load_lds((const unsigned*)((Vb + key0 * pitch) + (unsigned)((16 * (wid & 3) + (lane >> 2)) * pitch + (wid >> 2) * 32 + (lane & 3) * 8)), (LAS unsigned*)(lds + L_V + slot * 8192 + wid * 1024), 16, 0, 0);
}
template <int KEEP> __device__ __forceinline__ void wait_bar() {
    if (KEEP == 2) asm volatile("s_waitcnt vmcnt(2) lgkmcnt(0)" ::: "memory");
    else if (KEEP == 1) asm volatile("s_waitcnt vmcnt(1) lgkmcnt(0)" ::: "memory");
    else asm volatile("s_waitcnt vmcnt(0) lgkmcnt(0)" ::: "memory");
    __builtin_amdgcn_s_barrier();
    asm volatile("" ::: "memory");
}
__device__ __forceinline__ void dma_k(LAS unsigned char* lds, int slot, const bf16* Kb, int pitch, int key0, int wid, int lane) {
    __builtin_amdgcn_global_load_lds((const unsigned*)(Kb + (unsigned)((key0 + lane) * pitch + wid * 8)), (LAS unsigned*)(lds + L_K + slot * 8192 + wid * 1024), 16, 0, 0);
}
__device__ __forceinline__ void dma_v(LAS unsigned char* lds, int slot, const bf16* Vb, int pitch, int key0, int wid, int lane) {
    __builtin_amdgcn_global_load_lds((const unsigned*)(Vb + (unsigned)((key0 + 16 * (wid & 3) + (lane >> 2)) * pitch + (wid >> 2) * 32 + (lane & 3) * 8)), (LAS unsigned*)(lds + L_V + slot * 8192 + wid * 1024), 16, 0, 0);
}
__device__ __forceinline__ void wait_bar_n(int keep) {
    if (keep >= 4) asm volatile("s_waitcnt vmcnt(4) lgkmcnt(0)" ::: "memory");
    else if (keep == 3) asm volatile("s_waitcnt vmcnt(3) lgkmcnt(0)" ::: "memory");
    else if (keep == 2) asm volatile("s_waitcnt vmcnt(2) lgkmcnt(0)" ::: "memory");
    else if (keep == 1) asm volatile("s_waitcnt vmcnt(1) lgkmcnt(0)" ::: "memory");
    else asm volatile("s_waitcnt vmcnt(0) lgkmcnt(0)" ::: "memory");
    __builtin_amdgcn_s_barrier();
    asm volatile("" ::: "memory");
}
__device__ __forceinline__ void qk_tile(f32x16& p0, f32x16& p1, const LAS unsigned char* Ks, const bf16x8 (&qr)[4], const f32x16& c0, const f32x16& c1, int r32, int hi) {
    const LAS unsigned char* kb = Ks + hi * 1024 + r32 * 16;
#pragma unroll
    for (int d0 = 0; d0 < 4; ++d0) {
        const bf16x8 b0 = *(const LAS bf16x8*)(kb + d0 * 2048), b1 = *(const LAS bf16x8*)(kb + d0 * 2048 + 512);
        if (d0 == 0) { p0 = __builtin_amdgcn_mfma_f32_32x32x16_bf16(b0, qr[0], c0, 0, 0, 0); p1 = __builtin_amdgcn_mfma_f32_32x32x16_bf16(b1, qr[0], c1, 0, 0, 0); }
        else { p0 = __builtin_amdgcn_mfma_f32_32x32x16_bf16(b0, qr[d0], p0, 0, 0, 0); p1 = __builtin_amdgcn_mfma_f32_32x32x16_bf16(b1, qr[d0], p1, 0, 0, 0); } }
}
__device__ __forceinline__ void qk_half_ext(f32x16& p, const LAS unsigned char* Ks, int half, const bf16x8 (&qr)[4], const bf16x8 qext, const bf16x8 ae, int r32, int hi) {
    const LAS unsigned char* kb = Ks + hi * 1024 + r32 * 16 + half * 512;
    const f32x16 z = (f32x16){0.f};
    p = __builtin_amdgcn_mfma_f32_32x32x16_bf16(ae, qext, z, 0, 0, 0);
#pragma unroll
    for (int d0 = 0; d0 < 4; ++d0) { const bf16x8 b0 = *(const LAS bf16x8*)(kb + d0 * 2048); p = __builtin_amdgcn_mfma_f32_32x32x16_bf16(b0, qr[d0], p, 0, 0, 0); }
}
__device__ __forceinline__ void ref_words(float mhat, int hi, unsigned& w2, unsigned& w3) {
    const float x = -mhat; const unsigned a = cvt_pk_bf16(x, 0.f) & 0xffffu; const float r1 = x - __uint_as_float(a << 16);
    const unsigned bb = cvt_pk_bf16(r1, 0.f) & 0xffffu; const float r2 = r1 - __uint_as_float(bb << 16); const unsigned c = cvt_pk_bf16(r2, 0.f) & 0xffffu;
    w2 = hi ? 0u : (a | (bb << 16)); w3 = hi ? 0u : c;
}
__device__ __forceinline__ float max3f(float a, float b, float c) { return fmaxf(fmaxf(a, b), c); }
__device__ __forceinline__ float rowmax32(const f32x16& p0, const f32x16& p1) {
    float a = max3f(p0[0], p0[1], p1[0]), b = max3f(p0[2], p0[3], p1[1]); a = max3f(a, p1[2], p1[3]);
#pragma unroll
    for (int r = 4; r < 16; r += 4) { a = max3f(a, p0[r], p0[r + 1]); b = max3f(b, p0[r + 2], p0[r + 3]); a = max3f(a, p1[r], p1[r + 1]); b = max3f(b, p1[r + 2], p1[r + 3]); }
    const float m = fmaxf(a, b);
    return fmaxf(m, __shfl_xor(m, 32));
}
__device__ __forceinline__ s16x4 vtr(unsigned addr) { s16x4 r; asm volatile("ds_read_b64_tr_b16 %0, %1" : "=v"(r) : "v"(addr) : "memory"); return r; }
__device__ __forceinline__ float rowmax16(const f32x16& p) {
    float a = max3f(p[0], p[1], p[2]), bq = max3f(p[3], p[4], p[5]);
    a = max3f(a, p[6], p[7]); bq = max3f(bq, p[8], p[9]); a = max3f(a, p[10], p[11]); bq = max3f(bq, p[12], p[13]); a = max3f(a, p[14], p[15]);
    const float m = fmaxf(a, bq);
    return fmaxf(m, __shfl_xor(m, 32));
}
template <bool FIRST>
__device__ __forceinline__ void softmax_half(f32x16& p, f32x16& nx, bool hasn, float& mhat, unsigned& rw2, unsigned& rw3, float& l, f32x16 (&o)[2], LAS float* wsf, int r32, int hi) {
    constexpr float THR = 8.f;
    const float rm = rowmax16(p);
    if (FIRST || __any(rm > THR)) {
        float dl = FIRST ? rm : ((rm > THR) ? rm : 0.f);
        if (dl == -INFINITY) dl = 0.f;
        mhat += dl;
#pragma unroll
        for (int r = 0; r < 16; ++r) p[r] -= dl;
        ref_words(mhat, hi, rw2, rw3);
        if (hasn) {
#pragma unroll
            for (int r = 0; r < 16; ++r) nx[r] -= dl; }
        if (!FIRST) {
            const float f = __builtin_amdgcn_exp2f(-dl); l *= f;
            if (hi == 0) wsf[r32] = f;
            LDS_WAIT();
#pragma unroll
            for (int a = 0; a < 4; ++a) { const f32x4 fv = *(const LAS f32x4*)(wsf + 8 * a + 4 * hi);
#pragma unroll
                for (int j = 0; j < 4; ++j) { o[0][4 * a + j] *= fv[j]; o[1][4 * a + j] *= fv[j]; } }
            LDS_WAIT();
        }
    }
    float s = 0.f;
#pragma unroll
    for (int r = 0; r < 16; ++r) { p[r] = __builtin_amdgcn_exp2f(p[r]); s += p[r]; }
    l += s;
}
__device__ __forceinline__ void pv_half(f32x16 (&o)[2], unsigned vbase, int half, const f32x16& p) {
#pragma unroll
    for (int k2 = 0; k2 < 2; ++k2) { const int ks = 2 * half + k2;
        s16x4 lo[2], hi[2];
#pragma unroll
        for (int d0 = 0; d0 < 2; ++d0) { lo[d0] = vtr(vbase + d0 * 4096 + ks * 1024); hi[d0] = vtr(vbase + d0 * 4096 + ks * 1024 + 512); }
        const int bb = k2 * 8;
        u32x4 w; w.x = cvt_pk_bf16(p[bb + 0], p[bb + 1]); w.y = cvt_pk_bf16(p[bb + 2], p[bb + 3]); w.z = cvt_pk_bf16(p[bb + 4], p[bb + 5]); w.w = cvt_pk_bf16(p[bb + 6], p[bb + 7]);
        const bf16x8 pa = __builtin_bit_cast(bf16x8, w);
        asm volatile("s_waitcnt lgkmcnt(0)" : "+v"(lo[0]), "+v"(lo[1]), "+v"(hi[0]), "+v"(hi[1]) :: "memory");
        __builtin_amdgcn_sched_barrier(0);
#pragma unroll
        for (int d0 = 0; d0 < 2; ++d0) { const bf16x8 vf = (bf16x8){lo[d0][0], lo[d0][1], lo[d0][2], lo[d0][3], hi[d0][0], hi[d0][1], hi[d0][2], hi[d0][3]};
            o[d0] = __builtin_amdgcn_mfma_f32_32x32x16_bf16(pa, vf, o[d0], 0, 0, 0); }
    }
}
template <int MT> __device__ __forceinline__ void mask_half(f32x16& p, int lim, int off) {
#pragma unroll
    for (int r = 0; r < 16; ++r) { const int c = (r & 3) + 8 * (r >> 2) + off;
        if (MT == 2) { if (!(c > lim)) p[r] = -INFINITY; } else { if (!(c <= lim)) p[r] = -INFINITY; } }
}
template <int MT> __device__ __forceinline__ void mask_tile(f32x16& p0, f32x16& p1, int lim) {
    if (MT == 0) return;
#pragma unroll
    for (int r = 0; r < 16; ++r) { const int c = (r & 3) + 8 * (r >> 2);
        if (MT == 2) { if (!(c > lim)) p0[r] = -INFINITY; if (!(c + 32 > lim)) p1[r] = -INFINITY; }
        else { if (!(c <= lim)) p0[r] = -INFINITY; if (!(c + 32 <= lim)) p1[r] = -INFINITY; } }
}
__device__ __forceinline__ void pv_tile(f32x16 (&o)[2], unsigned vbase, const f32x16& p0, const f32x16& p1) {
#pragma unroll
    for (int ks = 0; ks < 4; ++ks) {
        s16x4 lo[2], hi[2];
#pragma unroll
        for (int d0 = 0; d0 < 2; ++d0) { lo[d0] = vtr(vbase + d0 * 4096 + ks * 1024); hi[d0] = vtr(vbase + d0 * 4096 + ks * 1024 + 512); }
        const f32x16& P = (ks < 2) ? p0 : p1; const int b = (ks & 1) * 8;
        u32x4 w; w.x = cvt_pk_bf16(P[b + 0], P[b + 1]); w.y = cvt_pk_bf16(P[b + 2], P[b + 3]); w.z = cvt_pk_bf16(P[b + 4], P[b + 5]); w.w = cvt_pk_bf16(P[b + 6], P[b + 7]);
        const bf16x8 pa = __builtin_bit_cast(bf16x8, w);
        asm volatile("s_waitcnt lgkmcnt(0)" : "+v"(lo[0]), "+v"(lo[1]), "+v"(hi[0]), "+v"(hi[1]) :: "memory");
        __builtin_amdgcn_sched_barrier(0);
#pragma unroll
        for (int d0 = 0; d0 < 2; ++d0) { const bf16x8 vf = (bf16x8){lo[d0][0], lo[d0][1], lo[d0][2], lo[d0][3], hi[d0][0], hi[d0][1], hi[d0][2], hi[d0][3]};
            o[d0] = __builtin_amdgcn_mfma_f32_32x32x16_bf16(pa, vf, o[d0], 0, 0, 0); }
    }
}
__device__ __forceinline__ float max32(const f32x16& p0, const f32x16& p1) {
    float a = fmaxf(p0[0], p1[0]);
#pragma unroll
    for (int r = 1; r < 16; ++r) a = fmaxf(a, fmaxf(p0[r], p1[r]));
    return fmaxf(a, __shfl_xor(a, 32));
}
__device__ __forceinline__ void softmax_step(f32x16& p0, f32x16& p1, float sk, bool lv, float& m, float& l, f32x16 (&o)[2], LAS float* wsf, int r32, int hi) {
    const float rm = max32(p0, p1);
    const float rmt = lv ? rm + sk : -INFINITY;
    const float mn = fmaxf(m, rmt);
    const float mup = (mn == -INFINITY || !lv) ? INFINITY : mn - sk;
    const float f = (mn == -INFINITY) ? 1.f : __builtin_amdgcn_exp2f(m - mn);
    float s = 0.f;
#pragma unroll
    for (int r = 0; r < 16; ++r) { p0[r] = __builtin_amdgcn_exp2f(p0[r] - mup); p1[r] = __builtin_amdgcn_exp2f(p1[r] - mup); s += p0[r] + p1[r]; }
    l = l * f + s;
    if (__any(mn != m)) {
        if (hi == 0) wsf[r32] = f;
        LDS_WAIT();
#pragma unroll
        for (int a = 0; a < 4; ++a) { const f32x4 fv = *(const LAS f32x4*)(wsf + 8 * a + 4 * hi);
#pragma unroll
            for (int j = 0; j < 4; ++j) { o[0][4 * a + j] *= fv[j]; o[1][4 * a + j] *= fv[j]; } }
        LDS_WAIT();
    }
    m = mn;
}
template <bool FIRST>
__device__ __forceinline__ void accum_out(LAS float* stg, const f32x16 (&o)[2], float scale, LAS float* wsf, int r32, int hi) {
    if (hi == 0) wsf[r32] = scale;
    LDS_WAIT();
#pragma unroll
    for (int a = 0; a < 4; ++a) { const f32x4 fv = *(const LAS f32x4*)(wsf + 8 * a + 4 * hi);
#pragma unroll
        for (int j = 0; j < 4; ++j) { LAS float* p = stg + (j + 8 * a + 4 * hi) * 64 + r32;
            float v0 = o[0][4 * a + j] * fv[j], v1 = o[1][4 * a + j] * fv[j];
            if (!FIRST) { v0 += p[0]; v1 += p[32]; }
            p[0] = v0; p[32] = v1; } }
    LDS_WAIT();
}

#ifdef PROF_MODE
#define PROF_T0() const unsigned long long pt0_ = __builtin_amdgcn_s_memrealtime()
#define PROF_ACC() do { if (threadIdx.x == 0) { LAS unsigned* pa_ = (LAS unsigned*)(lds + MISC_OFF + 64); pa_[0] += (unsigned)(__builtin_amdgcn_s_memrealtime() - pt0_); } } while (0)
#else
#define PROF_T0() do {} while (0)
#define PROF_ACC() do {} while (0)
#endif
template <bool SEL>
__device__ __forceinline__ void att_branch(LAS unsigned char* lds, const bf16* Kb, const bf16* Vb, unsigned long long blocks, unsigned long long mysel, int qt, int t0, int ql,
                                           const bf16x8 (&qr)[4], unsigned spk, unsigned wpk0, unsigned wpk1, float& l, f32x16 (&o)[2], int wid, int lane_) {
    int lane = lane_; asm volatile("" : "+v"(lane));
    const int r32 = lane & 31, hi = lane >> 5;
    LAS float* wsf = (LAS float*)(lds + L_WS) + wid * 64;
    const unsigned vb0 = (unsigned)(uintptr_t)(lds + L_V) + ((lane >> 4) & 1) * 32 + (lane & 3) * 8 + (4 * hi + ((lane & 15) >> 2)) * 64;
#if defined(PROF_MODE) && PROF_MODE == 2
    PROF_T0();
#endif
    const int n = SEL ? __builtin_popcountll(blocks) : (qt < 8 ? qt + 1 : 9);
    unsigned long long rem = blocks; int wnext = qt, issued = 0;
    auto pop = [&]() -> int { if (issued >= n) return -1; ++issued; if (SEL) { const int j = 63 - __builtin_clzll(rem); rem &= ~(1ull << j); return j; } else return wnext--; };
    auto mineof = [&](int j) -> bool { return SEL ? (bool)((mysel >> j) & 1ull) : true; };
    int j0 = pop(), j1 = pop(), j2 = pop();
    dma_k(lds, 0, Kb, 768, j0 * 64, wid, lane); dma_v(lds, 0, Vb, 768, j0 * 64, wid, lane);
    if (j1 >= 0) { dma_k(lds, 1, Kb, 768, j1 * 64, wid, lane); dma_v(lds, 1, Vb, 768, j1 * 64, wid, lane); }
    if (j2 >= 0) { dma_k(lds, 2, Kb, 768, j2 * 64, wid, lane); dma_v(lds, 2, Vb, 768, j2 * 64, wid, lane); }
    float mhat = 0.f; unsigned rw2 = 0u, rw3 = 0u; l = 0.f; o[0] = (f32x16){0.f}; o[1] = (f32x16){0.f};
    f32x16 h0, h1;
    const unsigned one2 = hi ? 0u : 0x3f803f80u, one1 = hi ? 0u : 0x00003f80u;
#define ATT_QKH(P, j_, ks_, half_) do { const float Pf_ = (float)((j_) * 64 - t0); const unsigned ppk_ = hi ? 0u : cvt_pk_bf16(Pf_, Pf_); \
        qk_half_ext(P, lds + L_K + (ks_) * 8192, half_, qr, __builtin_bit_cast(bf16x8, (u32x4){spk, spk, rw2, rw3}), __builtin_bit_cast(bf16x8, (u32x4){ppk_, (half_) ? wpk1 : wpk0, one2, one1}), r32, hi); } while (0)
#define ATT_MASK(P, j_, m_, off_) do { \
        if ((j_) == qt) mask_half<1>(P, ql - 4 * hi, off_); else if (!SEL && (j_) == qt - 8) mask_half<2>(P, ql - 4 * hi, off_); \
        if (SEL && !__all(m_)) { _Pragma("unroll") for (int r = 0; r < 16; ++r) P[r] = (m_) ? P[r] : -INFINITY; } } while (0)
    wait_bar_n((j1 >= 0 ? 2 : 0) + (j2 >= 0 ? 2 : 0));
    ATT_QKH(h0, j0, 0, 0);
    int ks = 0, vs = 0; bool first = true;
    while (j0 >= 0) {
        const bool m0 = mineof(j0); const bool do0 = !SEL || __any(m0);
        if (do0) { ATT_QKH(h1, j0, ks, 1); __builtin_amdgcn_sched_barrier(0);
            ATT_MASK(h0, j0, m0, 0);
            if (first) softmax_half<true>(h0, h1, true, mhat, rw2, rw3, l, o, wsf, r32, hi); else softmax_half<false>(h0, h1, true, mhat, rw2, rw3, l, o, wsf, r32, hi);
            pv_half(o, vb0 + vs * 8192, 0, h0); }
#if defined(PROF_MODE) && PROF_MODE == 1
        { PROF_T0(); wait_bar_n((j2 >= 0 ? 2 : 0)); PROF_ACC(); }
#else
        wait_bar_n((j2 >= 0 ? 2 : 0));
#endif
        const int j3 = pop();
        if (j3 >= 0) { dma_k(lds, ks, Kb, 768, j3 * 64, wid, lane); dma_v(lds, (vs + 3) & 3, Vb, 768, j3 * 64, wid, lane); }
        bool m1 = false, do1 = false; if (j1 >= 0) { m1 = mineof(j1); do1 = !SEL || __any(m1); }
        const int ks1 = (ks == 2) ? 0 : ks + 1;
        if (do1) ATT_QKH(h0, j1, ks1, 0);
        __builtin_amdgcn_sched_barrier(0);
        if (do0) { ATT_MASK(h1, j0, m0, 32);
            softmax_half<false>(h1, h0, do1, mhat, rw2, rw3, l, o, wsf, r32, hi);
            pv_half(o, vb0 + vs * 8192, 1, h1); }
        j0 = j1; j1 = j2; j2 = j3; ks = ks1; vs = (vs + 1) & 3; first = false;
    }
#undef ATT_QKH
#undef ATT_MASK
    l += __shfl_xor(l, 32);
    wait_bar<0>();
#if defined(PROF_MODE) && PROF_MODE == 2
    PROF_ACC();
#endif
}

__device__ __forceinline__ void attn_unit(Frame& F, int b, int g, int qt, int lu) {
    LAS unsigned char* lds = F.lds;
    const int tid = F.tid, lane = F.lane, wid = F.wave, r32 = lane & 31, hi = lane >> 5, hr = wid >> 1, qh = wid & 1;
    const int head = g * 4 + hr, t0 = qt * 64, ql = qh * 32 + r32, tq = t0 + ql;
    const float slope2 = __builtin_amdgcn_exp2f(-(float)(head + 1)) * LOG2E;
    const size_t rowq = (size_t)b * SEQ + tq;
    const bf16* Qb = (const bf16*)(F.ws + WS_QB);
    const bf16* KVb = (const bf16*)(F.ws + WS_KVB) + (size_t)b * SEQ * 768;
    const bf16* KC = (const bf16*)(F.ws + WS_KC) + (size_t)(b * 2 + g) * 256 * 64;
    const bf16* VC = (const bf16*)(F.ws + WS_VC) + (size_t)(b * 2 + g) * 256 * 64;
    const float* NG = (const float*)(F.ws + WS_NG) + rowq * 32 + g * 12 + hr * 3;
    LAS float* wsf = (LAS float*)(lds + L_WS) + wid * 64;
    LAS unsigned* imp = (LAS unsigned*)(lds + L_IMP);
    LAS unsigned long long* sel = (LAS unsigned long long*)(lds + L_SEL);
    LAS unsigned long long* wun = (LAS unsigned long long*)(lds + L_WU);
    const unsigned vb0 = (unsigned)(uintptr_t)(lds + L_V) + ((lane >> 4) & 1) * 32 + (lane & 3) * 8 + (4 * hi + ((lane & 15) >> 2)) * 64;
    bf16x8 qr[4];
#pragma unroll
    for (int d0 = 0; d0 < 4; ++d0) qr[d0] = *(const bf16x8*)(Qb + rowq * 512 + head * 64 + d0 * 16 + hi * 8);
    LAS float* stg = (LAS float*)(lds + L_OST) + wid * 2048;
    const float gate_c = NG[0], gate_s = NG[1], gate_w = NG[2];
    f32x16 o[2], p0, p1;
    const bool need_imp = qt >= 8;
    const int ntc = min(4, (4 * qt + 2) / 64 + 1);
    const int nmax = (tq >= 31) ? ((tq - 31) >> 4) : -1;
#if defined(PROF_MODE) && (PROF_MODE == 3 || PROF_MODE == 5)
    PROF_T0();
#endif
    unsigned spk, wpk0, wpk1;
    { const unsigned sh = cvt_pk_bf16(slope2, 0.f) & 0xffffu; const float shf = __uint_as_float(sh << 16); spk = hi ? 0u : (sh | (cvt_pk_bf16(0.f, slope2 - shf) & 0xffff0000u));
      wpk0 = hi ? 0u : cvt_pk_bf16((float)r32, (float)r32); wpk1 = hi ? 0u : cvt_pk_bf16((float)(r32 + 32), (float)(r32 + 32)); }
    const unsigned wc0 = hi ? 0u : cvt_pk_bf16((float)(16 * r32), (float)(16 * r32)), wc1 = hi ? 0u : cvt_pk_bf16((float)(16 * r32 + 512), (float)(16 * r32 + 512));
    const unsigned cone2 = hi ? 0u : 0x3f803f80u, cone1 = hi ? 0u : 0x00003f80u;
    float l = 0.f, mhat = 0.f;
    o[0] = (f32x16){0.f}; o[1] = (f32x16){0.f};
    float gacc[4][8], lacc[4][8];
    dma_tile<true>(lds, 0, KC, VC, 64, 0, wid, lane);
    if (ntc > 1) dma_tile<true>(lds, 1, KC, VC, 64, 64, wid, lane);
    for (int i = tid; i < 64 * 65; i += 512) imp[i] = 0u;
#pragma unroll
    for (int it = 0; it < 4; ++it) {
        if (it < ntc) {
            const int sl = (it == 3) ? 0 : it;
            if (it + 1 < ntc) wait_bar<2>(); else wait_bar<0>();
            if (it + 2 < ntc) dma_tile<true>(lds, (it + 2 == 3) ? 0 : it + 2, KC, VC, 64, (it + 2) * 64, wid, lane);
            { const float Pf = (float)(1024 * it - t0); const unsigned ppk = hi ? 0u : cvt_pk_bf16(Pf, Pf);
              const bf16x8 qx = __builtin_bit_cast(bf16x8, (u32x4){spk, spk, 0u, 0u});
              qk_half_ext(p0, lds + L_K + sl * 8192, 0, qr, qx, __builtin_bit_cast(bf16x8, (u32x4){ppk, wc0, cone2, cone1}), r32, hi);
              qk_half_ext(p1, lds + L_K + sl * 8192, 1, qr, qx, __builtin_bit_cast(bf16x8, (u32x4){ppk, wc1, cone2, cone1}), r32, hi); }
            if (64 * it + 63 > 4 * qt - 2) mask_tile<3>(p0, p1, nmax - 64 * it - 4 * hi);
            const float sk = 0.f;
            const float rm = max32(p0, p1) + sk;
            if (it == 0) mhat = (rm == -INFINITY) ? 0.f : rm;
            else if (__any(rm > mhat + 8.f)) {
                const float dl = (rm > mhat + 8.f) ? rm - mhat : 0.f; mhat += dl;
                const float f = __builtin_amdgcn_exp2f(-dl); l *= f;
#pragma unroll
                for (int t2 = 0; t2 < 4; ++t2) if (t2 < it) {
#pragma unroll
                    for (int a = 0; a < 8; ++a) { gacc[t2][a] *= f; lacc[t2][a] *= f; } }
                if (hi == 0) wsf[r32] = f;
                LDS_WAIT();
#pragma unroll
                for (int a = 0; a < 4; ++a) { const f32x4 fv = *(const LAS f32x4*)(wsf + 8 * a + 4 * hi);
#pragma unroll
                    for (int j = 0; j < 4; ++j) { o[0][4 * a + j] *= fv[j]; o[1][4 * a + j] *= fv[j]; } }
                LDS_WAIT();
            }
            const float mup = mhat - sk; float s = 0.f;
#pragma unroll
            for (int r = 0; r < 16; ++r) { p0[r] = __builtin_amdgcn_exp2f(p0[r] - mup); p1[r] = __builtin_amdgcn_exp2f(p1[r] - mup); s += p0[r] + p1[r]; }
            l += s;
#pragma unroll
            for (int a = 0; a < 4; ++a) { gacc[it][a] = (p0[4 * a] + p0[4 * a + 1]) + (p0[4 * a + 2] + p0[4 * a + 3]); gacc[it][4 + a] = (p1[4 * a] + p1[4 * a + 1]) + (p1[4 * a + 2] + p1[4 * a + 3]);
                lacc[it][a] = p0[4 * a + 3]; lacc[it][4 + a] = p1[4 * a + 3]; }
            pv_tile(o, vb0 + sl * 8192, p0, p1);
        }
    }
    l += __shfl_xor(l, 32);
    const float inv_lc = (l > 0.f) ? 1.0f / l : 0.f;
    if (need_imp) { const float sc = inv_lc * 134217728.f;
#pragma unroll
        for (int it = 0; it < 4; ++it) if (it < ntc) {
#pragma unroll
            for (int a = 0; a < 4; ++a) { const int j0 = 16 * it + 2 * a + hi, j1 = j0 + 8;
                __hip_atomic_fetch_add(&imp[ql * 65 + j0], (unsigned)(gacc[it][a] * sc + 0.5f), __ATOMIC_RELAXED, __HIP_MEMORY_SCOPE_WORKGROUP);
                __hip_atomic_fetch_add(&imp[ql * 65 + j1], (unsigned)(gacc[it][4 + a] * sc + 0.5f), __ATOMIC_RELAXED, __HIP_MEMORY_SCOPE_WORKGROUP);
                __hip_atomic_fetch_add(&imp[ql * 65 + j0 + 1], (unsigned)(lacc[it][a] * sc + 0.5f), __ATOMIC_RELAXED, __HIP_MEMORY_SCOPE_WORKGROUP);
                if (j1 + 1 < 64) __hip_atomic_fetch_add(&imp[ql * 65 + j1 + 1], (unsigned)(lacc[it][4 + a] * sc + 0.5f), __ATOMIC_RELAXED, __HIP_MEMORY_SCOPE_WORKGROUP); } } }
    wait_bar<0>();
#if defined(PROF_MODE) && PROF_MODE == 3
    PROF_ACC();
#endif
#if defined(PROF_MODE) && PROF_MODE == 4
    PROF_T0();
#endif
#ifndef LATE_TWO
#define LATE_TWO 0
#endif
    f32x4 lv0[16], lv1[16];
#ifndef LATE_IN_P0
    const int lit0 = __builtin_amdgcn_readfirstlane(lu * 16 + wid), lit1 = lit0 + 8;
    { int ln = lane; asm volatile("" : "+v"(ln)); const LateD d0 = late_desc(F, lit0, ln); late_load(d0, lv0);
#if LATE_TWO
      const LateD d1 = late_desc(F, lit1, ln); late_load(d1, lv1);
#endif
    }
#endif
    unsigned long long mysel, uni;
    if (need_imp) {
        int lk = (int)__builtin_amdgcn_mbcnt_hi(~0u, __builtin_amdgcn_mbcnt_lo(~0u, 0u)); asm volatile("" : "+v"(lk));
        int key[8]; unsigned long long msk[8];
#pragma unroll
        for (int qq = 0; qq < 8; ++qq) { const int q = wid * 8 + qq;
            key[qq] = (lk >= 1 && lk <= qt - 2) ? (int)(((imp[q * 65 + lk] >> 4) << 6) | (unsigned)(63 - lk)) : -1;
            msk[qq] = 1ull | (1ull << qt) | (1ull << (qt - 1)); }
#pragma unroll 1
        for (int k = 0; k < 5; ++k) {
            int mx[8];
#pragma unroll
            for (int qq = 0; qq < 8; ++qq) mx[qq] = key[qq];
#pragma unroll
            for (int o2 = 1; o2 < 64; o2 <<= 1) {
#pragma unroll
                for (int qq = 0; qq < 8; ++qq) mx[qq] = max(mx[qq], __shfl_xor(mx[qq], o2)); }
#pragma unroll
            for (int qq = 0; qq < 8; ++qq) { const int js = 63 - (mx[qq] & 63); msk[qq] |= 1ull << js; if (lk == js) key[qq] = -2; }
        }
        unsigned long long wu = 0ull;
#pragma unroll
        for (int qq = 0; qq < 8; ++qq) { if (lk == 0) sel[wid * 8 + qq] = msk[qq]; wu |= msk[qq]; }
        if (lk == 0) wun[wid] = wu;
        wait_bar<0>();
        mysel = sel[ql]; uni = 0ull;
#pragma unroll
        for (int w = 0; w < 8; ++w) uni |= wun[w];
    } else { mysel = (2ull << qt) - 1ull; uni = mysel; }
#if defined(PROF_MODE) && PROF_MODE == 4
    PROF_ACC();
#endif
    uni = ((unsigned long long)__builtin_amdgcn_readfirstlane((unsigned)(uni >> 32)) << 32) | (unsigned long long)__builtin_amdgcn_readfirstlane((unsigned)uni);
#ifndef LATE_IN_P0
#if defined(PROF_MODE) && PROF_MODE == 7
    PROF_T0();
#endif
    { int ln = lane; asm volatile("" : "+v"(ln)); const LateD d0 = late_desc(F, lit0, ln); late_finish(F, d0, lv0); const LateD d1 = late_desc(F, lit1, ln);
#if !LATE_TWO
      late_load(d1, lv1);
#endif
      late_finish(F, d1, lv1); }
#if defined(PROF_MODE) && PROF_MODE == 7
    asm volatile("s_waitcnt vmcnt(0)" ::: "memory"); PROF_ACC();
#endif
#endif
    accum_out<true>(stg, o, ABLF(4) (gate_c * inv_lc), wsf, r32, hi);
    att_branch<true>(lds, KVb + 2 * 128 + g * 64, KVb + 3 * 128 + g * 64, uni, mysel, qt, t0, ql, qr, spk, wpk0, wpk1, l, o, wid, lane);
    accum_out<false>(stg, o, ABLF(5) ((l > 0.f) ? gate_s / l : 0.f), wsf, r32, hi);
    att_branch<false>(lds, KVb + 4 * 128 + g * 64, KVb + 5 * 128 + g * 64, 0ull, 0ull, qt, t0, ql, qr, spk, wpk0, wpk1, l, o, wid, lane);
    accum_out<false>(stg, o, ABLF(6) ((l > 0.f) ? gate_w / l : 0.f), wsf, r32, hi);
    {
        bf16* Ow = (bf16*)(F.ws + WS_AC) + ((size_t)b * SEQ + t0 + qh * 32) * 1024 + head * 64;
#pragma unroll
        for (int i = 0; i < 4; ++i) { const int row = i * 8 + (lane >> 3), ch = lane & 7;
            const f32x4 v0 = *(const LAS f32x4*)(stg + row * 64 + ch * 8), v1 = *(const LAS f32x4*)(stg + row * 64 + ch * 8 + 4);
#if defined(ABL) && ABL == 1
            *(u32x4*)(Ow + (unsigned)(row * 1024 + ch * 8)) = (u32x4){0u, 0u, 0u, 0u}; }
#else
            st_wt16(Ow + (unsigned)(row * 1024 + ch * 8), pack8(v0, v1)); }
#endif
    }
    wait_bar<0>();
#if defined(PROF_MODE) && PROF_MODE == 5
    PROF_ACC();
#endif
}

__device__ __forceinline__ void attn_phase(Frame& F, int rep) {
    LAS int* qw = (LAS int*)(F.lds + MISC_OFF + 128);
    for (int i = F.tid; i < 1024; i += NWAVES * 64) ((LAS float*)(F.lds + L_GAIN))[i] = F.inp(17)[i];
    __syncthreads();
#if ATT_XCD_QUEUES
    { const int x0 = (int)(xb_xcc_id() & 7u);
      for (int hop = 0; hop < 8; ++hop) { const int xq = (x0 + hop) & 7;
        for (;;) {
            if (F.tid == 0) qw[0] = (int)__hip_atomic_fetch_add(F.ctl + CW_QX + 64 * (xq + 8 * rep), 1u, RLX_AGENT);
            __syncthreads();
            const int u = qw[0];
            __syncthreads();
            if (u >= 128) break;
            const int qt = 63 - (u >> 1), bg = 2 * xq + (u & 1); attn_unit(F, bg >> 1, bg & 1, qt, 1 << 20);
        } } }
#else
    for (;;) {
        if (F.tid == 0) qw[0] = (int)__hip_atomic_fetch_add(F.ctl + CW_QATT + 16 * rep, 1u, RLX_AGENT);
        __syncthreads();
        const int u = qw[0];
        __syncthreads();
        if (u >= 1024) break;
        const int qt = 63 - (u >> 4), bg = u & 15; attn_unit(F, bg >> 1, bg & 1, qt, u);
    }
#endif
    ConvW cwv; conv_weights(F, cwv);
    for (;;) {
        if (F.tid == 0) qw[0] = (int)__hip_atomic_fetch_add(F.ctl + CW_QATT + 32 + 16 * rep, 2u, RLX_AGENT);
        __syncthreads();
        const int u = qw[0];
        __syncthreads();
        if (u >= 1024) break;
        conv_unit(F, u, cwv); conv_unit(F, u + 1, cwv);
    }
#ifdef CONV_REP
    for (;;) {
        if (F.tid == 0) qw[0] = (int)__hip_atomic_fetch_add(F.ctl + CW_QATT + 48, 1u, RLX_AGENT);
        __syncthreads();
        const int u = qw[0];
        __syncthreads();
        if (u >= 1024) break;
        conv_unit(F, u, cwv);
    }
#endif
}
}
#ifndef X1_IN_WS
#define X1_IN_WS 0
#endif
#if X1_IN_WS
#define X1_OFF WS_X1
#else
#define X1_OFF ((size_t)((unsigned char*)F.out - F.ws))
#endif

__device__ __forceinline__ void p6_router(Frame& F, int rep = 0) {
    const int lane = F.lane, i16 = lane & 15, kq = lane >> 4;
    const bf16* XB = (const bf16*)(F.ws + X1_OFF); const bf16* WR = (const bf16*)(F.ws + WS_WR);
    int* list = (int*)(F.ws + (rep ? WS_GLU : WS_LIST)); float* wt = (float*)(F.ws + WS_WT); float* listw = (float*)(F.ws + WS_LISTW); float* listr = (float*)(F.ws + WS_LISTR); const int cwc = rep ? 8192 : CW_CNT; float* rstd2 = (float*)(F.ws + WS_RSTD2);
    LAS float* lg = (LAS float*)(F.lds + F.wave * 3072);
    LAS unsigned* hist = (LAS unsigned*)(F.lds + 24576); LAS unsigned* base = hist + 32;
    constexpr int WRP = 2064; LAS unsigned char* wrl = F.lds + 25600;
    for (int i = F.tid; i < 48 * 128; i += NWAVES * 64) { const int r = i >> 7, ch = i & 127, sr = r < 16 ? r : r + 16;
        *(LAS u32x4*)(wrl + r * WRP + ch * 16) = *(const u32x4*)(WR + (size_t)sr * 1024 + ch * 8); }
    __syncthreads();
    const int gw = F.vcu * NWAVES + F.wave, NGW = F.G * NWAVES, niter = (T / 16 + NGW - 1) / NGW;
    for (int itr = 0; itr < niter; ++itr) {
        const int grp = itr * NGW + gw; const bool live = grp < T / 16;
        if (F.tid < 32) hist[F.tid] = 0u;
        int ea = 0, eb = 0, tok = 0; float w0 = 0.f, w1 = 0.f, rstd = 0.f;
        if (live) {
            const size_t row = (size_t)grp * 16 + i16;
            f32x4 acc0 = (f32x4){0.f, 0.f, 0.f, 0.f}, acc2 = acc0, acc3 = acc0; float ssq = 0.f;
#pragma unroll 16
            for (int s = 0; s < 32; ++s) {
                const u32x4 w = *(const u32x4*)(XB + row * 1024 + s * 32 + kq * 8);
                f32x4 a0, a1; unpack8(w, a0, a1);
                ssq += (a0[0] * a0[0] + a0[1] * a0[1]) + (a0[2] * a0[2] + a0[3] * a0[3]) + (a1[0] * a1[0] + a1[1] * a1[1]) + (a1[2] * a1[2] + a1[3] * a1[3]);
                const bf16x8 a = __builtin_bit_cast(bf16x8, w);
                const bf16x8 b0 = *(const LAS bf16x8*)(wrl + i16 * WRP + s * 64 + kq * 16);
                const bf16x8 b2 = *(const LAS bf16x8*)(wrl + (16 + i16) * WRP + s * 64 + kq * 16);
                const bf16x8 b3 = *(const LAS bf16x8*)(wrl + (32 + i16) * WRP + s * 64 + kq * 16);
                acc0 = __builtin_amdgcn_mfma_f32_16x16x32_bf16(a, b0, acc0, 0, 0, 0);
                acc2 = __builtin_amdgcn_mfma_f32_16x16x32_bf16(a, b2, acc2, 0, 0, 0);
                acc3 = __builtin_amdgcn_mfma_f32_16x16x32_bf16(a, b3, acc3, 0, 0, 0);
            }
            ssq += __shfl_xor(ssq, 16); ssq += __shfl_xor(ssq, 32);
            rstd = 1.0f / sqrtf(ssq * (1.f / 1024.f) + EPS);
#pragma unroll
            for (int r = 0; r < 4; ++r) { lg[(kq * 4 + r) * 48 + i16] = acc0[r]; lg[(kq * 4 + r) * 48 + 16 + i16] = acc2[r]; lg[(kq * 4 + r) * 48 + 32 + i16] = acc3[r]; }
            LDS_WAIT();
            if (lane < 16) {
                tok = grp * 16 + lane;
                float g4[4];
#pragma unroll
                for (int c = 0; c < 4; ++c) g4[c] = lg[lane * 48 + c] * rstd + F.inp(19)[c];
                int gs = 0; float gm = g4[0];
#pragma unroll
                for (int c = 1; c < 4; ++c) if (g4[c] > gm) { gm = g4[c]; gs = c; }
                float den = 0.f;
#pragma unroll
                for (int c = 0; c < 4; ++c) den += __builtin_amdgcn_exp2f((g4[c] - gm) * LOG2E);
                const float pg = 1.0f / den;
                float e8[8];
#pragma unroll
                for (int c = 0; c < 8; ++c) e8[c] = lg[lane * 48 + 16 + gs * 8 + c] * rstd + F.inp(21)[gs * 8 + c];
                int i1 = 0; float m1 = e8[0];
#pragma unroll
                for (int c = 1; c < 8; ++c) if (e8[c] > m1) { m1 = e8[c]; i1 = c; }
                int i2 = -1; float m2 = -INFINITY;
#pragma unroll
                for (int c = 0; c < 8; ++c) if (c != i1 && e8[c] > m2) { m2 = e8[c]; i2 = c; }
                const float ex = __builtin_amdgcn_exp2f((m2 - m1) * LOG2E);
                w0 = pg / (1.f + ex); w1 = pg * ex / (1.f + ex);
                ea = gs * 8 + i1; eb = gs * 8 + i2;
            }
        }
        __syncthreads();
        unsigned ra = 0u, rb = 0u;
        if (live && lane < 16) { ra = __hip_atomic_fetch_add(hist + ea, 1u, __ATOMIC_RELAXED, __HIP_MEMORY_SCOPE_WORKGROUP); rb = __hip_atomic_fetch_add(hist + eb, 1u, __ATOMIC_RELAXED, __HIP_MEMORY_SCOPE_WORKGROUP); }
        __syncthreads();
        if (F.tid < 32) { const unsigned h = hist[F.tid]; base[F.tid] = h ? __hip_atomic_fetch_add(F.ctl + cwc + 64 * F.tid, h, RLX_AGENT) : 0u; }
        __syncthreads();
        if (live && lane < 16) {
            const int pa = ea * LISTCAP + base[ea] + ra, pb = eb * LISTCAP + base[eb] + rb;
            list[pa] = tok * 2; list[pb] = tok * 2 + 1; if (!rep) { listw[pa] = w0; listw[pb] = w1; listr[pa] = rstd; listr[pb] = rstd; }
            wt[tok * 2] = w0; wt[tok * 2 + 1] = w1; rstd2[tok] = rstd;
        }
        __syncthreads();
    }
}

__device__ __forceinline__ void moe_table(Frame& F) {
    LAS int* tab = (LAS int*)(F.lds + MOE_OFF);
    if (F.tid < 32) tab[33 + F.tid] = (int)__hip_atomic_load(F.ctl + CW_CNT + 64 * F.tid, RLX_AGENT);
    __syncthreads();
    if (F.tid < 32) {
        const int e = F.tid, cnt = tab[33 + e], rem = cnt & 255;
        int ts = 0, fb = 0, nfull = 0, rank = 0;
        for (int k = 0; k < 32; ++k) { const int ck = tab[33 + k], rk = ck & 255;
            if (k < e) { ts += (ck + 255) >> 8; fb += ck >> 8; }
            nfull += ck >> 8;
            if (rk && (rk > rem || (rk == rem && k < e))) ++rank; }
        tab[e] = ts;
        for (int k = 0; k < (cnt >> 8); ++k) tab[80 + fb + k] = (ts + k) | (e << 16);
        if (rem) tab[80 + nfull + rank] = (ts + (cnt >> 8)) | (e << 16);
        if (e == 31) tab[32] = ts + ((cnt + 255) >> 8);
    }
    __syncthreads();
}

__device__ __forceinline__ void p9_combine(Frame& F) {
    const int lane = F.lane; const int gw = F.vcu * NWAVES + F.wave, NGW = F.G * NWAVES;
    const bf16* Y = (const bf16*)(F.ws + WS_Y); const bf16* X1 = (const bf16*)(F.ws + X1_OFF); bf16* XB = (bf16*)(F.ws + WS_XN); float* rstd3 = (float*)(F.ws + WS_RSTD3);
#pragma unroll 2
    for (int m = gw; m < T; m += NGW) {
        const u32x4* xr = (const u32x4*)(X1 + (size_t)m * DM) + lane;
        const u32x2* y0 = (const u32x2*)((const unsigned char*)Y + (size_t)(2 * m) * DM) + lane; const u32x2* y1 = (const u32x2*)((const unsigned char*)Y + (size_t)(2 * m + 1) * DM) + lane;
        u32x4* ob = (u32x4*)(XB + (size_t)m * DM) + lane; u32x2* o8 = (u32x2*)(F.ws + WS_X1F8 + (size_t)m * DM) + lane;
        float s = 0.f;
#pragma unroll
        for (int j = 0; j < 2; ++j) { f32x4 v0, v1, a0, a1, b0, b1; unpack8(xr[64 * j], v0, v1); unpack8_fp8(y0[64 * j], a0, a1); unpack8_fp8(y1[64 * j], b0, b1);
            v0 += (a0 + b0) * 0.0625f; v1 += (a1 + b1) * 0.0625f;
            const u32x4 w = pack8(v0, v1); st_wt16(ob + 64 * j, w); unpack8(w, v0, v1); if (P10_FP8) o8[64 * j] = pack8_fp8(v0 * 16.f, v1 * 16.f);
            s += (v0[0] * v0[0] + v0[1] * v0[1]) + (v0[2] * v0[2] + v0[3] * v0[3]) + (v1[0] * v1[0] + v1[1] * v1[1]) + (v1[2] * v1[2] + v1[3] * v1[3]); }
        s = wave_sum(s);
        if (lane == 0) rstd3[m] = 1.0f / sqrtf(s * (1.f / DM) + EPS);
    }
}

__device__ __forceinline__ void ph1(Frame& F, unsigned char* ws, int cid) {
#ifndef X_NO_P1A
    { pg8::Gemm g{(const bf16*)(ws + WS_XN), (const bf16*)(ws + WS_WIN), 1024}; pg8::StaticOrder S; S.init(T, 8 * 256, F.G, cid);
      EpiWin<0> E{(bf16*)(ws + WS_QB), (bf16*)(ws + WS_KVB), (bf16*)(ws + WS_GLU), (bf16*)(ws + WS_MG), (float*)(ws + WS_NG), F.inp(4), F.inp(5), F.inp(15), 1.f};
      pg8::gemm_phase<EpiWin<0>, pg8::StaticOrder, P1_ALIGN>(F.lds, g, S, E); }
#endif
#ifndef X_NO_P1B
    { pg8::Gemm g{(const bf16*)(ws + WS_XN8), (const bf16*)(ws + WS_WIN8), 512}; pg8::StaticOrderF8 S; S.init(T, 10 * 256, F.G, cid); S.pbase = 8; S.bown = true;
      EpiWin<1> E{(bf16*)(ws + WS_QB), (bf16*)(ws + WS_KVB), (bf16*)(ws + WS_GLU), (bf16*)(ws + WS_MG), (float*)(ws + WS_NG), F.inp(4), F.inp(5), F.inp(15), 1.f / 512.f};
      pg8::gemm_phase<EpiWin<1>, pg8::StaticOrderF8, P1_ALIGN>(F.lds, g, S, E); }
#endif
}
__device__ __forceinline__ void ph4(Frame& F, unsigned char* ws, int cid) {
    pg8::Gemm g{(const bf16*)(ws + WS_AC), (const bf16*)(ws + WS_WAC), 1024}; pg8::StaticOrder S; S.init(T, 1024, F.G, cid);
    EpiMerge E{(const bf16*)(ws + WS_MG), (bf16*)(ws + WS_XN), F.lds};
    pg8::gemm_phase<EpiMerge, pg8::StaticOrder, true>(F.lds, g, S, E);
}
__device__ __forceinline__ void ph5_wo(Frame& F, unsigned char* ws, int cid) {
    pg8::Gemm g{(const bf16*)(ws + WS_XN), (const bf16*)(ws + WS_WO), 1024}; pg8::StaticOrder S; S.init(T, 1024, F.G, cid);
    EpiWo E{F.inp(0), (bf16*)(ws + X1_OFF), ws + WS_X1F8, (const bf16*)F.out + (size_t)T * DM};
    pg8::gemm_phase<EpiWo, pg8::StaticOrder, true>(F.lds, g, S, E);
}
__device__ __forceinline__ void ph5_pp(Frame& F, unsigned char* ws, int cid) {
    pg8::Gemm g{(const bf16*)(ws + WS_PBF), (const bf16*)(ws + WS_WPP), 256}; pg8::StaticOrder S; S.init(T, 1024, F.G, cid);
    EpiBf E{(bf16*)(ws + WS_PP), 1024};
    pg8::gemm_phase<EpiBf, pg8::StaticOrder, true>(F.lds, g, S, E);
}
__device__ __forceinline__ void ph5(Frame& F, unsigned char* ws, int cid) {
    if ((cid >> 3) & 1) { ph5_pp(F, ws, cid); ph5_wo(F, ws, cid); } else { ph5_wo(F, ws, cid); ph5_pp(F, ws, cid); }
}
__device__ __forceinline__ void ph7(Frame& F, unsigned char* ws, int cid) {
    moe_table(F);
    pg8::Gemm g{(const bf16*)(ws + WS_X1F8), (const bf16*)(ws + WS_WGU), 512};
    LAS int* rowtab = (LAS int*)(F.lds + LDSCTL_OFF + 4096);
    MoeOrder<true> S{(const LAS int*)(F.lds + MOE_OFF), (const int*)(ws + WS_LIST), F.G, cid, F.ctl + CW_Q7, (LAS int*)(F.lds + MOE_OFF + 2048), rowtab};
    for (int i = 0; i < 8; ++i) { pg8::Unit u; if (!S.next(i, u)) break;
        if (F.tid < 256) rowtab[i * 256 + F.tid] = ((const int*)(ws + WS_LIST))[u.e * LISTCAP + u.lp + (F.tid < u.nrow ? F.tid : u.nrow - 1)] >> 1; }
    __syncthreads();
    EpiGU E{(bf16*)(ws + WS_H), (const int*)(ws + WS_LIST), (const float*)(ws + WS_LISTR)};
    pg8::gemm_phase<EpiGU, MoeOrder<true>, true>(F.lds, g, S, E);
}
__device__ __forceinline__ void ph8(Frame& F, unsigned char* ws, int cid) {
    moe_table(F);
    pg8::Gemm g{(const bf16*)(ws + WS_H), (const bf16*)(ws + WS_WD), 256};
    MoeOrder<false> S{(const LAS int*)(F.lds + MOE_OFF), (const int*)(ws + WS_LIST), F.G, cid, F.ctl + CW_Q8, (LAS int*)(F.lds + MOE_OFF + 2048), nullptr};
    EpiDown E{(bf16*)(ws + WS_Y), (const int*)(ws + WS_LIST), (const float*)(ws + WS_LISTW)};
    pg8::gemm_phase<EpiDown, MoeOrder<false>, true>(F.lds, g, S, E);
}
__device__ __forceinline__ void ph10(Frame& F, unsigned char* ws, int cid) {
#ifdef STAGGER_US
    if ((cid >> 3) & 1) { const unsigned long long t0_ = __builtin_amdgcn_s_memrealtime(); while (__builtin_amdgcn_s_memrealtime() - t0_ < (unsigned long long)(STAGGER_US * 100)) __builtin_amdgcn_s_sleep(8); }
#endif
    EpiPle E{F.out, (const bf16*)(ws + WS_XN), (const bf16*)(ws + WS_PP), (const float*)(ws + WS_RSTD3), F.inp(27), (float*)(ws + WS_Y)};
#if P10_FP8
    pg8::Gemm g{(const bf16*)(ws + WS_X1F8), (const bf16*)(ws + WS_WPG), 512}; pg8::StaticOrderF8 S; S.init(T, 1024, F.G, cid);
    pg8::gemm_phase<EpiPle, pg8::StaticOrderF8, true>(F.lds, g, S, E);
#else
    pg8::Gemm g{(const bf16*)(ws + WS_XN), (const bf16*)(ws + WS_WPG), 1024}; pg8::StaticOrder S; S.init(T, 1024, F.G, cid);
    pg8::gemm_phase<EpiPle, pg8::StaticOrder, true>(F.lds, g, S, E);
#endif
}

#ifdef CHECK
constexpr int CW_CHK = 3072;
constexpr int NCHK = 24;
__device__ __forceinline__ int chk_token(int s) {
    const int fixed[16] = {0, 1, 29, 30, 31, 63, 64, 4095, 4096, 4097, 4126, 8191, 12288, 20000, 32767, 16384 + 33};
    return s < 16 ? fixed[s] : (int)(((unsigned)s * 2654435761u) % (unsigned)T);
}
__device__ __forceinline__ void chk_report(Frame& F, int k, float err) {
    if (!(err >= 0.f)) err = 1e30f;
    atomicMax((unsigned*)(F.ctl + CW_CHK + k), __float_as_uint(err));
}
__device__ __forceinline__ float block_sum(Frame& F, float v, LAS float* red) {
    v = wave_sum(v); __syncthreads(); if (F.lane == 0) red[F.wave] = v; __syncthreads();
    float s = 0.f; for (int w = 0; w < 8; ++w) s += red[w]; __syncthreads(); return s;
}
__device__ __forceinline__ float bfv(const bf16* p, size_t i) { return __uint_as_float((unsigned)p[i] << 16); }

__device__ void chk_p1(Frame& F) {
    const int s = blockIdx.x; if (s >= 64) return;
    const int t = chk_token(s), tid = F.tid;
    LAS float* h = (LAS float*)F.lds; LAS float* z = h + 1024; LAS float* red = z + 4608;
    const float* x = F.inp(0) + (size_t)t * 1024; const float* W = F.inp(3);
    float ss = 0.f; for (int k = tid; k < 1024; k += 512) ss += x[k] * x[k];
    ss = block_sum(F, ss, red); const float rstd = 1.0f / sqrtf(ss / 1024.f + EPS);
    for (int k = tid; k < 1024; k += 512) h[k] = x[k] * rstd * F.inp(2)[k];
    __syncthreads();
    for (int c = tid; c < NIN; c += 512) { float a = 0.f; for (int k = 0; k < 1024; ++k) a += h[k] * W[(size_t)k * NIN + c]; z[c] = a; }
    __syncthreads();
    const bf16* Qb = (const bf16*)(F.ws + WS_QB); const bf16* KVb = (const bf16*)(F.ws + WS_KVB); const bf16* GLU = (const bf16*)(F.ws + WS_GLU); const bf16* MG = (const bf16*)(F.ws + WS_MG); const float* NG = (const float*)(F.ws + WS_NG);
    { const int c = tid, hd = c >> 6; float q2 = 0.f; for (int d = 0; d < 64; ++d) q2 += z[hd * 64 + d] * z[hd * 64 + d];
      const float e = z[c] / sqrtf(q2 / 64.f + EPS) * F.inp(4)[c & 63] * QC2; chk_report(F, 1, fabsf(e - bfv(Qb, (size_t)t * 512 + c))); }
    for (int c = tid; c < 768; c += 512) { const int i = c >> 7, grp = c >> 6; float e = z[OFF_KV + c];
        if (i == 2 || i == 4) { float q2 = 0.f; for (int d = 0; d < 64; ++d) q2 += z[OFF_KV + grp * 64 + d] * z[OFF_KV + grp * 64 + d]; e = e / sqrtf(q2 / 64.f + EPS) * F.inp(5)[(i == 2 ? 64 : 128) + (c & 63)]; }
        chk_report(F, 2, fabsf(e - bfv(KVb, (size_t)t * 768 + c))); }
    { const int c = tid; const float e = z[OFF_CONV + c] / (1.f + expf(-z[OFF_CONV + 512 + c])); chk_report(F, 3, fabsf(e - bfv(GLU, (size_t)t * 512 + c))); }
#ifdef MG_RAW
    for (int c = tid; c < 2048; c += 512) { const float e = z[OFF_MERGE + c];
#else
    for (int c = tid; c < 2048; c += 512) { const float e = 1.f / (1.f + expf(-(z[OFF_MERGE + c] + F.inp(15)[c])));
#endif
        const float er = fabsf(e - bfv(MG, (size_t)t * 2048 + c)); chk_report(F, 4, er); if (er > 0.08f) atomicMax((unsigned*)(F.ctl + CW_CHK + 40 + s), 1u); }
    if (tid < 24) { const float e = 1.f / (1.f + expf(-z[OFF_GATE + tid])); chk_report(F, 5, fabsf(e - NG[(size_t)t * 32 + tid])); }
    __syncthreads();
}
__device__ void chk_conv(Frame& F) {
    const int s = blockIdx.x; if (s >= 64) return;
    const int t = chk_token(s), tid = F.tid, sp = t & (SEQ - 1);
    LAS float* red = (LAS float*)F.lds;
    const bf16* GLU = (const bf16*)(F.ws + WS_GLU);
    float a = F.inp(11)[tid];
    for (int j = 0; j < 31; ++j) { const int sq = sp - 30 + j; if (sq >= 0) a += F.inp(10)[j * 512 + tid] * bfv(GLU, (size_t)(t - 30 + j) * 512 + tid); }
    const float mu = block_sum(F, a, red) / 512.f; const float d = a - mu; const float var = block_sum(F, d * d, red) / 512.f;
    float y = d / sqrtf(var + EPS) * F.inp(12)[tid] + F.inp(13)[tid]; y = y / (1.f + expf(-y));
    chk_report(F, 6, fabsf(y - bfv((const bf16*)(F.ws + WS_AC), (size_t)t * 1024 + 512 + tid)));
}
__device__ void chk_merge(Frame& F) {
    const int s = blockIdx.x; if (s >= 64) return;
    const int t = chk_token(s), tid = F.tid;
    const bf16* AC = (const bf16*)(F.ws + WS_AC); const bf16* MG = (const bf16*)(F.ws + WS_MG); const bf16* MER = (const bf16*)(F.ws + WS_XN);
    for (int c = tid; c < 1024; c += 512) { float ya = 0.f, yc = 0.f;
        for (int k = 0; k < 512; ++k) { ya += bfv(AC, (size_t)t * 1024 + k) * F.inp(9)[(size_t)k * 1024 + c]; yc += bfv(AC, (size_t)t * 1024 + 512 + k) * F.inp(14)[(size_t)k * 1024 + c]; }
        const float e = bfv(MG, (size_t)t * 2048 + c) * ya + bfv(MG, (size_t)t * 2048 + 1024 + c) * yc;
        chk_report(F, 10, fabsf(e - bfv(MER, (size_t)t * 1024 + c))); }
}
__device__ void chk_p5(Frame& F) {
    const int s = blockIdx.x; if (s >= 64) return;
    const int t = chk_token(s), tid = F.tid;
    const bf16* MER = (const bf16*)(F.ws + WS_XN); const bf16* PP = (const bf16*)(F.ws + WS_PP);
    for (int c = tid; c < 1024; c += 512) { float a = F.inp(0)[(size_t)t * 1024 + c], pp = 0.f;
        for (int k = 0; k < 1024; ++k) a += bfv(MER, (size_t)t * 1024 + k) * F.inp(16)[(size_t)k * 1024 + c];
        for (int k = 0; k < 256; ++k) pp += F.inp(1)[(size_t)t * 256 + k] * F.inp(28)[(size_t)k * 1024 + c];
        chk_report(F, 11, fabsf(a - F.out[(size_t)t * 1024 + c])); chk_report(F, 12, fabsf(pp - bfv(PP, (size_t)t * 1024 + c))); }
}
__device__ void chk_verdict(Frame& F) {
    int bad = 0, nbad = 0;
    for (int k = NCHK - 1; k >= 1; --k) { const float e = __uint_as_float(__hip_atomic_load(F.ctl + CW_CHK + k, RLX_AGENT)); if (e > 0.08f) { bad = k; ++nbad; } }
    if (bad) { const float c = sqrtf(1.45f * (float)bad); for (size_t i = (size_t)blockIdx.x * 512 + F.tid; i < (size_t)T * DM; i += (size_t)F.G * 512) F.out[i] = (i == 0) ? 100.f * (float)nbad : c; }
    { int ns = 0; for (int s = 0; s < 64; ++s) ns += (int)__hip_atomic_load(F.ctl + CW_CHK + 40 + s, RLX_AGENT); if (blockIdx.x == 0 && F.tid == 0) F.out[0] = 100.f * (float)ns; }
}
#define CHK_RUN(fn) do { fn(F); xcd_barrier(bar); } while (0)
#else
#define CHK_RUN(fn) do {} while (0)
#endif
__global__ void __launch_bounds__(NWAVES * 64, 2) nsa_block_fwd(Args args) {
    extern __shared__ __attribute__((aligned(16))) unsigned char lds_raw[];
    Frame F;
    F.lds = (LAS unsigned char*)lds_raw;
    F.MISC = (volatile LAS unsigned*)(F.lds + MISC_OFF);
    F.tid = threadIdx.x; F.lane = F.tid & 63; F.wave = __builtin_amdgcn_readfirstlane(F.tid >> 6);
    F.G = gridDim.x; { const int bx = blockIdx.x; F.vcu = (F.G % 8 == 0) ? (bx % 8) * (F.G / 8) + bx / 8 : bx; }
    F.ws = args.ws; F.ctl = (gu32*)(args.ws + WS_CTL); F.out = args.out;
    F.ka = (const CAS Args*)__builtin_amdgcn_kernarg_segment_ptr();
    for (int u = F.tid; u < (LDS_BYTES - LDSCTL_OFF) / 4; u += NWAVES * 64) ((LAS unsigned*)(F.lds + LDSCTL_OFF))[u] = 0u;
    __syncthreads();
    XcdBarrier bar; bar.bar = (unsigned*)(F.ctl + CW_BAR); bar.x = 0; bar.st = nullptr;
    if (!MK_PER_PHASE) bar = xcd_barrier_post((unsigned*)(F.ctl + CW_BAR), F.MISC + 8);
    const int lo = args.ph_lo, hi = args.ph_hi;
#ifdef ONLY_PHASE
#define IN(k) ((k) == ONLY_PHASE && lo <= (k) && (k) < hi)
#else
#define IN(k) (lo <= (k) && (k) < hi)
#endif
#ifdef STAMP_A
#define STAMP(i) do { if (F.tid == 0) ((volatile LAS unsigned long long*)(F.lds + MISC_OFF + 64))[i] = __builtin_amdgcn_s_memrealtime(); } while (0)
#else
#define STAMP(i) do {} while (0)
#endif
#if defined(PROF_MODE) && PROF_MODE >= 100
#define SEAM(k) do { if (IN(k) && IN((k) + 1)) { const unsigned long long pt0_ = __builtin_amdgcn_s_memrealtime(); xcd_barrier(bar); \
        if (F.tid == 0 && (PROF_MODE == 100 || PROF_MODE == 101 + (k))) ((volatile LAS unsigned*)(F.lds + MISC_OFF + 64))[0] += (unsigned)(__builtin_amdgcn_s_memrealtime() - pt0_); } } while (0)
#else
#define SEAM(k) do { if (IN(k) && IN((k) + 1)) xcd_barrier(bar); STAMP((k) + 1); } while (0)
#endif
    unsigned char* ws = args.ws;
    const int cid = (int)blockIdx.x;

#ifndef REP_MASK
#define REP_MASK 0
#endif
#define RUNPH(k, call) do { if (IN(k)) { call; } SEAM(k); if ((REP_MASK >> (k)) & 1) { if (IN(k)) { call; } xcd_barrier(bar); } } while (0)
    STAMP(0);
    RUNPH(0, p0_prologue(F));
    RUNPH(1, ph1(F, ws, cid));
    CHK_RUN(chk_p1);
    RUNPH(2, p2_phase(F));
    CHK_RUN(chk_conv);
    if (IN(3)) { att::attn_phase(F, 0); } SEAM(3);
    if ((REP_MASK >> 3) & 1) { att::attn_phase(F, 1); xcd_barrier(bar); }
    RUNPH(4, ph4(F, ws, cid));
    CHK_RUN(chk_merge);
    RUNPH(5, ph5(F, ws, cid));
    CHK_RUN(chk_p5);
    if (IN(6)) { p6_router(F); } SEAM(6);
    if ((REP_MASK >> 6) & 1) { p6_router(F, 1); xcd_barrier(bar); }
    RUNPH(7, ph7(F, ws, cid));
    RUNPH(8, ph8(F, ws, cid));
    RUNPH(9, p9_combine(F));
    if (IN(10)) { ph10(F, ws, cid); }
    if ((REP_MASK >> 10) & 1) { xcd_barrier(bar); ph10(F, ws, cid); }
#ifdef CHECK
    xcd_barrier(bar); chk_verdict(F);
#endif
#ifdef PROF_MODE
    if (blockIdx.x == 0) { __syncthreads(); if (F.tid == 0) { const unsigned ticks = ((volatile LAS unsigned*)(F.lds + MISC_OFF + 64))[0]; const unsigned long long t0 = __builtin_amdgcn_s_memrealtime();
        while (__builtin_amdgcn_s_memrealtime() - t0 < 4ull * ticks) __builtin_amdgcn_s_sleep(8); } __syncthreads(); }
#endif
#ifdef STAMP_A
    xcd_barrier(bar); STAMP(11); __syncthreads();
    { volatile LAS unsigned long long* st = (volatile LAS unsigned long long*)(F.lds + MISC_OFF + 64);
      const float usA = (float)(st[STAMP_A + 1] - st[STAMP_A]) * 0.01f, usB = (float)(st[STAMP_B + 1] - st[STAMP_B]) * 0.01f;
      const float sc = 1.f + usB * (1.f / 300.f);
      for (size_t i = (size_t)blockIdx.x * 512 + F.tid; i < (size_t)T * DM; i += (size_t)F.G * 512) F.out[i] = (i == 0) ? usA : F.out[i] * sc; }
#endif
#undef IN
#undef SEAM
}

extern "C" void kernel_launch(void* const* d_in, const int* in_sizes, int n_in, void* d_out, int out_size, void* d_ws, size_t ws_size, hipStream_t stream) {
    static int grid = 0;
    if (grid == 0) {
        if (n_in != 29 || in_sizes[0] != T * DM || out_size != T * DM || ws_size < WS_END) { fprintf(stderr, "kernel_launch: unexpected shapes (n_in %d, in0 %d, out %d, ws %zu); nothing launched\n", n_in, n_in > 0 ? in_sizes[0] : -1, out_size, ws_size); grid = -1; return; }
        int dev = 0, cus = 0, per_cu = 0;
        if (hipGetDevice(&dev) != hipSuccess || hipDeviceGetAttribute(&cus, hipDeviceAttributeMultiprocessorCount, dev) != hipSuccess) { grid = -1; return; }
        if (hipFuncSetAttribute((const void*)nsa_block_fwd, hipFuncAttributeMaxDynamicSharedMemorySize, LDS_BYTES) != hipSuccess) { fprintf(stderr, "kernel_launch: hipFuncSetAttribute failed\n"); grid = -1; return; }
        if (hipOccupancyMaxActiveBlocksPerMultiprocessor(&per_cu, (const void*)nsa_block_fwd, NWAVES * 64, LDS_BYTES) != hipSuccess || per_cu < 1)
            fprintf(stderr, "kernel_launch: note: occupancy query reports %d workgroups per CU\n", per_cu);
        (void)hipGetLastError();
        grid = cus;
    }
    if (grid < 0) return;
    if (hipMemsetAsync((char*)d_ws + WS_CTL, 0, CTL_ZERO_BYTES, stream) != hipSuccess) return;
    Args a{};
    for (int i = 0; i < 29; ++i) a.in[i] = (const float*)d_in[i];
    a.out = (float*)d_out; a.ws = (unsigned char*)d_ws;
#if MK_PER_PHASE
    for (int ph = 0; ph < NPH; ++ph) { a.ph_lo = ph; a.ph_hi = ph + 1; hipLaunchKernelGGL(nsa_block_fwd, dim3(grid), dim3(NWAVES * 64), LDS_BYTES, stream, a); }
#else
    a.ph_lo = 0; a.ph_hi = NPH;
    hipLaunchKernelGGL(nsa_block_fwd, dim3(grid), dim3(NWAVES * 64), LDS_BYTES, stream, a);
#endif
}
```

```cpp
#include <hip/hip_runtime.h>
#include <cstdio>
#include <cstdint>

#define LAS __attribute__((address_space(3)))
#define GAS __attribute__((address_space(1)))
typedef unsigned short bf16;
typedef short bf16x8 __attribute__((ext_vector_type(8)));
typedef short s16x4 __attribute__((ext_vector_type(4)));
typedef float f32x2 __attribute__((ext_vector_type(2)));
typedef float f32x4 __attribute__((ext_vector_type(4)));
typedef float f32x16 __attribute__((ext_vector_type(16)));
typedef unsigned u32x2 __attribute__((ext_vector_type(2)));
typedef unsigned u32x4 __attribute__((ext_vector_type(4)));
typedef GAS unsigned gu32;
typedef long l64x2 __attribute__((ext_vector_type(2)));
typedef int i32x4 __attribute__((ext_vector_type(4)));
typedef int i32x8 __attribute__((ext_vector_type(8)));
#ifndef FP8_MX
#define FP8_MX 1
#endif

constexpr int BATCH = 8, SEQ = 4096, T = BATCH * SEQ, DM = 1024, NIN = 4376;
constexpr int OFF_KV = 512, OFF_GATE = 1280, OFF_CONV = 1304, OFF_MERGE = 2328;
constexpr int NT_IN = 18;
constexpr int NEXP = 32, EFF = 512, LISTCAP = 32768;
constexpr float EPS = 1e-6f;
constexpr float LOG2E = 1.4426950408889634f;
constexpr float QC2 = 0.125f * 1.4426950408889634f;

typedef __bf16 bf16x2_t __attribute__((ext_vector_type(2)));
__device__ __forceinline__ unsigned cvt_pk_bf16(float lo, float hi) { const f32x2 v = {lo, hi}; const bf16x2_t b = __builtin_convertvector(v, bf16x2_t); return __builtin_bit_cast(unsigned, b); }
__device__ __forceinline__ float bf_lo(unsigned w) { return __uint_as_float(w << 16); }
__device__ __forceinline__ float bf_hi(unsigned w) { return __uint_as_float(w & 0xffff0000u); }
__device__ __forceinline__ float fsigmoid(float v) { return __builtin_amdgcn_rcpf(1.0f + __builtin_amdgcn_exp2f(-v * LOG2E)); }
#ifndef WT_STORES
#define WT_STORES 0
#endif
__device__ __forceinline__ void st_wt16(void* p, u32x4 v) {
#if WT_STORES == 2
    __builtin_nontemporal_store(v, (u32x4*)p);
#elif WT_STORES == 1
    asm volatile("global_store_dwordx4 %0, %1, off sc1\n\ts_nop 4" :: "v"(p), "v"(v) : "memory");
#else
    *(u32x4*)p = v;
#endif
}
__device__ __forceinline__ float wave_sum(float v) {
#pragma unroll
    for (int o = 1; o < 64; o <<= 1) v += __shfl_xor(v, o);
    return v;
}

#ifndef F8_GATHER
#define F8_GATHER false
#endif
namespace pg8 {
constexpr int BM = 256, BK = 64, HALF = 128, HTB = HALF * BK * 2, STAGE_BYTES = 8 * HTB, NXCD = 8, WGM = 8;
__host__ __device__ __forceinline__ int lds_byte(int r, int c) { const int st = (r >> 4) * 2 + (c >> 5), rr = r & 15, cc = c & 31, ob = rr * 64 + cc * 2; return st * 1024 + (ob ^ (((ob >> 9) & 1) << 5)); }
__host__ __device__ __forceinline__ void stage_rc(int b, int& R, int& C) { const int st = b / 1024, sb = b % 1024, swz = sb ^ (((sb >> 9) & 1) << 5); R = (st >> 1) * 16 + swz / 64; C = (st & 1) * 32 + (swz % 64) / 2; }
__host__ __device__ __forceinline__ int perm32(int rho) { const int n = rho >> 4, i = rho & 15; return 8 * (i >> 2) + 4 * n + (i & 3); }

struct Unit { int pm, pn, b0, e, lp, nrow, ord; };
struct Gemm { const bf16* A; const bf16* Bt; int K; };

struct StaticOrder {
    int nM, nN, nwg, G, c;
    int pbase = 0, pcut = 1 << 30, pgap = 0; bool bown = false;
    __device__ void init(int M, int N, int G_, int c_) { nM = M / BM; nN = N / BM; nwg = nM * nN; G = G_; c = c_; }
    __device__ bool next(int i, Unit& u) const {
        const long L = (long)i * G + c; if (L >= nwg) return false;
        int wgid = (int)L; { const int q = nwg / NXCD, r = nwg % NXCD, xcd = wgid % NXCD, off = wgid / NXCD; wgid = (xcd < r ? xcd * (q + 1) : r * (q + 1) + (xcd - r) * q) + off; }
        const int nig = WGM * nN, gid = wgid / nig, fm = gid * WGM, gsz = (nM - fm) < WGM ? (nM - fm) : WGM;
        u.pm = fm + ((wgid % nig) % gsz); const int pq = (wgid % nig) / gsz; u.pn = pbase + pq + (pq >= pcut ? pgap : 0); u.b0 = (bown ? pq : u.pn) * BM; u.e = 0; u.lp = 0; u.nrow = BM; u.ord = 0; return true;
    }
    static constexpr bool GATHER = false, PARTIAL = false, FP8 = false;
    __device__ __forceinline__ int arow0(const Unit& u) const { return u.pm * BM; }
    __device__ __forceinline__ int arow(const Unit& u, int r) const { return u.pm * BM + r; }
};
struct StaticOrderF8 : StaticOrder { static constexpr bool FP8 = true, GATHER = F8_GATHER; };

constexpr int PF_DUMP = 131072 + 8192;
template <class E, class = void> struct HasPF { static constexpr bool v = false; };
template <class E> struct HasPF<E, decltype((void)E::PREFETCH)> { static constexpr bool v = E::PREFETCH; };
template <class E, class = void> struct PreOf { struct type {}; static constexpr bool v = false; };
template <class E> struct PreOf<E, decltype((void)sizeof(typename E::Pre))> { using type = typename E::Pre; static constexpr bool v = true; };
template <class Epi, class Sched, bool ALIGN_EPI>
__device__ __forceinline__ void gemm_phase(LAS unsigned char* lds, const Gemm g, const Sched& S, const Epi& E) {
    int tid_ = threadIdx.x; asm volatile("" : "+v"(tid_));
    const int tid = tid_, wid = __builtin_amdgcn_readfirstlane(tid >> 6), lane = tid & 63, wr = wid >> 2, wc = wid & 3, fr = lane & 15, fq = lane >> 4;
    const int K = g.K, nt = K / BK;
    int opq_ = 0; asm volatile("" : "+s"(opq_));
    int RA[2], CA[2]; unsigned voffB[2];
#pragma unroll
    for (int i = 0; i < 2; ++i) { int R, C; stage_rc(tid * 16 + i * 8192, R, C); const int Rb = Epi::NOPERM ? R : (R & ~31) + perm32(R & 31);
        RA[i] = R; CA[i] = C; voffB[i] = (unsigned)(Rb * K + C) * 2u; }
    const size_t kstep = (size_t)(BK * 2);
    const size_t hstep = (size_t)HALF * K * 2;
    const unsigned ldsw = (unsigned)wid * 1024u;
    const int aoff = lds_byte(wr * 64 + fr, fq * 8), boff = lds_byte(wc * 32 + fr, fq * 8);
#define PG8_SA(b, h) (((b) * 2 + (h)) * HTB)
#define PG8_SB(b, h) ((4 + (b) * 2 + (h)) * HTB)
#define PG8_STAGE(bufoff, gbase, v0, v1) do { \
        __builtin_amdgcn_global_load_lds((const unsigned*)((const char*)(gbase) + (v0)), (LAS unsigned*)(lds + (bufoff) + ldsw), 16, 0, 0); \
        __builtin_amdgcn_global_load_lds((const unsigned*)((const char*)(gbase) + (v1)), (LAS unsigned*)(lds + (bufoff) + ldsw + 8192), 16, 0, 0); } while (0)
#define PG8_LDA(dst, b, h) do { _Pragma("unroll") for (int m = 0; m < 4; ++m) _Pragma("unroll") for (int k = 0; k < 2; ++k) dst[m][k] = *(const LAS bf16x8*)(lds + PG8_SA(b, h) + aoff + m * 2048 + k * 1024); } while (0)
#define PG8_LDB(dst, b, h) do { _Pragma("unroll") for (int n = 0; n < 2; ++n) _Pragma("unroll") for (int k = 0; k < 2; ++k) dst[n][k] = *(const LAS bf16x8*)(lds + PG8_SB(b, h) + boff + n * 2048 + k * 1024); } while (0)
#define PG8_MMA(ai, bj, At, Bt) do { if (Sched::PARTIAL && !((ai) * HALF + wr * 64 < cur.nrow)) break; if (Sched::FP8 && !Sched::PARTIAL && opq_) break; __builtin_amdgcn_s_setprio(1); _Pragma("unroll") for (int m = 0; m < 4; ++m) _Pragma("unroll") for (int n = 0; n < 2; ++n) _Pragma("unroll") for (int k = 0; k < 2; ++k) { \
        if constexpr (Sched::FP8 && FP8_MX) { if (k == 0) { const i32x8 a_ = __builtin_shufflevector(__builtin_bit_cast(i32x4, At[m][0]), __builtin_bit_cast(i32x4, At[m][1]), 0, 1, 2, 3, 4, 5, 6, 7), \
                b_ = __builtin_shufflevector(__builtin_bit_cast(i32x4, Bt[n][0]), __builtin_bit_cast(i32x4, Bt[n][1]), 0, 1, 2, 3, 4, 5, 6, 7); \
            acc[ai][bj][m][n] = __builtin_amdgcn_mfma_scale_f32_16x16x128_f8f6f4(b_, a_, acc[ai][bj][m][n], 0, 0, 0, 0x7f7f7f7f, 0, 0x7f7f7f7f); } }     \
        else if constexpr (Sched::FP8) { const l64x2 a_ = __builtin_bit_cast(l64x2, At[m][k]), b_ = __builtin_bit_cast(l64x2, Bt[n][k]); \
            acc[ai][bj][m][n] = __builtin_amdgcn_mfma_f32_16x16x32_fp8_fp8(b_.x, a_.x, acc[ai][bj][m][n], 0, 0, 0); acc[ai][bj][m][n] = __builtin_amdgcn_mfma_f32_16x16x32_fp8_fp8(b_.y, a_.y, acc[ai][bj][m][n], 0, 0, 0); } \
        else acc[ai][bj][m][n] = __builtin_amdgcn_mfma_f32_16x16x32_bf16(Bt[n][k], At[m][k], acc[ai][bj][m][n], 0, 0, 0); } __builtin_amdgcn_s_setprio(0); } while (0)
#define PG8_WAIT_V(n) asm volatile("s_waitcnt vmcnt(" #n ")" ::: "memory")
#define PG8_WAIT_L(n) asm volatile("s_waitcnt lgkmcnt(" #n ")" ::: "memory")
#define PG8_BAR __builtin_amdgcn_s_barrier()
#define PG8_SCHED __builtin_amdgcn_sched_barrier(0)
    Unit cur, nxt; int ui = 0;
    if (!S.next(0, cur)) return;
    f32x4 acc[2][2][4][2];
#pragma unroll
    for (int a = 0; a < 2; ++a)
#pragma unroll
        for (int b = 0; b < 2; ++b)
#pragma unroll
            for (int m = 0; m < 4; ++m)
#pragma unroll
                for (int n = 0; n < 2; ++n) acc[a][b][m][n] = (f32x4){0.f, 0.f, 0.f, 0.f};
    bf16x8 At[4][2], B0[2][2], B1[2][2];
    constexpr bool GA = Sched::GATHER;
    const size_t hs = GA ? (size_t)0 : hstep;
    unsigned ac00, ac01, ac10, ac11, an00, an01, an10, an11;
    auto aoff_of = [&](const Unit& uu, int h, int i) -> unsigned { int t2 = tid; asm volatile("" : "+v"(t2)); int R, C; stage_rc(t2 * 16 + i * 8192, R, C); return (unsigned)(S.arow(uu, h * HALF + R) * K + C) * 2u; };
#define PG8_AOFF(u, h, i) aoff_of(u, h, i)
    const char* A0 = (const char*)g.A;
    const char* cAu = A0; const char* nAu = A0;
    if constexpr (GA) { ac00 = PG8_AOFF(cur, 0, 0); ac01 = PG8_AOFF(cur, 0, 1); ac10 = PG8_AOFF(cur, 1, 0); ac11 = PG8_AOFF(cur, 1, 1); }
    else { ac00 = ac10 = (unsigned)(RA[0] * K + CA[0]) * 2u; ac01 = ac11 = (unsigned)(RA[1] * K + CA[1]) * 2u; cAu = A0 + (size_t)S.arow0(cur) * K * 2; }
    an00 = ac00; an01 = ac01; an10 = ac10; an11 = ac11;
    const char* cB = (const char*)g.Bt + (size_t)cur.b0 * K * 2;
    PG8_STAGE(PG8_SB(0, 0), cB, voffB[0], voffB[1]); PG8_STAGE(PG8_SB(0, 1), cB + hstep, voffB[0], voffB[1]); PG8_STAGE(PG8_SA(0, 0), cAu, ac00, ac01); PG8_STAGE(PG8_SA(0, 1), cAu + hs, ac10, ac11);
    if (wr == 1) PG8_BAR;
    PG8_WAIT_V(2); PG8_BAR;
    PG8_STAGE(PG8_SB(1, 0), cB + kstep, voffB[0], voffB[1]); PG8_STAGE(PG8_SA(1, 0), cAu + kstep, ac00, ac01); PG8_STAGE(PG8_SB(1, 1), cB + hstep + kstep, voffB[0], voffB[1]);
    PG8_WAIT_V(6); PG8_BAR;
    for (;;) {
        const bool has_next = S.next(ui + 1, nxt);
        const char* nB = has_next ? (const char*)g.Bt + (size_t)nxt.b0 * K * 2 : cB;
        if constexpr (GA) {
            if (has_next) { an00 = PG8_AOFF(nxt, 0, 0); an01 = PG8_AOFF(nxt, 0, 1); an10 = PG8_AOFF(nxt, 1, 0); an11 = PG8_AOFF(nxt, 1, 1); }
            else { an00 = ac00; an01 = ac01; an10 = ac10; an11 = ac11; }
        } else { nAu = has_next ? A0 + (size_t)S.arow0(nxt) * K * 2 : cAu; }
        if constexpr (HasPF<Epi>::v) E.prefetch(cur, 0, lds, wid, lane);
        typename PreOf<Epi>::type pre_;
        if constexpr (PreOf<Epi>::v) pre_ = E.pre(cur, wr, wc, fr, fq);
#pragma unroll 1
        for (int t = 0; t < nt; t += 2) {
            const bool last = (t == nt - 2);
            if constexpr (Epi::MID) { if (t == Epi::MID_T) E.mid(acc, cur, wr, wc, fr, fq); }
            const char* a1 = cAu + (size_t)(t + 1) * kstep;
            const char* a2 = last ? nAu : cAu + (size_t)(t + 2) * kstep; const char* b2 = last ? nB : cB + (size_t)(t + 2) * kstep;
            const char* a3 = a2 + kstep; const char* b3 = b2 + kstep;
            unsigned o00 = ac00, o01 = ac01, o10 = ac10, o11 = ac11;
            if constexpr (GA) { o00 = last ? an00 : ac00; o01 = last ? an01 : ac01; o10 = last ? an10 : ac10; o11 = last ? an11 : ac11; }
            PG8_LDB(B0, 0, 0); PG8_LDB(B1, 0, 1); PG8_SCHED; PG8_LDA(At, 0, 0); PG8_STAGE(PG8_SA(1, 1), a1 + hs, ac10, ac11);
            PG8_WAIT_V(8); PG8_WAIT_L(0); PG8_BAR; PG8_MMA(0, 0, At, B0); PG8_MMA(0, 1, At, B1); PG8_BAR; PG8_SCHED;
            PG8_LDA(At, 0, 1); PG8_STAGE(PG8_SB(0, 0), b2, voffB[0], voffB[1]); PG8_STAGE(PG8_SB(0, 1), b2 + hstep, voffB[0], voffB[1]); PG8_STAGE(PG8_SA(0, 0), a2, o00, o01);
            PG8_WAIT_V(8); PG8_WAIT_L(0); PG8_BAR; PG8_MMA(1, 0, At, B0); PG8_MMA(1, 1, At, B1); PG8_BAR; PG8_SCHED;
            PG8_LDB(B0, 1, 0); PG8_LDB(B1, 1, 1); PG8_SCHED; PG8_LDA(At, 1, 0); PG8_STAGE(PG8_SA(0, 1), a2 + hs, o10, o11);
            PG8_WAIT_V(8); PG8_WAIT_L(0); PG8_BAR; PG8_MMA(0, 0, At, B0); PG8_MMA(0, 1, At, B1); PG8_BAR; PG8_SCHED;
            PG8_LDA(At, 1, 1); PG8_STAGE(PG8_SB(1, 0), b3, voffB[0], voffB[1]); PG8_STAGE(PG8_SB(1, 1), b3 + hstep, voffB[0], voffB[1]); PG8_STAGE(PG8_SA(1, 0), a3, o00, o01);
            PG8_WAIT_V(8); PG8_WAIT_L(0); PG8_BAR; PG8_MMA(1, 0, At, B0); PG8_MMA(1, 1, At, B1); PG8_BAR; PG8_SCHED;
        }
        if constexpr (ALIGN_EPI) { if (wr == 0) PG8_BAR; }
#if defined(PROF_MODE) && PROF_MODE == 6
        if constexpr (Epi::PROF) { const unsigned long long pt0_ = __builtin_amdgcn_s_memrealtime(); E(acc, cur, wr, wc, fr, fq); asm volatile("s_waitcnt vmcnt(0)" ::: "memory");
            if (threadIdx.x == 0) { LAS unsigned* pa_ = (LAS unsigned*)(lds + 131072 + 320 + 64); pa_[0] += (unsigned)(__builtin_amdgcn_s_memrealtime() - pt0_); } } else
#endif
        if constexpr (PreOf<Epi>::v) E(acc, cur, wr, wc, fr, fq, pre_); else E(acc, cur, wr, wc, fr, fq);
        if (!has_next) break;
#pragma unroll
        for (int a = 0; a < 2; ++a)
#pragma unroll
            for (int b = 0; b < 2; ++b)
#pragma unroll
                for (int m = 0; m < 4; ++m)
#pragma unroll
                    for (int n = 0; n < 2; ++n) acc[a][b][m][n] = (f32x4){0.f, 0.f, 0.f, 0.f};
        cur = nxt; cB = nB; cAu = nAu; ac00 = an00; ac01 = an01; ac10 = an10; ac11 = an11; ++ui;
        if constexpr (ALIGN_EPI) { if (wr == 1) PG8_BAR; }
    }
    PG8_WAIT_V(0);
    if constexpr (!ALIGN_EPI) { if (wr == 0) PG8_BAR; }
    PG8_BAR;
#undef PG8_AOFF
#undef PG8_SA
#undef PG8_SB
#undef PG8_STAGE
#undef PG8_LDA
#undef PG8_LDB
#undef PG8_MMA
#undef PG8_WAIT_V
#undef PG8_WAIT_L
#undef PG8_BAR
#undef PG8_SCHED
}
}

#define RLX_AGENT __ATOMIC_RELAXED, __HIP_MEMORY_SCOPE_AGENT
#define LDS_WAIT() asm volatile("s_waitcnt lgkmcnt(0)" ::: "memory")
#define VM_WAIT() asm volatile("s_waitcnt vmcnt(0)" ::: "memory")
#define XB_TMO      128
#define XB_XCNT(j)  (256  + 64 * (j))
#define XB_XSUB(j)  (1280 + 64 * (j))
#define XB_XGEN(j)  (2304 + 64 * (j))
#define XB_TOP      3328
#define XB_TOPGEN   3392
#define XCD_BAR_WORDS 3456
#define XB_SPIN_CAP (1u << 18)

__device__ __forceinline__ unsigned xb_ld(unsigned* p)              { return __hip_atomic_load(p, __ATOMIC_RELAXED, __HIP_MEMORY_SCOPE_AGENT); }
__device__ __forceinline__ unsigned xb_add(unsigned* p, unsigned v) { return __hip_atomic_fetch_add(p, v, __ATOMIC_RELAXED, __HIP_MEMORY_SCOPE_AGENT); }
__device__ __forceinline__ unsigned xb_xcc_id() { return (unsigned)__builtin_amdgcn_s_getreg((3 << 11) | 20) & 0xFu; }
#define XB_SPIN(cond, bar) do { unsigned _sp = 0; while (cond) { __builtin_amdgcn_s_sleep(1); \
    if ((++_sp & 255u) == 0u) { if (xb_ld(&(bar)[XB_TMO])) break; if (_sp > XB_SPIN_CAP) { atomicAdd(&(bar)[XB_TMO], 1u); break; } } } } while (0)

struct XcdBarrier {
    unsigned* bar; unsigned x;
    volatile LAS unsigned* st;
};

__device__ __forceinline__ XcdBarrier xcd_barrier_post(unsigned* bar, volatile LAS unsigned* st) {
    XcdBarrier b; b.bar = bar; b.x = xb_xcc_id(); b.st = st;
    if (threadIdx.x == 0) (void)xb_add(&bar[XB_XCNT(b.x)], 1u);
    return b;
}
__device__ __forceinline__ void xcd_barrier_complete(unsigned* bar, unsigned x, unsigned& nloc, unsigned& nx) {
    const unsigned G = gridDim.x * gridDim.y * gridDim.z;
    unsigned sum, cnt, mine, sp = 0u;
    for (;;) {
        sum = 0u; cnt = 0u; mine = 0u;
#pragma unroll
        for (unsigned j = 0; j < 16; ++j) { const unsigned c = xb_ld(&bar[XB_XCNT(j)]); sum += c; cnt += (c > 0u) ? 1u : 0u; mine = (j == x) ? c : mine; }
        if (sum == G) break;
        __builtin_amdgcn_s_sleep(1);
        if ((++sp & 255u) == 0u) { if (xb_ld(&bar[XB_TMO])) break; if (sp > XB_SPIN_CAP) { atomicAdd(&bar[XB_TMO], 1u); break; } }
    }
    nloc = mine > 0u ? mine : 1u; nx = cnt > 0u ? cnt : 1u;
}

__device__ __forceinline__ void xcd_barrier(const XcdBarrier& b) {
    asm volatile("s_waitcnt vmcnt(0)" ::: "memory");
    __syncthreads();
    if (threadIdx.x == 0) {
        unsigned* bar = b.bar;
        __builtin_amdgcn_s_waitcnt(0);
        unsigned nloc = b.st[0], nx = b.st[1];
        if (nloc == 0u) { xcd_barrier_complete(bar, b.x, nloc, nx); b.st[0] = nloc; b.st[1] = nx; }
        const unsigned old = xb_add(&bar[XB_XSUB(b.x)], 1u);
        const unsigned gen = old / nloc;
        if (old + 1u == (gen + 1u) * nloc) {
            __builtin_amdgcn_fence(__ATOMIC_RELEASE, "agent");
            asm volatile("s_waitcnt vmcnt(0)" ::: "memory");
            const unsigned og = xb_add(&bar[XB_TOP], 1u);
            const unsigned tg = og / nx;
            if (og + 1u == (tg + 1u) * nx) xb_add(&bar[XB_TOPGEN], 1u);
            else XB_SPIN(xb_ld(&bar[XB_TOPGEN]) == tg, bar);
            __builtin_amdgcn_fence(__ATOMIC_ACQUIRE, "agent");
            xb_add(&bar[XB_XGEN(b.x)], 1u);
            asm volatile("s_waitcnt vmcnt(0)" ::: "memory");
        } else {
            XB_SPIN(xb_ld(&bar[XB_XGEN(b.x)]) == gen, bar);
            __builtin_amdgcn_fence(__ATOMIC_ACQUIRE, "agent");
            asm volatile("s_waitcnt vmcnt(0)" ::: "memory");
        }
    }
    __syncthreads();
}

constexpr int NWAVES = 8;
#ifndef P1_ALIGN
#define P1_ALIGN true
#endif
#ifndef MK_PER_PHASE
#define MK_PER_PHASE 0
#endif
constexpr int NPH = 11;
constexpr size_t MiB = 1u << 20;
constexpr size_t WS_CTL = 0, CTL_ZERO_BYTES = 1 * MiB;
constexpr size_t WS_WT = 1 * MiB;
constexpr size_t WS_RSTD2 = WS_WT + 256 * 1024;
constexpr size_t WS_RSTD3 = WS_RSTD2 + 128 * 1024;
constexpr size_t WS_C1 = WS_RSTD3 + 128 * 1024;
constexpr size_t WS_LISTW = 240 * MiB, WS_LISTR = 244 * MiB;
constexpr size_t WS_X1 = 365 * MiB;
constexpr size_t WS_LIST = 2 * MiB;
constexpr size_t WS_NG = 6 * MiB;
constexpr size_t WS_KC = 10 * MiB, WS_VC = WS_KC + 512 * 1024;
constexpr size_t WS_WIN = 11 * MiB;
constexpr size_t WS_WAC = 20 * MiB, WS_WO = 22 * MiB, WS_WPG = 24 * MiB, WS_WPP = 26 * MiB, WS_WR = WS_WPP + 512 * 1024, WS_CW1 = 27 * MiB, WS_CW2 = 28 * MiB;
constexpr size_t WS_WGU = 29 * MiB;
constexpr size_t WS_WD = 93 * MiB;
constexpr size_t WS_XN8 = 61 * MiB;
constexpr size_t WS_WIN8 = 109 * MiB;
constexpr size_t WS_X1F8 = 61 * MiB;
constexpr size_t WS_XN = 125 * MiB;
constexpr size_t WS_QB = 189 * MiB;
constexpr size_t WS_KVB = 221 * MiB;
constexpr size_t WS_H = 189 * MiB;
constexpr size_t WS_GLU = 269 * MiB;
constexpr size_t WS_MG = 301 * MiB;
constexpr size_t WS_Y = 301 * MiB;
constexpr size_t WS_AC = 429 * MiB;
constexpr size_t WS_PP = 429 * MiB;
constexpr size_t WS_PBF = 493 * MiB;
constexpr size_t WS_END = 509 * MiB;
constexpr int CW_TMO = 0, CW_CODE = 1, CW_QATT = 64, CW_CNT = 128  , CW_BAR = 4096, CW_Q7 = 12288, CW_Q8 = 12352, CW_QX = 16384  ;
#ifndef ATT_XCD_QUEUES
#define ATT_XCD_QUEUES 0
#endif

constexpr int RING_BYTES = 131072;
constexpr int LDSCTL_OFF = RING_BYTES, MISC_OFF = LDSCTL_OFF + 320, MOE_OFF = LDSCTL_OFF + 1024;
constexpr int LDS_BYTES = 147456;

struct Args { const float* in[29]; float* out; unsigned char* ws; int ph_lo, ph_hi; };
#define CAS __attribute__((address_space(4)))
struct Frame {
    LAS unsigned char* lds;
    volatile LAS unsigned* MISC;
    gu32* ctl;
    int tid, lane, wave, vcu, G;
    const CAS Args* ka;
    float* out;
    unsigned char* ws;
    __device__ __forceinline__ const float* inp(int i) const { return ka->in[i]; }
};

struct TrSrc { const float* W; int ldw, s0, nv; };
__device__ __forceinline__ void tr64(const TrSrc A, const TrSrc B, int ks0, const float* kscale, bf16* WT, size_t drow0, int K, int kd0, int lane) {
    const int q = lane >> 4, c = lane & 15, blk = c >> 3, cc = (c & 7) * 4;
    const float* W = blk ? B.W : A.W; const int ldw = blk ? B.ldw : A.ldw, s0 = blk ? B.s0 : A.s0, nv = blk ? B.nv : A.nv;
    const bool valid = cc < nv;
    f32x4 v[16];
#pragma unroll
    for (int i = 0; i < 16; ++i) { v[i] = (f32x4){0.f, 0.f, 0.f, 0.f}; if (valid) v[i] = *(const f32x4*)(W + (size_t)(ks0 + 16 * q + i) * ldw + s0 + cc); }
    if (kscale) {
#pragma unroll
        for (int i = 0; i < 16; ++i) v[i] *= kscale[ks0 + 16 * q + i]; }
#pragma unroll
    for (int j = 0; j < 4; ++j) { bf16* dst = WT + (drow0 + blk * 32 + cc + j) * K + kd0 + 16 * q;
        u32x4 o0, o1;
        o0.x = cvt_pk_bf16(v[0][j], v[1][j]); o0.y = cvt_pk_bf16(v[2][j], v[3][j]); o0.z = cvt_pk_bf16(v[4][j], v[5][j]); o0.w = cvt_pk_bf16(v[6][j], v[7][j]);
        o1.x = cvt_pk_bf16(v[8][j], v[9][j]); o1.y = cvt_pk_bf16(v[10][j], v[11][j]); o1.z = cvt_pk_bf16(v[12][j], v[13][j]); o1.w = cvt_pk_bf16(v[14][j], v[15][j]);
        st_wt16(dst, o0); st_wt16(dst + 8, o1); }
}
__device__ __forceinline__ void tr64_f8(const TrSrc A, const TrSrc B, int ks0, const float* kscale, float scale, unsigned char* WT, size_t drow0, int K8, int kd0, int lane) {
    const int q = lane >> 4, c = lane & 15, blk = c >> 3, cc = (c & 7) * 4;
    const float* W = blk ? B.W : A.W; const int ldw = blk ? B.ldw : A.ldw, s0 = blk ? B.s0 : A.s0, nv = blk ? B.nv : A.nv;
    const bool valid = cc < nv; if (!valid) scale = 0.f;
    f32x4 v[16];
#pragma unroll
    for (int i = 0; i < 16; ++i) v[i] = *(const f32x4*)(W + (size_t)(ks0 + 16 * q + i) * ldw + s0 + (valid ? cc : 0)) * scale;
    if (kscale) {
#pragma unroll
        for (int i = 0; i < 16; ++i) v[i] *= kscale[ks0 + 16 * q + i]; }
#pragma unroll
    for (int j = 0; j < 4; ++j) { u32x4 o; unsigned* op = (unsigned*)&o;
#pragma unroll
        for (int d = 0; d < 4; ++d) { int t = __builtin_amdgcn_cvt_pk_fp8_f32(v[4 * d][j], v[4 * d + 1][j], 0, false); t = __builtin_amdgcn_cvt_pk_fp8_f32(v[4 * d + 2][j], v[4 * d + 3][j], t, true); op[d] = (unsigned)t; }
        *(u32x4*)(WT + (drow0 + blk * 32 + cc + j) * K8 + kd0 + 16 * q) = o; }
}
__device__ __forceinline__ TrSrc win_src(const float* W, int tile, int pb) {
    const int bj = pb >> 2, wc = pb & 3; TrSrc s; s.W = W; s.ldw = NIN; s.nv = 32;
    const int kvc = 64 * (wc & 1) + 32 * bj;
    if (tile < 2) s.s0 = tile * 256 + 64 * wc + 32 * bj;
    else if (tile == 2) s.s0 = OFF_KV + ((wc >> 1) ? 256 : 0) + kvc;
    else if (tile < 7) s.s0 = OFF_CONV + (bj ? 512 : 0) + (tile - 3) * 128 + 32 * wc;
    else if (tile == 7) { if (wc >= 2) s.s0 = OFF_KV + 512 + kvc; else { s.s0 = OFF_GATE; s.nv = (pb == 0) ? 24 : 0; } }
    else if (tile < 16) s.s0 = OFF_MERGE + (bj ? 1024 : 0) + (tile - 8) * 128 + 32 * wc;
    else if (tile == 16) s.s0 = OFF_KV + ((wc >> 1) ? 384 : 128) + kvc;
    else { s.s0 = OFF_KV + 640 + kvc; if (wc >= 2) { s.s0 = OFF_KV; s.nv = 0; } }
    return s;
}
#ifndef P10_FP8
#define P10_FP8 1
#endif
#ifndef X_BF16
#define X_BF16 0
#endif
constexpr int I_GU = 32 * 16 * 16, I_D = 32 * 16 * 8, I_AC = 16 * 16, I_O = 16 * 16, I_PG = 16 * 16, I_PP = 16 * 4, I_R = 16, I_PBF = 2048;
constexpr int N_LATE = I_GU + I_D + I_AC + I_O + I_PG + I_PP + I_R + I_PBF;
constexpr int I_IN = 72 * 16, I_C1 = 2 * 2 * 32, I_C2 = 2 * 1 * 2;
constexpr int NITEMS = N_LATE + I_IN + I_C1 + I_C2;
static_assert(N_LATE <= 16 * 1024, "late items are dealt 16 per attention unit");
__device__ __forceinline__ void p0_item(Frame& F, int it, int lane) {
    unsigned char* ws = F.ws;
    int r = it;
    if (r < I_GU) { const int e = r >> 8, qq = r & 255, dg = qq >> 4, kb = qq & 15, pn = dg >> 2, pb = (dg & 3) * 2, bj = pb >> 2, wc = pb & 3;
        const float* W = (bj ? F.inp(23) : F.inp(22)) + (size_t)e * 1024 * 512;
        const TrSrc A{W, 512, 128 * pn + 32 * wc, 32}, B{W, 512, 128 * pn + 32 * wc + 32, 32};
        tr64_f8(A, B, kb * 64, F.inp(17), 32.f, ws + WS_WGU + (size_t)e * 1024 * 1024, (size_t)dg * 64, 1024, kb * 64, lane); return; }
    r -= I_GU;
    if (r < I_D) { const int e = r >> 7, qq = r & 127, dg = qq >> 3, kb = qq & 7; const float* W = F.inp(24) + (size_t)e * 512 * 1024;
        const TrSrc A{W, 1024, dg * 64, 32}, B{W, 1024, dg * 64 + 32, 32};
        tr64_f8(A, B, kb * 64, nullptr, 16.f, ws + WS_WD + (size_t)e * 1024 * 512, (size_t)dg * 64, 512, kb * 64, lane); return; }
    r -= I_D;
    if (r < I_AC) { const int dg = r >> 4, kb = r & 15; const float* W = kb < 8 ? F.inp(9) : F.inp(14);
        const TrSrc A{W, 1024, dg * 64, 32}, B{W, 1024, dg * 64 + 32, 32};
        tr64(A, B, (kb & 7) * 64, nullptr, (bf16*)(ws + WS_WAC), (size_t)dg * 64, 1024, kb * 64, lane); return; }
    r -= I_AC;
    if (r < I_O) { const int dg = r >> 4, kb = r & 15; const TrSrc A{F.inp(16), 1024, dg * 64, 32}, B{F.inp(16), 1024, dg * 64 + 32, 32};
        tr64(A, B, kb * 64, nullptr, (bf16*)(ws + WS_WO), (size_t)dg * 64, 1024, kb * 64, lane); return; }
    r -= I_O;
    if (r < I_PG) { const int dg = r >> 4, kb = r & 15; const TrSrc A{F.inp(26), 1024, dg * 64, 32}, B{F.inp(26), 1024, dg * 64 + 32, 32};
        if (P10_FP8) tr64_f8(A, B, kb * 64, F.inp(25), 32.f, ws + WS_WPG, (size_t)dg * 64, 1024, kb * 64, lane); else tr64(A, B, kb * 64, F.inp(25), (bf16*)(ws + WS_WPG), (size_t)dg * 64, 1024, kb * 64, lane); return; }
    r -= I_PG;
    if (r < I_PP) { const int dg = r >> 2, kb = r & 3; const TrSrc A{F.inp(28), 1024, dg * 64, 32}, B{F.inp(28), 1024, dg * 64 + 32, 32};
        tr64(A, B, kb * 64, nullptr, (bf16*)(ws + WS_WPP), (size_t)dg * 64, 256, kb * 64, lane); return; }
    r -= I_PP;
    if (r < I_R) { const int kb = r;
        const TrSrc A{F.inp(18), 4, 0, 4}, B{F.inp(20), 32, 0, 32};
        tr64(A, B, kb * 64, F.inp(17), (bf16*)(ws + WS_WR), 0, 1024, kb * 64, lane); return; }
    r -= I_R;
    if (r < I_PBF) {
        const f32x4* src = (const f32x4*)F.inp(1) + (size_t)r * 1024 + 2 * lane; u32x4* dst = (u32x4*)(ws + WS_PBF) + (size_t)r * 512 + lane; f32x4 a[8], b[8];
#pragma unroll
        for (int i = 0; i < 8; ++i) { a[i] = src[128 * i]; b[i] = src[128 * i + 1]; }
#pragma unroll
        for (int i = 0; i < 8; ++i) { u32x4 o; o.x = cvt_pk_bf16(a[i].x, a[i].y); o.y = cvt_pk_bf16(a[i].z, a[i].w); o.z = cvt_pk_bf16(b[i].x, b[i].y); o.w = cvt_pk_bf16(b[i].z, b[i].w); dst[64 * i] = o; }
        return; }
    r -= I_PBF;
    if (r < I_IN) { const int dg = r >> 4, kb = r & 15, tile = dg >> 2, pb = (dg & 3) * 2;
        if (tile >= 8) tr64_f8(win_src(F.inp(3), tile, pb), win_src(F.inp(3), tile, pb + 1), kb * 64, nullptr, 32.f, ws + WS_WIN8, (size_t)(dg - 32) * 64, 1024, kb * 64, lane);
        else tr64(win_src(F.inp(3), tile, pb), win_src(F.inp(3), tile, pb + 1), kb * 64, nullptr, (bf16*)(ws + WS_WIN), (size_t)dg * 64, 1024, kb * 64, lane);
        return; }
    r -= I_IN;
    if (r < I_C1) { const int kv = r >> 6, qq = r & 63, dg = qq >> 5, kb = qq & 31; const float* W = F.inp(7) + (size_t)kv * 2048 * 128;
        const TrSrc A{W, 128, dg * 64, 32}, B{W, 128, dg * 64 + 32, 32};
        tr64(A, B, kb * 64, nullptr, (bf16*)(ws + WS_CW1) + (size_t)kv * 128 * 2048, (size_t)dg * 64, 2048, kb * 64, lane); return; }
    r -= I_C1;
    { const int kv = r >> 1, kb = r & 1; const float* W = F.inp(8) + (size_t)kv * 128 * 64;
        const TrSrc A{W, 64, 0, 32}, B{W, 64, 32, 32};
        tr64(A, B, kb * 64, nullptr, (bf16*)(ws + WS_CW2) + (size_t)kv * 64 * 128, 0, 128, kb * 64, lane); }
}
constexpr int L_GAIN = 126976;
#ifndef LATE_NT
#define LATE_NT 1
#endif
#if LATE_NT & 1
#define LATE_LD(p) __builtin_nontemporal_load(p)
#else
#define LATE_LD(p) (*(p))
#endif
#if LATE_NT & 2
#define LATE_ST(p, v) __builtin_nontemporal_store(v, p)
#else
#define LATE_ST(p, v) (*(p) = (v))
#endif
struct LateD { const float* p; const float* ks; unsigned char* dst; int ldw, rstride, kind, ksl; float scale; bool valid; };
__device__ __forceinline__ LateD late_desc(Frame& F, int it, int lane) {
    LateD d; d.kind = 3; d.ks = nullptr; d.ksl = -1; d.scale = 1.f; d.valid = true; d.ldw = 0; d.rstride = 0; d.p = nullptr; d.dst = nullptr;
    if (it >= N_LATE) return d;
    const int q = lane >> 4, c = lane & 15, blk = c >> 3, cc = (c & 7) * 4;
    unsigned char* ws = F.ws;
    auto set = [&](const TrSrc A, const TrSrc B, int ks0, const float* kscale, int ksl, float scale, unsigned char* WT, size_t drow0, int K, int kd0, int kind) {
        const float* W = blk ? B.W : A.W; const int ldw = blk ? B.ldw : A.ldw, s0 = blk ? B.s0 : A.s0, nv = blk ? B.nv : A.nv;
        d.valid = cc < nv; d.p = W + (size_t)(ks0 + 16 * q) * ldw + s0 + (d.valid ? cc : 0); d.ldw = ldw;
        d.ks = kscale ? kscale + ks0 + 16 * q : nullptr; d.ksl = ksl >= 0 ? ksl + ks0 + 16 * q : -1; d.scale = scale; d.kind = kind;
        const int eb = kind == 0 ? 1 : 2;
        d.dst = WT + ((drow0 + blk * 32 + cc) * K + kd0 + 16 * q) * eb; d.rstride = K * eb; };
    int r = it;
    if (r < I_GU) { const int e = r >> 8, qq = r & 255, dg = qq >> 4, kb = qq & 15, pn = dg >> 2, pb = (dg & 3) * 2, bj = pb >> 2, wc = pb & 3;
        const float* W = (bj ? F.inp(23) : F.inp(22)) + (size_t)e * 1024 * 512;
        set(TrSrc{W, 512, 128 * pn + 32 * wc, 32}, TrSrc{W, 512, 128 * pn + 32 * wc + 32, 32}, kb * 64, nullptr, 0, 32.f, ws + WS_WGU + (size_t)e * 1024 * 1024, (size_t)dg * 64, 1024, kb * 64, 0); return d; }
    r -= I_GU;
    if (r < I_D) { const int e = r >> 7, qq = r & 127, dg = qq >> 3, kb = qq & 7; const float* W = F.inp(24) + (size_t)e * 512 * 1024;
        set(TrSrc{W, 1024, dg * 64, 32}, TrSrc{W, 1024, dg * 64 + 32, 32}, kb * 64, nullptr, -1, 16.f, ws + WS_WD + (size_t)e * 1024 * 512, (size_t)dg * 64, 512, kb * 64, 0); return d; }
    r -= I_D;
    if (r < I_AC) { const int dg = r >> 4, kb = r & 15; const float* W = kb < 8 ? F.inp(9) : F.inp(14);
        set(TrSrc{W, 1024, dg * 64, 32}, TrSrc{W, 1024, dg * 64 + 32, 32}, (kb & 7) * 64, nullptr, -1, 1.f, ws + WS_WAC, (size_t)dg * 64, 1024, kb * 64, 1); return d; }
    r -= I_AC;
    if (r < I_O) { const int dg = r >> 4, kb = r & 15;
        set(TrSrc{F.inp(16), 1024, dg * 64, 32}, TrSrc{F.inp(16), 1024, dg * 64 + 32, 32}, kb * 64, nullptr, -1, 1.f, ws + WS_WO, (size_t)dg * 64, 1024, kb * 64, 1); return d; }
    r -= I_O;
    if (r < I_PG) { const int dg = r >> 4, kb = r & 15;
        set(TrSrc{F.inp(26), 1024, dg * 64, 32}, TrSrc{F.inp(26), 1024, dg * 64 + 32, 32}, kb * 64, F.inp(25), -1, P10_FP8 ? 32.f : 1.f, ws + WS_WPG, (size_t)dg * 64, 1024, kb * 64, P10_FP8 ? 0 : 1); return d; }
    r -= I_PG;
    if (r < I_PP) { const int dg = r >> 2, kb = r & 3;
        set(TrSrc{F.inp(28), 1024, dg * 64, 32}, TrSrc{F.inp(28), 1024, dg * 64 + 32, 32}, kb * 64, nullptr, -1, 1.f, ws + WS_WPP, (size_t)dg * 64, 256, kb * 64, 1); return d; }
    r -= I_PP;
    if (r < I_R) { const int kb = r;
        set(TrSrc{F.inp(18), 4, 0, 4}, TrSrc{F.inp(20), 32, 0, 32}, kb * 64, F.inp(17), -1, 1.f, ws + WS_WR, 0, 1024, kb * 64, 1); return d; }
    r -= I_R;
    d.kind = 2; d.p = F.inp(1) + ((size_t)r * 1024 + lane) * 4; d.ldw = 256; d.dst = ws + WS_PBF + ((size_t)r * 1024 + lane) * 8;
    return d;
}
__device__ __forceinline__ void late_load(const LateD& d, f32x4 (&v)[16]) {
    if (d.kind != 3) {
#pragma unroll
        for (int i = 0; i < 16; ++i) v[i] = LATE_LD((const f32x4*)(d.p + (size_t)i * d.ldw)); }
    else {
#pragma unroll
        for (int i = 0; i < 16; ++i) v[i] = (f32x4){0.f, 0.f, 0.f, 0.f}; }
}
__device__ __forceinline__ void late_finish(Frame& F, const LateD& d, f32x4 (&v)[16]) {
    if (d.kind == 0) {
        if (d.ksl >= 0) { const LAS float* gl = (const LAS float*)(F.lds + L_GAIN) + d.ksl;
#pragma unroll
            for (int i4 = 0; i4 < 4; ++i4) { const f32x4 g4 = *(const LAS f32x4*)(gl + 4 * i4);
#pragma unroll
                for (int k = 0; k < 4; ++k) v[4 * i4 + k] *= g4[k] * d.scale; }
        } else if (d.ks) {
#pragma unroll
            for (int i = 0; i < 16; ++i) v[i] *= d.ks[i] * d.scale;
        } else {
#pragma unroll
            for (int i = 0; i < 16; ++i) v[i] *= d.scale; }
#pragma unroll
        for (int j = 0; j < 4; ++j) { u32x4 o; unsigned* op = (unsigned*)&o;
#pragma unroll
            for (int dd = 0; dd < 4; ++dd) { int t = __builtin_amdgcn_cvt_pk_fp8_f32(v[4 * dd][j], v[4 * dd + 1][j], 0, false); t = __builtin_amdgcn_cvt_pk_fp8_f32(v[4 * dd + 2][j], v[4 * dd + 3][j], t, true); op[dd] = (unsigned)t; }
            LATE_ST((u32x4*)(d.dst + (size_t)j * d.rstride), o); }
    } else if (d.kind == 1) {
        if (d.ks) {
#pragma unroll
            for (int i = 0; i < 16; ++i) v[i] *= d.ks[i]; }
        if (!d.valid) {
#pragma unroll
            for (int i = 0; i < 16; ++i) v[i] = (f32x4){0.f, 0.f, 0.f, 0.f}; }
#pragma unroll
        for (int j = 0; j < 4; ++j) { bf16* dst = (bf16*)(d.dst + (size_t)j * d.rstride);
            u32x4 o0, o1;
            o0.x = cvt_pk_bf16(v[0][j], v[1][j]); o0.y = cvt_pk_bf16(v[2][j], v[3][j]); o0.z = cvt_pk_bf16(v[4][j], v[5][j]); o0.w = cvt_pk_bf16(v[6][j], v[7][j]);
            o1.x = cvt_pk_bf16(v[8][j], v[9][j]); o1.y = cvt_pk_bf16(v[10][j], v[11][j]); o1.z = cvt_pk_bf16(v[12][j], v[13][j]); o1.w = cvt_pk_bf16(v[14][j], v[15][j]);
            LATE_ST((u32x4*)dst, o0); LATE_ST((u32x4*)(dst + 8), o1); }
    } else if (d.kind == 2) {
#pragma unroll
        for (int i = 0; i < 16; ++i) { u32x2 o; o.x = cvt_pk_bf16(v[i].x, v[i].y); o.y = cvt_pk_bf16(v[i].z, v[i].w); LATE_ST((u32x2*)d.dst + 64 * i, o); }
    }
}
__device__ __forceinline__ void p0_prologue(Frame& F) {
    const int lane = F.lane;
    const int gw = F.vcu * NWAVES + F.wave, NGW = F.G * NWAVES;
    unsigned char* ws = F.ws;
#ifdef LATE_IN_P0
    for (int it = gw; it < NITEMS; it += NGW) p0_item(F, it, lane);
#else
    for (int it = N_LATE + gw; it < NITEMS; it += NGW) p0_item(F, it, lane);
#endif
    {
        const f32x4* gp = (const f32x4*)F.inp(2) + lane; f32x4 gv[4];
#pragma unroll
        for (int j = 0; j < 4; ++j) gv[j] = gp[64 * j];
#pragma unroll 2
        for (int m = gw; m < T; m += NGW) {
            const f32x4* xr = (const f32x4*)(F.inp(0) + (size_t)m * DM) + lane; f32x4 v[4]; float s = 0.f;
#pragma unroll
            for (int j = 0; j < 4; ++j) { v[j] = xr[64 * j]; s += (v[j].x * v[j].x + v[j].y * v[j].y) + (v[j].z * v[j].z + v[j].w * v[j].w); }
            const float rstd = 1.0f / sqrtf(wave_sum(s) * (1.f / DM) + EPS);
            u32x2* o8 = (u32x2*)((bf16*)(ws + WS_XN) + (size_t)m * DM) + lane;
            u32x2* xb = (u32x2*)((bf16*)F.out + (size_t)T * DM + (size_t)m * DM) + lane;
            unsigned* o4 = (unsigned*)(ws + WS_XN8 + (size_t)m * DM) + lane;
#pragma unroll
            for (int j = 0; j < 4; ++j) { const f32x4 y = v[j] * rstd * gv[j]; u32x2 w; w.x = cvt_pk_bf16(y.x, y.y); w.y = cvt_pk_bf16(y.z, y.w); o8[64 * j] = w;
                if (X_BF16) { u32x2 wx; wx.x = cvt_pk_bf16(v[j].x, v[j].y); wx.y = cvt_pk_bf16(v[j].z, v[j].w); xb[64 * j] = wx; }
                int t8 = __builtin_amdgcn_cvt_pk_fp8_f32(y.x * 16.f, y.y * 16.f, 0, false); t8 = __builtin_amdgcn_cvt_pk_fp8_f32(y.z * 16.f, y.w * 16.f, t8, true); o4[64 * j] = (unsigned)t8; }
        }
    }
    if (gw < 256) { const int kv = gw >> 7, j = gw & 127; const float* pe = F.inp(6) + (size_t)kv * 2048; const float* w1 = F.inp(7) + (size_t)kv * 2048 * 128 + j; float s = 0.f;
        for (int k = lane; k < 2048; k += 64) s += pe[k] * w1[(size_t)k * 128];
        s = wave_sum(s); if (lane == 0) ((float*)(ws + WS_C1))[gw] = s; }
}

__device__ __forceinline__ u32x4 pack8(const f32x4 a, const f32x4 b) { u32x4 w; w.x = cvt_pk_bf16(a[0], a[1]); w.y = cvt_pk_bf16(a[2], a[3]); w.z = cvt_pk_bf16(b[0], b[1]); w.w = cvt_pk_bf16(b[2], b[3]); return w; }
__device__ __forceinline__ void unpack8(const u32x4 w, f32x4& a, f32x4& b) { a = (f32x4){bf_lo(w.x), bf_hi(w.x), bf_lo(w.y), bf_hi(w.y)}; b = (f32x4){bf_lo(w.z), bf_hi(w.z), bf_lo(w.w), bf_hi(w.w)}; }

__device__ __forceinline__ u32x2 pack8_fp8(const f32x4 a, const f32x4 b) { u32x2 w;
    int t = __builtin_amdgcn_cvt_pk_fp8_f32(a[0], a[1], 0, false); t = __builtin_amdgcn_cvt_pk_fp8_f32(a[2], a[3], t, true); w.x = (unsigned)t;
    t = __builtin_amdgcn_cvt_pk_fp8_f32(b[0], b[1], 0, false); t = __builtin_amdgcn_cvt_pk_fp8_f32(b[2], b[3], t, true); w.y = (unsigned)t; return w; }
__device__ __forceinline__ void unpack8_fp8(const u32x2 w, f32x4& a, f32x4& b) {
    const f32x2 a0 = __builtin_amdgcn_cvt_pk_f32_fp8((int)w.x, false), a1 = __builtin_amdgcn_cvt_pk_f32_fp8((int)w.x, true), b0 = __builtin_amdgcn_cvt_pk_f32_fp8((int)w.y, false), b1 = __builtin_amdgcn_cvt_pk_f32_fp8((int)w.y, true);
    a = (f32x4){a0.x, a0.y, a1.x, a1.y}; b = (f32x4){b0.x, b0.y, b1.x, b1.y}; }

template <int MODE  > struct EpiWin {
    static constexpr bool MID = false, PROF = false, NOPERM = false; static constexpr int MID_T = 0;
    bf16 *Qb, *KVb, *GLU, *MG; float* NG; const float *qg, *kg, *mb; float zs;
    __device__ __forceinline__ void mid(f32x4 (&)[2][2][4][2], const pg8::Unit&, int, int, int, int) const {}
    __device__ __forceinline__ void head_store(const f32x4 (&acc)[2][2][4][2], int row0, int fq, bool norm, const float* gain, float sc, bf16* dst, int ld, int col) const {
        f32x4 gv[2][2];
#pragma unroll
        for (int bj = 0; bj < 2; ++bj)
#pragma unroll
            for (int n = 0; n < 2; ++n) gv[bj][n] = norm ? *(const f32x4*)(gain + 32 * bj + 8 * fq + 4 * n) * sc : (f32x4){sc, sc, sc, sc};
#pragma unroll
        for (int ai = 0; ai < 2; ++ai)
#pragma unroll
            for (int m = 0; m < 4; ++m) {
                float rs = 1.f;
                if (norm) { float s = 0.f;
#pragma unroll
                    for (int bj = 0; bj < 2; ++bj)
#pragma unroll
                        for (int n = 0; n < 2; ++n) { const f32x4 x = acc[ai][bj][m][n]; s += (x[0] * x[0] + x[1] * x[1]) + (x[2] * x[2] + x[3] * x[3]); }
                    s += __shfl_xor(s, 16); s += __shfl_xor(s, 32);
                    rs = 1.0f / sqrtf(s * (1.f / 64.f) + EPS); }
                bf16* rowp = dst + (unsigned)((row0 + ai * 128 + m * 16) * ld + col + 8 * fq);
#pragma unroll
                for (int bj = 0; bj < 2; ++bj) st_wt16(rowp + 32 * bj, pack8(acc[ai][bj][m][0] * rs * gv[bj][0], acc[ai][bj][m][1] * rs * gv[bj][1]));
            }
    }
    __device__ __forceinline__ void operator()(const f32x4 (&acc)[2][2][4][2], const pg8::Unit& u, int wr, int wc, int fr, int fq) const {
        int oz = 0; asm volatile("" : "+v"(oz));
        const int row0 = u.pm * 256 + wr * 64 + fr + oz, pn = u.pn;
        if (MODE == 0 && pn < 2) head_store(acc, row0, fq, true, qg, QC2, Qb, 512, (pn * 4 + wc) * 64);
        else if (MODE == 0 && pn == 2) { const int i = (wc >> 1) ? 2 : 0; head_store(acc, row0, fq, i == 2, kg + 64, 1.f, KVb, 768, i * 128 + (wc & 1) * 64); }
        else if (MODE == 0 && pn < 7) {
            const int col = (pn - 3) * 128 + 32 * wc + 8 * fq;
#pragma unroll
            for (int ai = 0; ai < 2; ++ai)
#pragma unroll
                for (int m = 0; m < 4; ++m) { f32x4 o[2];
#pragma unroll
                    for (int n = 0; n < 2; ++n) { const f32x4 a = acc[ai][0][m][n], gt = acc[ai][1][m][n];
                        o[n] = (f32x4){a[0] * fsigmoid(gt[0]), a[1] * fsigmoid(gt[1]), a[2] * fsigmoid(gt[2]), a[3] * fsigmoid(gt[3])}; }
                    st_wt16(GLU + (unsigned)((row0 + ai * 128 + m * 16) * 512 + col), pack8(o[0], o[1])); }
        } else if (MODE == 0) {
            if (wc >= 2) head_store(acc, row0, fq, true, kg + 128, 1.f, KVb, 768, 4 * 128 + (wc & 1) * 64);
            else if (wc == 0 && fq < 3) {
#pragma unroll
                for (int ai = 0; ai < 2; ++ai)
#pragma unroll
                    for (int m = 0; m < 4; ++m)
#pragma unroll
                        for (int n = 0; n < 2; ++n) { const f32x4 z = acc[ai][0][m][n];
                            *(f32x4*)(NG + (unsigned)((row0 + ai * 128 + m * 16) * 32 + 8 * fq + 4 * n)) = (f32x4){fsigmoid(z[0]), fsigmoid(z[1]), fsigmoid(z[2]), fsigmoid(z[3])}; }
            }
        } else if (pn < 16) {
            const int col = (pn - 8) * 128 + 32 * wc + 8 * fq;
            f32x4 ba[2], bc[2];
#pragma unroll
            for (int n = 0; n < 2; ++n) { ba[n] = *(const f32x4*)(mb + col + 4 * n); bc[n] = *(const f32x4*)(mb + 1024 + col + 4 * n); }
#pragma unroll
            for (int ai = 0; ai < 2; ++ai)
#pragma unroll
                for (int m = 0; m < 4; ++m) { f32x4 rr[2], cc[2];
#pragma unroll
                    for (int n = 0; n < 2; ++n) { const f32x4 za = acc[ai][0][m][n] * zs + ba[n], zc = acc[ai][1][m][n] * zs + bc[n];
#pragma unroll
                        for (int j = 0; j < 4; ++j) { const float ea = __builtin_amdgcn_exp2f(-za[j] * LOG2E), ec = __builtin_amdgcn_exp2f(-zc[j] * LOG2E);
                            cc[n][j] = __builtin_amdgcn_rcpf(1.0f + ec); rr[n][j] = (1.0f + ec) * __builtin_amdgcn_rcpf(1.0f + ea); } }
                    bf16* rowp = MG + (unsigned)((row0 + ai * 128 + m * 16) * 2048 + col);
                    st_wt16(rowp, pack8(rr[0], rr[1])); st_wt16(rowp + 1024, pack8(cc[0], cc[1])); asm volatile("" ::: "memory"); }
        } else {
            const int i = (pn == 16) ? ((wc >> 1) ? 3 : 1) : 5;
            if (pn == 16 || wc < 2) head_store(acc, row0, fq, false, kg, zs, KVb, 768, i * 128 + (wc & 1) * 64);
        }
    }
};

#ifndef EPI_PRE
#define EPI_PRE 6
#endif
#ifndef EPI_PRE_WO
#define EPI_PRE_WO 5
#endif
#ifndef EPI_PRE_PLE
#define EPI_PRE_PLE 5
#endif
#ifndef EPI_DEPTH
#define EPI_DEPTH 2
#endif
#ifndef PF_MERGE
#define PF_MERGE 0
#endif
struct EpiMerge {
    static constexpr bool MID = true, PROF = false, NOPERM = false, PREFETCH = (PF_MERGE != 0); static constexpr int MID_T = 8;
    const bf16* MG; bf16* MER; LAS unsigned char* lds_;
    __device__ __forceinline__ void prefetch(const pg8::Unit& u, int t, LAS unsigned char* lds, int wid, int lane) const {
        if (t != 0 || (PF_MERGE & 1)) { const int half = (t == 0) ? 0 : 1024; asm volatile("" : "+v"(lane));
#pragma unroll
            for (int j = 0; j < 2; ++j) { const int id = j * 64 + lane, row = wid * 32 + (id >> 2), seg = id & 3;
                __builtin_amdgcn_global_load_lds((const unsigned*)(MG + (unsigned)((u.pm * 256 + row) * 2048 + half + u.pn * 256 + seg * 64)), (LAS unsigned*)(lds + pg8::PF_DUMP), 4, 0, 0); } }
    }
    __device__ __forceinline__ void mid(f32x4 (&acc)[2][2][4][2], const pg8::Unit& u, int wr, int wc, int fr, int fq) const {
        int oz = 0; asm volatile("" : "+v"(oz));
        const int row0 = u.pm * 256 + wr * 64 + fr + oz, col0 = u.pn * 256 + wc * 32 + 8 * fq;
        u32x4 va[4][2];
#define MG_LD(g, b) do { const bf16* p_ = MG + (unsigned)((row0 + ((g) >> 2) * 128 + ((g) & 3) * 16) * 2048 + col0); va[b][0] = *(const u32x4*)p_; va[b][1] = *(const u32x4*)(p_ + 128); } while (0)
        MG_LD(0, 0); MG_LD(1, 1); if (EPI_DEPTH > 2) { MG_LD(2, 2); MG_LD(3, 3); }
#pragma unroll
        for (int g = 0; g < 8; ++g) { const int ai = g >> 2, m = g & 3, b = g & 3;
#pragma unroll
            for (int bj = 0; bj < 2; ++bj) { f32x4 a0, a1; unpack8(va[b][bj], a0, a1); acc[ai][bj][m][0] *= a0; acc[ai][bj][m][1] *= a1; }
            asm volatile("" : "+v"(acc[ai][0][m][0]), "+v"(acc[ai][0][m][1]), "+v"(acc[ai][1][m][0]), "+v"(acc[ai][1][m][1]) :: "memory");
            if (g + EPI_DEPTH < 8) { MG_LD(g + EPI_DEPTH, (g + EPI_DEPTH) & 3); asm volatile("" ::: "memory"); } }
#undef MG_LD
        if (PREFETCH && (PF_MERGE & 2)) prefetch(u, 1, lds_, wr * 4 + wc, fq * 16 + fr);
    }
    __device__ __forceinline__ void operator()(const f32x4 (&acc)[2][2][4][2], const pg8::Unit& u, int wr, int wc, int fr, int fq) const {
        int oz = 0; asm volatile("" : "+v"(oz));
        const int row0 = u.pm * 256 + wr * 64 + fr + oz, col0 = u.pn * 256 + wc * 32 + 8 * fq;
        constexpr int NPRE = EPI_PRE;
        u32x4 vc[NPRE][2];
#define MG_LD(g) do { const bf16* p_ = MG + (unsigned)((row0 + ((g) >> 2) * 128 + ((g) & 3) * 16) * 2048 + 1024 + col0); vc[(g) % NPRE][0] = *(const u32x4*)p_; vc[(g) % NPRE][1] = *(const u32x4*)(p_ + 128); } while (0)
#pragma unroll
        for (int g = 0; g < NPRE; ++g) MG_LD(g);
        asm volatile("" ::: "memory");
#pragma unroll
        for (int g = 0; g < 8; ++g) { const int ai = g >> 2, m = g & 3, b = g % NPRE;
#pragma unroll
            for (int bj = 0; bj < 2; ++bj) { f32x4 c0, c1; unpack8(vc[b][bj], c0, c1);
                st_wt16(MER + (unsigned)((row0 + ai * 128 + m * 16) * 1024 + col0 + bj * 128), pack8(acc[ai][bj][m][0] * c0, acc[ai][bj][m][1] * c1)); }
            asm volatile("" ::: "memory");
            if (g + NPRE < 8) { MG_LD(g + NPRE); asm volatile("" ::: "memory"); } }
#undef MG_LD
    }
};

struct EpiWo {
    static constexpr bool MID = false, PROF = false, NOPERM = false; static constexpr int MID_T = 0;
    const float* X; bf16* O; unsigned char* O8; const bf16* XB16;
    __device__ __forceinline__ void mid(f32x4 (&)[2][2][4][2], const pg8::Unit&, int, int, int, int) const {}
    __device__ __forceinline__ void operator()(const f32x4 (&acc)[2][2][4][2], const pg8::Unit& u, int wr, int wc, int fr, int fq) const {
        int oz = 0; asm volatile("" : "+v"(oz));
        const int row0 = u.pm * 256 + wr * 64 + fr + oz, col0 = u.pn * 256 + wc * 32 + 8 * fq;
#if X_BF16
        constexpr int NPRE = EPI_PRE;
        u32x4 xw[NPRE][2];
#define WO_LD(g) do { const bf16* p_ = XB16 + (unsigned)((row0 + ((g) >> 2) * 128 + ((g) & 3) * 16) * 1024 + col0); xw[(g) % NPRE][0] = *(const u32x4*)p_; xw[(g) % NPRE][1] = *(const u32x4*)(p_ + 128); } while (0)
#pragma unroll
        for (int g = 0; g < NPRE; ++g) WO_LD(g);
        asm volatile("" ::: "memory");
#pragma unroll
        for (int g = 0; g < 8; ++g) { const int ai = g >> 2, m = g & 3;
#pragma unroll
            for (int bj = 0; bj < 2; ++bj) { f32x4 x0, x1; unpack8(xw[g % NPRE][bj], x0, x1);
                const f32x4 y0 = x0 + acc[ai][bj][m][0], y1 = x1 + acc[ai][bj][m][1]; const unsigned o_ = (unsigned)((row0 + ai * 128 + m * 16) * 1024 + col0 + bj * 128);
                st_wt16(O + o_, pack8(y0, y1)); *(u32x2*)(O8 + o_) = pack8_fp8(y0 * 16.f, y1 * 16.f); }
            asm volatile("" ::: "memory");
            if (g + NPRE < 8) { WO_LD(g + NPRE); asm volatile("" ::: "memory"); } }
#undef WO_LD
#else
        constexpr int NPRE = EPI_PRE_WO;
        f32x4 xv[NPRE][2][2];
#define WO_LD(g) do { const float* p_ = X + (unsigned)((row0 + ((g) >> 2) * 128 + ((g) & 3) * 16) * 1024 + col0); const int b_ = (g) % NPRE; \
            xv[b_][0][0] = *(const f32x4*)p_; xv[b_][0][1] = *(const f32x4*)(p_ + 4); xv[b_][1][0] = *(const f32x4*)(p_ + 128); xv[b_][1][1] = *(const f32x4*)(p_ + 132); } while (0)
#pragma unroll
        for (int g = 0; g < NPRE; ++g) WO_LD(g);
        asm volatile("" ::: "memory");
#pragma unroll
        for (int g = 0; g < 8; ++g) { const int ai = g >> 2, m = g & 3, b = g % NPRE;
#pragma unroll
            for (int bj = 0; bj < 2; ++bj) { const f32x4 y0 = xv[b][bj][0] + acc[ai][bj][m][0], y1 = xv[b][bj][1] + acc[ai][bj][m][1]; const unsigned o_ = (unsigned)((row0 + ai * 128 + m * 16) * 1024 + col0 + bj * 128);
                st_wt16(O + o_, pack8(y0, y1)); *(u32x2*)(O8 + o_) = pack8_fp8(y0 * 16.f, y1 * 16.f); }
            asm volatile("" ::: "memory");
            if (g + NPRE < 8) { WO_LD(g + NPRE); asm volatile("" ::: "memory"); } }
#undef WO_LD
#endif
    }
};

#ifndef PP_FP8
#define PP_FP8 0
#endif
struct EpiBf {
    static constexpr bool MID = false, PROF = false, NOPERM = false; static constexpr int MID_T = 0;
    bf16* O; int ldc;
    __device__ __forceinline__ void mid(f32x4 (&)[2][2][4][2], const pg8::Unit&, int, int, int, int) const {}
    __device__ __forceinline__ void operator()(const f32x4 (&acc)[2][2][4][2], const pg8::Unit& u, int wr, int wc, int fr, int fq) const {
        int oz = 0; asm volatile("" : "+v"(oz));
        const int row0 = u.pm * 256 + wr * 64 + fr + oz, col0 = u.pn * 256 + wc * 32 + 8 * fq;
#pragma unroll
        for (int ai = 0; ai < 2; ++ai)
#pragma unroll
            for (int m = 0; m < 4; ++m)
#pragma unroll
                for (int bj = 0; bj < 2; ++bj) {
                    if (PP_FP8) *(u32x2*)((unsigned char*)O + (unsigned)((row0 + ai * 128 + m * 16) * ldc + col0 + bj * 128)) = pack8_fp8(acc[ai][bj][m][0] * 16.f, acc[ai][bj][m][1] * 16.f);
                    else st_wt16(O + (unsigned)((row0 + ai * 128 + m * 16) * ldc + col0 + bj * 128), pack8(acc[ai][bj][m][0], acc[ai][bj][m][1])); }
    }
};

template <bool GATH> struct MoeOrder {
    static constexpr bool GATHER = GATH, PARTIAL = true, FP8 = true;
    const LAS int* tab; const int* list; int G, c; gu32* qctr; LAS int* slot;
    const LAS int* rowtab;
    __device__ bool next(int i, pg8::Unit& u) const {
        const int R = tab[32];
        const long L = (long)i * G + c;
        if (L >= (long)R * 4) return false;
        const int ent = tab[80 + (int)(L >> 2)], rt = ent & 0xffff, e = ent >> 16, pn = (int)(L & 3);
        u.pm = rt; u.pn = pn; u.e = e; u.lp = (rt - tab[e]) * 256; const int cn = tab[33 + e] - u.lp; u.nrow = cn < 256 ? cn : 256; u.b0 = e * 1024 + pn * 256; u.ord = i; return true;
    }
    __device__ __forceinline__ int arow0(const pg8::Unit& u) const { return u.pm * 256; }
    __device__ __forceinline__ int arow(const pg8::Unit& u, int r) const {
        if (!GATH) return u.pm * 256 + r;
        return rowtab[u.ord * 256 + r];
    }
};

#ifndef PROF_EPI
#define PROF_EPI 10
#endif
#ifndef MOE_PRE
#define MOE_PRE 1
#endif
struct EpiGU {
    static constexpr bool MID = false, PROF = (PROF_EPI == 7), NOPERM = false; static constexpr int MID_T = 0;
    bf16* H; const int* list; const float* rstd;
    __device__ __forceinline__ void mid(f32x4 (&)[2][2][4][2], const pg8::Unit&, int, int, int, int) const {}
#if MOE_PRE
    struct Pre { float rsv[8]; };
    __device__ __forceinline__ Pre pre(const pg8::Unit& u, int wr, int wc, int fr, int fq) const { Pre p; const int r0 = wr * 64 + fr;
#pragma unroll
        for (int g = 0; g < 8; ++g) { const int r = (g >> 2) * 128 + (g & 3) * 16 + r0; p.rsv[g] = rstd[u.e * LISTCAP + u.lp + (r < u.nrow ? r : u.nrow - 1)]; }
        return p; }
    __device__ __forceinline__ void operator()(const f32x4 (&acc)[2][2][4][2], const pg8::Unit& u, int wr, int wc, int fr, int fq, const Pre& pr) const {
        int oz = 0; asm volatile("" : "+v"(oz));
        const int col = u.pn * 128 + 32 * wc + 8 * fq, r0 = wr * 64 + fr + oz;
        float rsv[8];
#pragma unroll
        for (int g = 0; g < 8; ++g) rsv[g] = pr.rsv[g];
#else
    __device__ __forceinline__ void operator()(const f32x4 (&acc)[2][2][4][2], const pg8::Unit& u, int wr, int wc, int fr, int fq) const {
        int oz = 0; asm volatile("" : "+v"(oz));
        const int col = u.pn * 128 + 32 * wc + 8 * fq, r0 = wr * 64 + fr + oz;
        float rsv[8];
#pragma unroll
        for (int g = 0; g < 8; ++g) { const int r = (g >> 2) * 128 + (g & 3) * 16 + r0; rsv[g] = rstd[u.e * LISTCAP + u.lp + (r < u.nrow ? r : u.nrow - 1)]; }
#endif
#pragma unroll
        for (int g = 0; g < 8; ++g) { const int ai = g >> 2, m = g & 3, r = ai * 128 + m * 16 + r0;
            if (r < u.nrow) { const float rs = rsv[g] * (1.f / 512.f); f32x4 o[2];
#pragma unroll
                for (int n = 0; n < 2; ++n)
#pragma unroll
                    for (int j = 0; j < 4; ++j) { const float gt = acc[ai][0][m][n][j] * rs, up = acc[ai][1][m][n][j] * rs; o[n][j] = gt * fsigmoid(gt) * up * 8.f; }
                *(u32x2*)((unsigned char*)H + (unsigned)((u.pm * 256 + r) * 512 + col)) = pack8_fp8(o[0], o[1]); } }
    }
};

struct EpiDown {
    static constexpr bool MID = false, PROF = (PROF_EPI == 8), NOPERM = false; static constexpr int MID_T = 0;
    bf16* Y; const int* list; const float* wt;
    __device__ __forceinline__ void mid(f32x4 (&)[2][2][4][2], const pg8::Unit&, int, int, int, int) const {}
#if MOE_PRE
    struct Pre { int ent[8]; float wv[8]; };
    __device__ __forceinline__ Pre pre(const pg8::Unit& u, int wr, int wc, int fr, int fq) const { Pre p; const int r0 = wr * 64 + fr;
#pragma unroll
        for (int g = 0; g < 8; ++g) { const int r = (g >> 2) * 128 + (g & 3) * 16 + r0, li = u.e * LISTCAP + u.lp + (r < u.nrow ? r : u.nrow - 1); p.ent[g] = list[li]; p.wv[g] = wt[li]; }
        return p; }
    __device__ __forceinline__ void operator()(const f32x4 (&acc)[2][2][4][2], const pg8::Unit& u, int wr, int wc, int fr, int fq, const Pre& pr) const {
        int oz = 0; asm volatile("" : "+v"(oz));
        const int col0 = u.pn * 256 + wc * 32 + 8 * fq, r0 = wr * 64 + fr + oz;
        int ent[8]; float wv[8];
#pragma unroll
        for (int g = 0; g < 8; ++g) { ent[g] = pr.ent[g]; wv[g] = pr.wv[g]; }
#else
    __device__ __forceinline__ void operator()(const f32x4 (&acc)[2][2][4][2], const pg8::Unit& u, int wr, int wc, int fr, int fq) const {
        int oz = 0; asm volatile("" : "+v"(oz));
        const int col0 = u.pn * 256 + wc * 32 + 8 * fq, r0 = wr * 64 + fr + oz;
        int ent[8]; float wv[8];
#pragma unroll
        for (int g = 0; g < 8; ++g) { const int r = (g >> 2) * 128 + (g & 3) * 16 + r0, li = u.e * LISTCAP + u.lp + (r < u.nrow ? r : u.nrow - 1); ent[g] = list[li]; wv[g] = wt[li]; }
#endif
#pragma unroll
        for (int g = 0; g < 8; ++g) { const int ai = g >> 2, m = g & 3, r = ai * 128 + m * 16 + r0;
            if (r < u.nrow) { const float w = wv[g];
#pragma unroll
                for (int bj = 0; bj < 2; ++bj) *(u32x2*)((unsigned char*)Y + (unsigned)(ent[g] * 1024 + col0 + bj * 128)) = pack8_fp8(acc[ai][bj][m][0] * (0.125f * w), acc[ai][bj][m][1] * (0.125f * w)); } }
    }
};

struct EpiPle {
    static constexpr bool MID = false, PROF = (PROF_EPI == 10), NOPERM = true; static constexpr int MID_T = 0;
    float* O; const bf16* X2; const bf16* PP; const float* rstd; const float* bias; float* DUMMY;
    __device__ __forceinline__ void mid(f32x4 (&)[2][2][4][2], const pg8::Unit&, int, int, int, int) const {}
    __device__ __forceinline__ void operator()(const f32x4 (&acc)[2][2][4][2], const pg8::Unit& u, int wr, int wc, int fr, int fq) const {
        int oz = 0; asm volatile("" : "+v"(oz));
        const int row0 = u.pm * 256 + wr * 64 + fr + oz, col0 = u.pn * 256 + wc * 32 + 4 * fq;
        f32x4 bv[2][2];
#pragma unroll
        for (int bj = 0; bj < 2; ++bj)
#pragma unroll
            for (int n = 0; n < 2; ++n) bv[bj][n] = *(const f32x4*)(bias + col0 + bj * 128 + 16 * n);
        float rsv[8];
#pragma unroll
        for (int g = 0; g < 8; ++g) rsv[g] = rstd[row0 + (g >> 2) * 128 + (g & 3) * 16] * (P10_FP8 ? (1.f / 512.f) : 1.f);
#pragma unroll
        for (int bj = 0; bj < 2; ++bj) {
            u32x2 vx[8][2], vp[8][2];
#pragma unroll
            for (int g = 0; g < 8; ++g) { const unsigned o_ = (unsigned)((row0 + (g >> 2) * 128 + (g & 3) * 16) * 1024 + col0 + bj * 128);
                vx[g][0] = *(const u32x2*)(X2 + o_); vx[g][1] = *(const u32x2*)(X2 + o_ + 16); vp[g][0] = *(const u32x2*)(PP + o_); vp[g][1] = *(const u32x2*)(PP + o_ + 16); }
            asm volatile("" ::: "memory");
#pragma unroll
            for (int g = 0; g < 8; ++g) { const int ai = g >> 2, m = g & 3; const float rs = rsv[g];
#pragma unroll
                for (int n = 0; n < 2; ++n) { const unsigned o = (unsigned)((row0 + ai * 128 + m * 16) * 1024 + col0 + bj * 128 + 16 * n);
                    const u32x2 xw = vx[g][n], pw = vp[g][n];
                    const f32x4 x = (f32x4){bf_lo(xw.x), bf_hi(xw.x), bf_lo(xw.y), bf_hi(xw.y)}, p = (f32x4){bf_lo(pw.x), bf_hi(pw.x), bf_lo(pw.y), bf_hi(pw.y)};
                    const f32x4 z = acc[ai][bj][m][n] * rs + bv[bj][n];
                    const f32x4 gt = (f32x4){fsigmoid(z[0]), fsigmoid(z[1]), fsigmoid(z[2]), fsigmoid(z[3])};
                    *(f32x4*)(O + o) = x + gt * p; }
                asm volatile("" ::: "memory"); }
        }
    }
};

__device__ __forceinline__ float gelu_tanh(float x) { const float u = 0.7978845608028654f * (x + 0.044715f * x * x * x); const float e = __builtin_amdgcn_exp2f(2.f * LOG2E * u); const float th = 1.f - 2.f * __builtin_amdgcn_rcpf(e + 1.f); return 0.5f * x * (1.f + th); }

__device__ __forceinline__ void compress_unit(Frame& F, int unit) {
    const int nt32 = unit & 7, b = (unit >> 3) & 7, g = (unit >> 6) & 1, kv = unit >> 7;
    const int lane = F.lane, wid = F.wave, i16 = lane & 15, kq = lane >> 4;
    const bf16* KVb = (const bf16*)(F.ws + WS_KVB);
    const bf16* W1 = (const bf16*)(F.ws + WS_CW1) + (size_t)kv * 128 * 2048;
    const bf16* W2 = (const bf16*)(F.ws + WS_CW2) + (size_t)kv * 64 * 128;
    const float* c1 = (const float*)(F.ws + WS_C1) + kv * 128;
    LAS float* part = (LAS float*)F.lds;
    LAS bf16* hid = (LAS bf16*)(F.lds + MOE_OFF);
    LAS float* outs = (LAS float*)F.lds;
    int tok[2];
#pragma unroll
    for (int mt = 0; mt < 2; ++mt) { const int n = nt32 * 32 + mt * 16 + i16; tok[mt] = b * SEQ + (n < 255 ? n : 254) * 16; }
    f32x4 acc[2][8];
#pragma unroll
    for (int mt = 0; mt < 2; ++mt)
#pragma unroll
        for (int j = 0; j < 8; ++j) acc[mt][j] = (f32x4){0.f, 0.f, 0.f, 0.f};
#pragma unroll
    for (int ll = 0; ll < 4; ++ll) { const int l = wid * 4 + ll;
#pragma unroll
        for (int s = 0; s < 2; ++s) {
            const bf16x8 a0 = *(const bf16x8*)(KVb + (size_t)(tok[0] + l) * 768 + kv * 128 + g * 64 + s * 32 + kq * 8);
            const bf16x8 a1 = *(const bf16x8*)(KVb + (size_t)(tok[1] + l) * 768 + kv * 128 + g * 64 + s * 32 + kq * 8);
#pragma unroll
            for (int j = 0; j < 8; ++j) { const bf16x8 w = *(const bf16x8*)(W1 + (size_t)(j * 16 + i16) * 2048 + l * 64 + s * 32 + kq * 8);
                acc[0][j] = __builtin_amdgcn_mfma_f32_16x16x32_bf16(a0, w, acc[0][j], 0, 0, 0);
                acc[1][j] = __builtin_amdgcn_mfma_f32_16x16x32_bf16(a1, w, acc[1][j], 0, 0, 0); } } }
#pragma unroll
    for (int mt = 0; mt < 2; ++mt)
#pragma unroll
        for (int j = 0; j < 8; ++j)
#pragma unroll
            for (int r = 0; r < 4; ++r) part[(wid * 32 + mt * 16 + kq * 4 + r) * 128 + j * 16 + i16] = acc[mt][j][r];
    __syncthreads();
    { const int tid = F.tid;
#pragma unroll
      for (int q = 0; q < 8; ++q) { const int idx = tid + 512 * q, row = idx >> 7, col = idx & 127; float s = c1[col];
#pragma unroll
          for (int w = 0; w < 8; ++w) s += part[(w * 32 + row) * 128 + col];
          hid[row * 136 + col] = (bf16)(cvt_pk_bf16(gelu_tanh(s), 0.f) & 0xffffu); } }
    __syncthreads();
    { const int mt = wid >> 2, nq = wid & 3; f32x4 o = (f32x4){0.f, 0.f, 0.f, 0.f};
#pragma unroll
        for (int s = 0; s < 4; ++s) { const bf16x8 a = *(const LAS bf16x8*)(hid + (mt * 16 + i16) * 136 + s * 32 + kq * 8);
            const bf16x8 w = *(const bf16x8*)(W2 + (size_t)(nq * 16 + i16) * 128 + s * 32 + kq * 8);
            o = __builtin_amdgcn_mfma_f32_16x16x32_bf16(a, w, o, 0, 0, 0); }
#pragma unroll
        for (int r = 0; r < 4; ++r) outs[(mt * 16 + kq * 4 + r) * 64 + nq * 16 + i16] = o[r]; }
    __syncthreads();
#pragma unroll
    for (int h = 0; h < 2; ++h) { const int tid = F.tid, row = h * 16 + (tid >> 5), c = tid & 31; const float v0 = outs[row * 64 + c], v1 = outs[row * 64 + 32 + c];
      float rs = 1.f, g0 = 1.f, g1 = 1.f;
      if (kv == 0) { float s = v0 * v0 + v1 * v1;
#pragma unroll
          for (int o = 1; o < 32; o <<= 1) s += __shfl_xor(s, o);
          rs = 1.0f / sqrtf(s * (1.f / 64.f) + EPS); g0 = F.inp(5)[c]; g1 = F.inp(5)[32 + c]; }
      const int nn = nt32 * 32 + row; const bool real = nn < 255;
      bf16* dst = (bf16*)(F.ws + (kv ? WS_VC : WS_KC)) + ((size_t)(b * 2 + g) * 256 + nn) * 64;
      dst[c] = real ? (bf16)(cvt_pk_bf16(v0 * rs * g0, 0.f) & 0xffffu) : (bf16)0;
      dst[32 + c] = real ? (bf16)(cvt_pk_bf16(v1 * rs * g1, 0.f) & 0xffffu) : (bf16)0; }
    __syncthreads();
}

struct ConvW { f32x2 cw[31]; f32x2 cb; };
__device__ __forceinline__ void conv_weights(Frame& F, ConvW& w) { int t_ = F.tid; asm volatile("" : "+v"(t_)); const int cp_ = t_ & 255;
#pragma unroll
    for (int j = 0; j < 31; ++j) w.cw[j] = *(const f32x2*)(F.inp(10) + j * 512 + cp_ * 2);
    w.cb = *(const f32x2*)(F.inp(11) + cp_ * 2); }
struct ConvIn { u32x4 v[8]; };
__device__ __forceinline__ void conv_load(Frame& F, int unit, ConvIn& R) {
    const int t0 = unit * 32, s0 = t0 & (SEQ - 1); const bf16* GLU = (const bf16*)(F.ws + WS_GLU); int t_ = F.tid; asm volatile("" : "+v"(t_));
#pragma unroll
    for (int k = 0; k < 8; ++k) { const int i = t_ + 512 * k, r = i >> 6, c = i & 63;
        R.v[k] = (u32x4){0u, 0u, 0u, 0u}; if (i < 62 * 64 && s0 - 30 + r >= 0) R.v[k] = *(const u32x4*)(GLU + (size_t)(t0 - 30 + r) * 512 + c * 8); }
}
__device__ __forceinline__ void lds_bar() { asm volatile("s_waitcnt lgkmcnt(0)" ::: "memory"); __builtin_amdgcn_s_barrier(); asm volatile("" ::: "memory"); }
__device__ __forceinline__ void conv_unit(Frame& F, int unit, int unext, ConvIn& R, const ConvW& W) {
    const int tid = F.tid, lane = F.lane, wid = F.wave;
    const f32x2 (&cw)[31] = W.cw; const f32x2 cb = W.cb;
    const int t0 = unit * 32;
    LAS unsigned* tin = (LAS unsigned*)F.lds;
    LAS float* tout = (LAS float*)(F.lds + 65536);
#pragma unroll
    for (int k = 0; k < 8; ++k) { const int i = tid + 512 * k, r = i >> 6, c = i & 63; if (i < 62 * 64) *(LAS u32x4*)(tin + r * 256 + c * 4) = R.v[k]; }
    lds_bar();
    { const int cp = tid & 255, th = tid >> 8;
      f32x2 xin[46];
#pragma unroll
      for (int r = 0; r < 46; ++r) { const unsigned w = tin[(th * 16 + r) * 256 + cp]; xin[r] = (f32x2){bf_lo(w), bf_hi(w)}; }
#pragma unroll
      for (int tt = 0; tt < 16; ++tt) { f32x2 a = cb;
#pragma unroll
          for (int j = 0; j < 31; ++j) a += cw[j] * xin[tt + j];
          *(LAS f32x2*)(tout + (th * 16 + tt) * 512 + cp * 2) = a; } }
    lds_bar();
    if (unext >= 0) conv_load(F, unext, R);
    { const f32x4 lg0 = *(const f32x4*)(F.inp(12) + lane * 8), lg1 = *(const f32x4*)(F.inp(12) + lane * 8 + 4), lb0 = *(const f32x4*)(F.inp(13) + lane * 8), lb1 = *(const f32x4*)(F.inp(13) + lane * 8 + 4);
      f32x4 v0[4], v1[4]; float sm[4], sq[4];
#pragma unroll
      for (int q = 0; q < 4; ++q) { const int tl = wid * 4 + q; v0[q] = *(const LAS f32x4*)(tout + tl * 512 + lane * 8); v1[q] = *(const LAS f32x4*)(tout + tl * 512 + lane * 8 + 4);
          sm[q] = (v0[q][0] + v0[q][1]) + (v0[q][2] + v0[q][3]) + (v1[q][0] + v1[q][1]) + (v1[q][2] + v1[q][3]); }
#pragma unroll
      for (int o = 1; o < 64; o <<= 1) {
#pragma unroll
          for (int q = 0; q < 4; ++q) sm[q] += __shfl_xor(sm[q], o); }
#pragma unroll
      for (int q = 0; q < 4; ++q) { const float mu = sm[q] * (1.f / 512.f); v0[q] = v0[q] - mu; v1[q] = v1[q] - mu;
          sq[q] = (v0[q][0] * v0[q][0] + v0[q][1] * v0[q][1]) + (v0[q][2] * v0[q][2] + v0[q][3] * v0[q][3]) + (v1[q][0] * v1[q][0] + v1[q][1] * v1[q][1]) + (v1[q][2] * v1[q][2] + v1[q][3] * v1[q][3]); }
#pragma unroll
      for (int o = 1; o < 64; o <<= 1) {
#pragma unroll
          for (int q = 0; q < 4; ++q) sq[q] += __shfl_xor(sq[q], o); }
#pragma unroll
      for (int q = 0; q < 4; ++q) { const int tl = wid * 4 + q; const float rs = 1.0f / sqrtf(sq[q] * (1.f / 512.f) + EPS);
          f32x4 y0 = v0[q] * rs * lg0 + lb0, y1 = v1[q] * rs * lg1 + lb1;
#pragma unroll
          for (int j = 0; j < 4; ++j) { y0[j] *= fsigmoid(y0[j]); y1[j] *= fsigmoid(y1[j]); }
          st_wt16((bf16*)(F.ws + WS_AC) + (size_t)(t0 + tl) * 1024 + 512 + lane * 8, pack8(y0, y1)); } }
    lds_bar();
}

__device__ __forceinline__ void p2_phase(Frame& F) {
    for (int u = F.vcu; u < 256; u += F.G) compress_unit(F, u);
}

namespace att {
#ifndef REPS_SEL
#define REPS_SEL 1
#endif
#ifndef REPS_WIN
#define REPS_WIN 1
#endif
#if defined(ABL)
#define ABLF(k) (ABL == (k) ? 0.f : 1.f) *
#else
#define ABLF(k)
#endif
constexpr int L_K = 0, L_V = 24576, L_WS = 57344, L_SEL = L_WS + 2048, L_WU = L_SEL + 512, L_Q = L_WU + 64, L_OST = 61440, L_IMP = L_OST;
static_assert(L_Q + 16 <= L_OST && L_OST + 65536 <= RING_BYTES && 64 * 65 * 4 <= 65536, "attention LDS map");
__device__ __forceinline__ int crow(int r, int hi) { return (r & 3) + 8 * (r >> 2) + 4 * hi; }

template <bool NEEDV> __device__ __forceinline__ void dma_tile(LAS unsigned char* lds, int slot, const bf16* Kb, const bf16* Vb, int pitch, int key0, int wid, int lane) {
    __builtin_amdgcn_global_load_lds((const unsigned*)((Kb + key0 * pitch) + (unsigned)(lane * pitch + wid * 8)), (LAS unsigned*)(lds + L_K + slot * 8192 + wid * 1024), 16, 0, 0);
    if (NEEDV) __builtin_amdgcn_global_load_lds((const unsigned*)((Vb + key0 * pitch) + (unsigned)((16 * (wid & 3) + (lane >> 2)) * pitch + (wid >> 2) * 32 + (lane & 3) * 8)), (LAS unsigned*)(lds + L_V + slot * 8192 + wid * 1024), 16, 0, 0);
}
template <int KEEP> __device__ __forceinline__ void wait_bar() {
    if (KEEP == 2) asm volatile("s_waitcnt vmcnt(2) lgkmcnt(0)" ::: "memory");
    else if (KEEP == 1) asm volatile("s_waitcnt vmcnt(1) lgkmcnt(0)" ::: "memory");
    else asm volatile("s_waitcnt vmcnt(0) lgkmcnt(0)" ::: "memory");
    __builtin_amdgcn_s_barrier();
    asm volatile("" ::: "memory");
}
__device__ __forceinline__ void dma_k(LAS unsigned char* lds, int slot, const bf16* Kb, int pitch, int key0, int wid, int lane) {
    __builtin_amdgcn_global_load_lds((const unsigned*)(Kb + (unsigned)((key0 + lane) * pitch + wid * 8)), (LAS unsigned*)(lds + L_K + slot * 8192 + wid * 1024), 16, 0, 0);
}
__device__ __forceinline__ void dma_v(LAS unsigned char* lds, int slot, const bf16* Vb, int pitch, int key0, int wid, int lane) {
    __builtin_amdgcn_global_load_lds((const unsigned*)(Vb + (unsigned)((key0 + 16 * (wid & 3) + (lane >> 2)) * pitch + (wid >> 2) * 32 + (lane & 3) * 8)), (LAS unsigned*)(lds + L_V + slot * 8192 + wid * 1024), 16, 0, 0);
}
__device__ __forceinline__ void wait_bar_n(int keep) {
    if (keep >= 4) asm volatile("s_waitcnt vmcnt(4) lgkmcnt(0)" ::: "memory");
    else if (keep == 3) asm volatile("s_waitcnt vmcnt(3) lgkmcnt(0)" ::: "memory");
    else if (keep == 2) asm volatile("s_waitcnt vmcnt(2) lgkmcnt(0)" ::: "memory");
    else if (keep == 1) asm volatile("s_waitcnt vmcnt(1) lgkmcnt(0)" ::: "memory");
    else asm volatile("s_waitcnt vmcnt(0) lgkmcnt(0)" ::: "memory");
    __builtin_amdgcn_s_barrier();
    asm volatile("" ::: "memory");
}
__device__ __forceinline__ void qk_tile(f32x16& p0, f32x16& p1, const LAS unsigned char* Ks, const bf16x8 (&qr)[4], const f32x16& c0, const f32x16& c1, int r32, int hi) {
    const LAS unsigned char* kb = Ks + hi * 1024 + r32 * 16;
#pragma unroll
    for (int d0 = 0; d0 < 4; ++d0) {
        const bf16x8 b0 = *(const LAS bf16x8*)(kb + d0 * 2048), b1 = *(const LAS bf16x8*)(kb + d0 * 2048 + 512);
        if (d0 == 0) { p0 = __builtin_amdgcn_mfma_f32_32x32x16_bf16(b0, qr[0], c0, 0, 0, 0); p1 = __builtin_amdgcn_mfma_f32_32x32x16_bf16(b1, qr[0], c1, 0, 0, 0); }
        else { p0 = __builtin_amdgcn_mfma_f32_32x32x16_bf16(b0, qr[d0], p0, 0, 0, 0); p1 = __builtin_amdgcn_mfma_f32_32x32x16_bf16(b1, qr[d0], p1, 0, 0, 0); } }
}
__device__ __forceinline__ void qk_half_ext(f32x16& p, const LAS unsigned char* Ks, int half, const bf16x8 (&qr)[4], const bf16x8 qext, const bf16x8 ae, int r32, int hi) {
    const LAS unsigned char* kb = Ks + hi * 1024 + r32 * 16 + half * 512;
    const f32x16 z = (f32x16){0.f};
    p = __builtin_amdgcn_mfma_f32_32x32x16_bf16(ae, qext, z, 0, 0, 0);
#pragma unroll
    for (int d0 = 0; d0 < 4; ++d0) { const bf16x8 b0 = *(const LAS bf16x8*)(kb + d0 * 2048); p = __builtin_amdgcn_mfma_f32_32x32x16_bf16(b0, qr[d0], p, 0, 0, 0); }
}
__device__ __forceinline__ void ref_words(float mhat, int hi, unsigned& w2, unsigned& w3) {
    const float x = -mhat; const unsigned a = cvt_pk_bf16(x, 0.f) & 0xffffu; const float r1 = x - __uint_as_float(a << 16);
    const unsigned bb = cvt_pk_bf16(r1, 0.f) & 0xffffu; const float r2 = r1 - __uint_as_float(bb << 16); const unsigned c = cvt_pk_bf16(r2, 0.f) & 0xffffu;
    w2 = hi ? 0u : (a | (bb << 16)); w3 = hi ? 0u : c;
}
__device__ __forceinline__ float max3f(float a, float b, float c) { return fmaxf(fmaxf(a, b), c); }
__device__ __forceinline__ float rowmax32(const f32x16& p0, const f32x16& p1) {
    float a = max3f(p0[0], p0[1], p1[0]), b = max3f(p0[2], p0[3], p1[1]); a = max3f(a, p1[2], p1[3]);
#pragma unroll
    for (int r = 4; r < 16; r += 4) { a = max3f(a, p0[r], p0[r + 1]); b = max3f(b, p0[r + 2], p0[r + 3]); a = max3f(a, p1[r], p1[r + 1]); b = max3f(b, p1[r + 2], p1[r + 3]); }
    const float m = fmaxf(a, b);
    return fmaxf(m, __shfl_xor(m, 32));
}
__device__ __forceinline__ s16x4 vtr(unsigned addr) { s16x4 r; asm volatile("ds_read_b64_tr_b16 %0, %1" : "=v"(r) : "v"(addr) : "memory"); return r; }
__device__ __forceinline__ float rowmax16(const f32x16& p) {
    float a = max3f(p[0], p[1], p[2]), bq = max3f(p[3], p[4], p[5]);
    a = max3f(a, p[6], p[7]); bq = max3f(bq, p[8], p[9]); a = max3f(a, p[10], p[11]); bq = max3f(bq, p[12], p[13]); a = max3f(a, p[14], p[15]);
    const float m = fmaxf(a, bq);
    return fmaxf(m, __shfl_xor(m, 32));
}
template <bool FIRST>
__device__ __forceinline__ void softmax_half(f32x16& p, f32x16& nx, bool hasn, float& mhat, unsigned& rw2, unsigned& rw3, float& l, f32x16 (&o)[2], LAS float* wsf, int r32, int hi) {
    constexpr float THR = 8.f;
    const float rm = rowmax16(p);
    if (FIRST || __any(rm > THR)) {
        float dl = FIRST ? rm : ((rm > THR) ? rm : 0.f);
        if (dl == -INFINITY) dl = 0.f;
        mhat += dl;
#pragma unroll
        for (int r = 0; r < 16; ++r) p[r] -= dl;
        ref_words(mhat, hi, rw2, rw3);
        if (hasn) {
#pragma unroll
            for (int r = 0; r < 16; ++r) nx[r] -= dl; }
        if (!FIRST) {
            const float f = __builtin_amdgcn_exp2f(-dl); l *= f;
            if (hi == 0) wsf[r32] = f;
            LDS_WAIT();
#pragma unroll
            for (int a = 0; a < 4; ++a) { const f32x4 fv = *(const LAS f32x4*)(wsf + 8 * a + 4 * hi);
#pragma unroll
                for (int j = 0; j < 4; ++j) { o[0][4 * a + j] *= fv[j]; o[1][4 * a + j] *= fv[j]; } }
            LDS_WAIT();
        }
    }
    float s = 0.f;
#pragma unroll
    for (int r = 0; r < 16; ++r) { p[r] = __builtin_amdgcn_exp2f(p[r]); s += p[r]; }
    l += s;
}
__device__ __forceinline__ void pv_half(f32x16 (&o)[2], unsigned vbase, int half, const f32x16& p) {
#pragma unroll
    for (int k2 = 0; k2 < 2; ++k2) { const int ks = 2 * half + k2;
        s16x4 lo[2], hi[2];
#pragma unroll
        for (int d0 = 0; d0 < 2; ++d0) { lo[d0] = vtr(vbase + d0 * 4096 + ks * 1024); hi[d0] = vtr(vbase + d0 * 4096 + ks * 1024 + 512); }
        const int bb = k2 * 8;
        u32x4 w; w.x = cvt_pk_bf16(p[bb + 0], p[bb + 1]); w.y = cvt_pk_bf16(p[bb + 2], p[bb + 3]); w.z = cvt_pk_bf16(p[bb + 4], p[bb + 5]); w.w = cvt_pk_bf16(p[bb + 6], p[bb + 7]);
        const bf16x8 pa = __builtin_bit_cast(bf16x8, w);
        asm volatile("s_waitcnt lgkmcnt(0)" : "+v"(lo[0]), "+v"(lo[1]), "+v"(hi[0]), "+v"(hi[1]) :: "memory");
        __builtin_amdgcn_sched_barrier(0);
#pragma unroll
        for (int d0 = 0; d0 < 2; ++d0) { const bf16x8 vf = (bf16x8){lo[d0][0], lo[d0][1], lo[d0][2], lo[d0][3], hi[d0][0], hi[d0][1], hi[d0][2], hi[d0][3]};
            o[d0] = __builtin_amdgcn_mfma_f32_32x32x16_bf16(pa, vf, o[d0], 0, 0, 0); }
    }
}
template <int MT> __device__ __forceinline__ void mask_half(f32x16& p, int lim, int off) {
#pragma unroll
    for (int r = 0; r < 16; ++r) { const int c = (r & 3) + 8 * (r >> 2) + off;
        if (MT == 2) { if (!(c > lim)) p[r] = -INFINITY; } else { if (!(c <= lim)) p[r] = -INFINITY; } }
}
template <int MT> __device__ __forceinline__ void mask_tile(f32x16& p0, f32x16& p1, int lim) {
    if (MT == 0) return;
#pragma unroll
    for (int r = 0; r < 16; ++r) { const int c = (r & 3) + 8 * (r >> 2);
        if (MT == 2) { if (!(c > lim)) p0[r] = -INFINITY; if (!(c + 32 > lim)) p1[r] = -INFINITY; }
        else { if (!(c <= lim)) p0[r] = -INFINITY; if (!(c + 32 <= lim)) p1[r] = -INFINITY; } }
}
__device__ __forceinline__ void pv_tile(f32x16 (&o)[2], unsigned vbase, const f32x16& p0, const f32x16& p1) {
#pragma unroll
    for (int ks = 0; ks < 4; ++ks) {
        s16x4 lo[2], hi[2];
#pragma unroll
        for (int d0 = 0; d0 < 2; ++d0) { lo[d0] = vtr(vbase + d0 * 4096 + ks * 1024); hi[d0] = vtr(vbase + d0 * 4096 + ks * 1024 + 512); }
        const f32x16& P = (ks < 2) ? p0 : p1; const int b = (ks & 1) * 8;
        u32x4 w; w.x = cvt_pk_bf16(P[b + 0], P[b + 1]); w.y = cvt_pk_bf16(P[b + 2], P[b + 3]); w.z = cvt_pk_bf16(P[b + 4], P[b + 5]); w.w = cvt_pk_bf16(P[b + 6], P[b + 7]);
        const bf16x8 pa = __builtin_bit_cast(bf16x8, w);
        asm volatile("s_waitcnt lgkmcnt(0)" : "+v"(lo[0]), "+v"(lo[1]), "+v"(hi[0]), "+v"(hi[1]) :: "memory");
        __builtin_amdgcn_sched_barrier(0);
#pragma unroll
        for (int d0 = 0; d0 < 2; ++d0) { const bf16x8 vf = (bf16x8){lo[d0][0], lo[d0][1], lo[d0][2], lo[d0][3], hi[d0][0], hi[d0][1], hi[d0][2], hi[d0][3]};
            o[d0] = __builtin_amdgcn_mfma_f32_32x32x16_bf16(pa, vf, o[d0], 0, 0, 0); }
    }
}
__device__ __forceinline__ float max32(const f32x16& p0, const f32x16& p1) {
    float a = fmaxf(p0[0], p1[0]);
#pragma unroll
    for (int r = 1; r < 16; ++r) a = fmaxf(a, fmaxf(p0[r], p1[r]));
    return fmaxf(a, __shfl_xor(a, 32));
}
__device__ __forceinline__ void softmax_step(f32x16& p0, f32x16& p1, float sk, bool lv, float& m, float& l, f32x16 (&o)[2], LAS float* wsf, int r32, int hi) {
    const float rm = max32(p0, p1);
    const float rmt = lv ? rm + sk : -INFINITY;
    const float mn = fmaxf(m, rmt);
    const float mup = (mn == -INFINITY || !lv) ? INFINITY : mn - sk;
    const float f = (mn == -INFINITY) ? 1.f : __builtin_amdgcn_exp2f(m - mn);
    float s = 0.f;
#pragma unroll
    for (int r = 0; r < 16; ++r) { p0[r] = __builtin_amdgcn_exp2f(p0[r] - mup); p1[r] = __builtin_amdgcn_exp2f(p1[r] - mup); s += p0[r] + p1[r]; }
    l = l * f + s;
    if (__any(mn != m)) {
        if (hi == 0) wsf[r32] = f;
        LDS_WAIT();
#pragma unroll
        for (int a = 0; a < 4; ++a) { const f32x4 fv = *(const LAS f32x4*)(wsf + 8 * a + 4 * hi);
#pragma unroll
            for (int j = 0; j < 4; ++j) { o[0][4 * a + j] *= fv[j]; o[1][4 * a + j] *= fv[j]; } }
        LDS_WAIT();
    }
    m = mn;
}
template <bool FIRST>
__device__ __forceinline__ void accum_out(LAS float* stg, const f32x16 (&o)[2], float scale, LAS float* wsf, int r32, int hi) {
    if (hi == 0) wsf[r32] = scale;
    LDS_WAIT();
#pragma unroll
    for (int a = 0; a < 4; ++a) { const f32x4 fv = *(const LAS f32x4*)(wsf + 8 * a + 4 * hi);
#pragma unroll
        for (int j = 0; j < 4; ++j) { LAS float* p = stg + (j + 8 * a + 4 * hi) * 64 + r32;
            float v0 = o[0][4 * a + j] * fv[j], v1 = o[1][4 * a + j] * fv[j];
            if (!FIRST) { v0 += p[0]; v1 += p[32]; }
            p[0] = v0; p[32] = v1; } }
    LDS_WAIT();
}

#ifdef PROF_MODE
#define PROF_T0() const unsigned long long pt0_ = __builtin_amdgcn_s_memrealtime()
#define PROF_ACC() do { if (threadIdx.x == 0) { LAS unsigned* pa_ = (LAS unsigned*)(lds + MISC_OFF + 64); pa_[0] += (unsigned)(__builtin_amdgcn_s_memrealtime() - pt0_); } } while (0)
#else
#define PROF_T0() do {} while (0)
#define PROF_ACC() do {} while (0)
#endif
template <bool SEL>
__device__ __forceinline__ void att_branch(LAS unsigned char* lds, const bf16* Kb, const bf16* Vb, unsigned long long blocks, unsigned long long mysel, int qt, int t0, int ql,
                                           const bf16x8 (&qr)[4], unsigned spk, unsigned wpk0, unsigned wpk1, float& l, f32x16 (&o)[2], int wid, int lane_) {
    int lane = lane_; asm volatile("" : "+v"(lane));
    const int r32 = lane & 31, hi = lane >> 5;
    LAS float* wsf = (LAS float*)(lds + L_WS) + wid * 64;
    const unsigned vb0 = (unsigned)(uintptr_t)(lds + L_V) + ((lane >> 4) & 1) * 32 + (lane & 3) * 8 + (4 * hi + ((lane & 15) >> 2)) * 64;
#if defined(PROF_MODE) && PROF_MODE == 2
    PROF_T0();
#endif
    const int n = SEL ? __builtin_popcountll(blocks) : (qt < 8 ? qt + 1 : 9);
    unsigned long long rem = blocks; int wnext = qt, issued = 0;
    auto pop = [&]() -> int { if (issued >= n) return -1; ++issued; if (SEL) { const int j = 63 - __builtin_clzll(rem); rem &= ~(1ull << j); return j; } else return wnext--; };
    auto mineof = [&](int j) -> bool { return SEL ? (bool)((mysel >> j) & 1ull) : true; };
    int j0 = pop(), j1 = pop(), j2 = pop();
    dma_k(lds, 0, Kb, 768, j0 * 64, wid, lane); dma_v(lds, 0, Vb, 768, j0 * 64, wid, lane);
    if (j1 >= 0) { dma_k(lds, 1, Kb, 768, j1 * 64, wid, lane); dma_v(lds, 1, Vb, 768, j1 * 64, wid, lane); }
    if (j2 >= 0) { dma_k(lds, 2, Kb, 768, j2 * 64, wid, lane); dma_v(lds, 2, Vb, 768, j2 * 64, wid, lane); }
    float mhat = 0.f; unsigned rw2 = 0u, rw3 = 0u; l = 0.f; o[0] = (f32x16){0.f}; o[1] = (f32x16){0.f};
    f32x16 h0, h1;
    const unsigned one2 = hi ? 0u : 0x3f803f80u, one1 = hi ? 0u : 0x00003f80u;
#define ATT_QKH(P, j_, ks_, half_) do { const float Pf_ = (float)((j_) * 64 - t0); const unsigned ppk_ = hi ? 0u : cvt_pk_bf16(Pf_, Pf_); \
        qk_half_ext(P, lds + L_K + (ks_) * 8192, half_, qr, __builtin_bit_cast(bf16x8, (u32x4){spk, spk, rw2, rw3}), __builtin_bit_cast(bf16x8, (u32x4){ppk_, (half_) ? wpk1 : wpk0, one2, one1}), r32, hi); } while (0)
#define ATT_MASK(P, j_, m_, off_) do { \
        if ((j_) == qt) mask_half<1>(P, ql - 4 * hi, off_); else if (!SEL && (j_) == qt - 8) mask_half<2>(P, ql - 4 * hi, off_); \
        if (SEL && !__all(m_)) { _Pragma("unroll") for (int r = 0; r < 16; ++r) P[r] = (m_) ? P[r] : -INFINITY; } } while (0)
    wait_bar_n((j1 >= 0 ? 2 : 0) + (j2 >= 0 ? 2 : 0));
    ATT_QKH(h0, j0, 0, 0);
    int ks = 0, vs = 0; bool first = true;
    while (j0 >= 0) {
        const bool m0 = mineof(j0); const bool do0 = !SEL || __any(m0);
        if (do0) { ATT_QKH(h1, j0, ks, 1); __builtin_amdgcn_sched_barrier(0);
            ATT_MASK(h0, j0, m0, 0);
            if (first) softmax_half<true>(h0, h1, true, mhat, rw2, rw3, l, o, wsf, r32, hi); else softmax_half<false>(h0, h1, true, mhat, rw2, rw3, l, o, wsf, r32, hi);
            pv_half(o, vb0 + vs * 8192, 0, h0); }
#if defined(PROF_MODE) && PROF_MODE == 1
        { PROF_T0(); wait_bar_n((j2 >= 0 ? 2 : 0)); PROF_ACC(); }
#else
        wait_bar_n((j2 >= 0 ? 2 : 0));
#endif
        const int j3 = pop();
        if (j3 >= 0) { dma_k(lds, ks, Kb, 768, j3 * 64, wid, lane); dma_v(lds, (vs + 3) & 3, Vb, 768, j3 * 64, wid, lane); }
        bool m1 = false, do1 = false; if (j1 >= 0) { m1 = mineof(j1); do1 = !SEL || __any(m1); }
        const int ks1 = (ks == 2) ? 0 : ks + 1;
        if (do1) ATT_QKH(h0, j1, ks1, 0);
        __builtin_amdgcn_sched_barrier(0);
        if (do0) { ATT_MASK(h1, j0, m0, 32);
            softmax_half<false>(h1, h0, do1, mhat, rw2, rw3, l, o, wsf, r32, hi);
            pv_half(o, vb0 + vs * 8192, 1, h1); }
        j0 = j1; j1 = j2; j2 = j3; ks = ks1; vs = (vs + 1) & 3; first = false;
    }
#undef ATT_QKH
#undef ATT_MASK
    l += __shfl_xor(l, 32);
    wait_bar<0>();
#if defined(PROF_MODE) && PROF_MODE == 2
    PROF_ACC();
#endif
}

__device__ __forceinline__ void attn_unit(Frame& F, int b, int g, int qt, int lu) {
    LAS unsigned char* lds = F.lds;
    const int tid = F.tid, lane = F.lane, wid = F.wave, r32 = lane & 31, hi = lane >> 5, hr = wid >> 1, qh = wid & 1;
    const int head = g * 4 + hr, t0 = qt * 64, ql = qh * 32 + r32, tq = t0 + ql;
    const float slope2 = __builtin_amdgcn_exp2f(-(float)(head + 1)) * LOG2E;
    const size_t rowq = (size_t)b * SEQ + tq;
    const bf16* Qb = (const bf16*)(F.ws + WS_QB);
    const bf16* KVb = (const bf16*)(F.ws + WS_KVB) + (size_t)b * SEQ * 768;
    const bf16* KC = (const bf16*)(F.ws + WS_KC) + (size_t)(b * 2 + g) * 256 * 64;
    const bf16* VC = (const bf16*)(F.ws + WS_VC) + (size_t)(b * 2 + g) * 256 * 64;
    const float* NG = (const float*)(F.ws + WS_NG) + rowq * 32 + g * 12 + hr * 3;
    LAS float* wsf = (LAS float*)(lds + L_WS) + wid * 64;
    LAS unsigned* imp = (LAS unsigned*)(lds + L_IMP);
    LAS unsigned long long* sel = (LAS unsigned long long*)(lds + L_SEL);
    LAS unsigned long long* wun = (LAS unsigned long long*)(lds + L_WU);
    const unsigned vb0 = (unsigned)(uintptr_t)(lds + L_V) + ((lane >> 4) & 1) * 32 + (lane & 3) * 8 + (4 * hi + ((lane & 15) >> 2)) * 64;
    bf16x8 qr[4];
#pragma unroll
    for (int d0 = 0; d0 < 4; ++d0) qr[d0] = *(const bf16x8*)(Qb + rowq * 512 + head * 64 + d0 * 16 + hi * 8);
    LAS float* stg = (LAS float*)(lds + L_OST) + wid * 2048;
    const float gate_c = NG[0], gate_s = NG[1], gate_w = NG[2];
    f32x16 o[2], p0, p1;
    const bool need_imp = qt >= 8;
    const int ntc = min(4, (4 * qt + 2) / 64 + 1);
    const int nmax = (tq >= 31) ? ((tq - 31) >> 4) : -1;
#if defined(PROF_MODE) && (PROF_MODE == 3 || PROF_MODE == 5)
    PROF_T0();
#endif
    unsigned spk, wpk0, wpk1;
    { const unsigned sh = cvt_pk_bf16(slope2, 0.f) & 0xffffu; const float shf = __uint_as_float(sh << 16); spk = hi ? 0u : (sh | (cvt_pk_bf16(0.f, slope2 - shf) & 0xffff0000u));
      wpk0 = hi ? 0u : cvt_pk_bf16((float)r32, (float)r32); wpk1 = hi ? 0u : cvt_pk_bf16((float)(r32 + 32), (float)(r32 + 32)); }
    const unsigned wc0 = hi ? 0u : cvt_pk_bf16((float)(16 * r32), (float)(16 * r32)), wc1 = hi ? 0u : cvt_pk_bf16((float)(16 * r32 + 512), (float)(16 * r32 + 512));
    const unsigned cone2 = hi ? 0u : 0x3f803f80u, cone1 = hi ? 0u : 0x00003f80u;
    float l = 0.f, mhat = 0.f;
    o[0] = (f32x16){0.f}; o[1] = (f32x16){0.f};
    float gacc[4][8], lacc[4][8];
    dma_tile<true>(lds, 0, KC, VC, 64, 0, wid, lane);
    if (ntc > 1) dma_tile<true>(lds, 1, KC, VC, 64, 64, wid, lane);
    for (int i = tid; i < 64 * 65; i += 512) imp[i] = 0u;
#pragma unroll
    for (int it = 0; it < 4; ++it) {
        if (it < ntc) {
            const int sl = (it == 3) ? 0 : it;
            if (it + 1 < ntc) wait_bar<2>(); else wait_bar<0>();
            if (it + 2 < ntc) dma_tile<true>(lds, (it + 2 == 3) ? 0 : it + 2, KC, VC, 64, (it + 2) * 64, wid, lane);
            { const float Pf = (float)(1024 * it - t0); const unsigned ppk = hi ? 0u : cvt_pk_bf16(Pf, Pf);
              const bf16x8 qx = __builtin_bit_cast(bf16x8, (u32x4){spk, spk, 0u, 0u});
              qk_half_ext(p0, lds + L_K + sl * 8192, 0, qr, qx, __builtin_bit_cast(bf16x8, (u32x4){ppk, wc0, cone2, cone1}), r32, hi);
              qk_half_ext(p1, lds + L_K + sl * 8192, 1, qr, qx, __builtin_bit_cast(bf16x8, (u32x4){ppk, wc1, cone2, cone1}), r32, hi); }
            if (64 * it + 63 > 4 * qt - 2) mask_tile<3>(p0, p1, nmax - 64 * it - 4 * hi);
            const float sk = 0.f;
            const float rm = max32(p0, p1) + sk;
            if (it == 0) mhat = (rm == -INFINITY) ? 0.f : rm;
            else if (__any(rm > mhat + 8.f)) {
                const float dl = (rm > mhat + 8.f) ? rm - mhat : 0.f; mhat += dl;
                const float f = __builtin_amdgcn_exp2f(-dl); l *= f;
#pragma unroll
                for (int t2 = 0; t2 < 4; ++t2) if (t2 < it) {
#pragma unroll
                    for (int a = 0; a < 8; ++a) { gacc[t2][a] *= f; lacc[t2][a] *= f; } }
                if (hi == 0) wsf[r32] = f;
                LDS_WAIT();
#pragma unroll
                for (int a = 0; a < 4; ++a) { const f32x4 fv = *(const LAS f32x4*)(wsf + 8 * a + 4 * hi);
#pragma unroll
                    for (int j = 0; j < 4; ++j) { o[0][4 * a + j] *= fv[j]; o[1][4 * a + j] *= fv[j]; } }
                LDS_WAIT();
            }
            const float mup = mhat - sk; float s = 0.f;
#pragma unroll
            for (int r = 0; r < 16; ++r) { p0[r] = __builtin_amdgcn_exp2f(p0[r] - mup); p1[r] = __builtin_amdgcn_exp2f(p1[r] - mup); s += p0[r] + p1[r]; }
            l += s;
#pragma unroll
            for (int a = 0; a < 4; ++a) { gacc[it][a] = (p0[4 * a] + p0[4 * a + 1]) + (p0[4 * a + 2] + p0[4 * a + 3]); gacc[it][4 + a] = (p1[4 * a] + p1[4 * a + 1]) + (p1[4 * a + 2] + p1[4 * a + 3]);
                lacc[it][a] = p0[4 * a + 3]; lacc[it][4 + a] = p1[4 * a + 3]; }
            pv_tile(o, vb0 + sl * 8192, p0, p1);
        }
    }
    l += __shfl_xor(l, 32);
    const float inv_lc = (l > 0.f) ? 1.0f / l : 0.f;
    if (need_imp) { const float sc = inv_lc * 134217728.f;
#pragma unroll
        for (int it = 0; it < 4; ++it) if (it < ntc) {
#pragma unroll
            for (int a = 0; a < 4; ++a) { const int j0 = 16 * it + 2 * a + hi, j1 = j0 + 8;
                __hip_atomic_fetch_add(&imp[ql * 65 + j0], (unsigned)(gacc[it][a] * sc + 0.5f), __ATOMIC_RELAXED, __HIP_MEMORY_SCOPE_WORKGROUP);
                __hip_atomic_fetch_add(&imp[ql * 65 + j1], (unsigned)(gacc[it][4 + a] * sc + 0.5f), __ATOMIC_RELAXED, __HIP_MEMORY_SCOPE_WORKGROUP);
                __hip_atomic_fetch_add(&imp[ql * 65 + j0 + 1], (unsigned)(lacc[it][a] * sc + 0.5f), __ATOMIC_RELAXED, __HIP_MEMORY_SCOPE_WORKGROUP);
                if (j1 + 1 < 64) __hip_atomic_fetch_add(&imp[ql * 65 + j1 + 1], (unsigned)(lacc[it][4 + a] * sc + 0.5f), __ATOMIC_RELAXED, __HIP_MEMORY_SCOPE_WORKGROUP); } } }
    wait_bar<0>();
#if defined(PROF_MODE) && PROF_MODE == 3
    PROF_ACC();
#endif
#if defined(PROF_MODE) && PROF_MODE == 4
    PROF_T0();
#endif
#ifndef LATE_TWO
#define LATE_TWO 0
#endif
    f32x4 lv0[16], lv1[16];
#ifndef LATE_IN_P0
    const int lit0 = __builtin_amdgcn_readfirstlane(lu * 16 + wid), lit1 = lit0 + 8;
    { int ln = lane; asm volatile("" : "+v"(ln)); const LateD d0 = late_desc(F, lit0, ln); late_load(d0, lv0);
#if LATE_TWO
      const LateD d1 = late_desc(F, lit1, ln); late_load(d1, lv1);
#endif
    }
#endif
    unsigned long long mysel, uni;
    if (need_imp) {
        int lk = (int)__builtin_amdgcn_mbcnt_hi(~0u, __builtin_amdgcn_mbcnt_lo(~0u, 0u)); asm volatile("" : "+v"(lk));
        int key[8]; unsigned long long msk[8];
#pragma unroll
        for (int qq = 0; qq < 8; ++qq) { const int q = wid * 8 + qq;
            key[qq] = (lk >= 1 && lk <= qt - 2) ? (int)(((imp[q * 65 + lk] >> 4) << 6) | (unsigned)(63 - lk)) : -1;
            msk[qq] = 1ull | (1ull << qt) | (1ull << (qt - 1)); }
#pragma unroll 1
        for (int k = 0; k < 5; ++k) {
            int mx[8];
#pragma unroll
            for (int qq = 0; qq < 8; ++qq) mx[qq] = key[qq];
#pragma unroll
            for (int o2 = 1; o2 < 64; o2 <<= 1) {
#pragma unroll
                for (int qq = 0; qq < 8; ++qq) mx[qq] = max(mx[qq], __shfl_xor(mx[qq], o2)); }
#pragma unroll
            for (int qq = 0; qq < 8; ++qq) { const int js = 63 - (mx[qq] & 63); msk[qq] |= 1ull << js; if (lk == js) key[qq] = -2; }
        }
        unsigned long long wu = 0ull;
#pragma unroll
        for (int qq = 0; qq < 8; ++qq) { if (lk == 0) sel[wid * 8 + qq] = msk[qq]; wu |= msk[qq]; }
        if (lk == 0) wun[wid] = wu;
        wait_bar<0>();
        mysel = sel[ql]; uni = 0ull;
#pragma unroll
        for (int w = 0; w < 8; ++w) uni |= wun[w];
    } else { mysel = (2ull << qt) - 1ull; uni = mysel; }
#if defined(PROF_MODE) && PROF_MODE == 4
    PROF_ACC();
#endif
    uni = ((unsigned long long)__builtin_amdgcn_readfirstlane((unsigned)(uni >> 32)) << 32) | (unsigned long long)__builtin_amdgcn_readfirstlane((unsigned)uni);
#ifndef LATE_IN_P0
#if defined(PROF_MODE) && PROF_MODE == 7
    PROF_T0();
#endif
    { int ln = lane; asm volatile("" : "+v"(ln)); const LateD d0 = late_desc(F, lit0, ln); late_finish(F, d0, lv0); const LateD d1 = late_desc(F, lit1, ln);
#if !LATE_TWO
      late_load(d1, lv1);
#endif
      late_finish(F, d1, lv1); }
#if defined(PROF_MODE) && PROF_MODE == 7
    asm volatile("s_waitcnt vmcnt(0)" ::: "memory"); PROF_ACC();
#endif
#endif
    accum_out<true>(stg, o, ABLF(4) (gate_c * inv_lc), wsf, r32, hi);
    att_branch<true>(lds, KVb + 2 * 128 + g * 64, KVb + 3 * 128 + g * 64, uni, mysel, qt, t0, ql, qr, spk, wpk0, wpk1, l, o, wid, lane);
    accum_out<false>(stg, o, ABLF(5) ((l > 0.f) ? gate_s / l : 0.f), wsf, r32, hi);
    att_branch<false>(lds, KVb + 4 * 128 + g * 64, KVb + 5 * 128 + g * 64, 0ull, 0ull, qt, t0, ql, qr, spk, wpk0, wpk1, l, o, wid, lane);
    accum_out<false>(stg, o, ABLF(6) ((l > 0.f) ? gate_w / l : 0.f), wsf, r32, hi);
    {
        bf16* Ow = (bf16*)(F.ws + WS_AC) + ((size_t)b * SEQ + t0 + qh * 32) * 1024 + head * 64;
#pragma unroll
        for (int i = 0; i < 4; ++i) { const int row = i * 8 + (lane >> 3), ch = lane & 7;
            const f32x4 v0 = *(const LAS f32x4*)(stg + row * 64 + ch * 8), v1 = *(const LAS f32x4*)(stg + row * 64 + ch * 8 + 4);
#if defined(ABL) && ABL == 1
            *(u32x4*)(Ow + (unsigned)(row * 1024 + ch * 8)) = (u32x4){0u, 0u, 0u, 0u}; }
#else
            st_wt16(Ow + (unsigned)(row * 1024 + ch * 8), pack8(v0, v1)); }
#endif
    }
    asm volatile("s_waitcnt lgkmcnt(0)" ::: "memory"); __builtin_amdgcn_s_barrier(); asm volatile("" ::: "memory");
#if defined(PROF_MODE) && PROF_MODE == 5
    PROF_ACC();
#endif
}

__device__ __forceinline__ void attn_phase(Frame& F, int rep) {
    LAS int* qw = (LAS int*)(F.lds + MISC_OFF + 128);
    { int t_ = F.tid; asm volatile("" : "+v"(t_)); for (int i = t_; i < 1024; i += NWAVES * 64) ((LAS float*)(F.lds + L_GAIN))[i] = F.inp(17)[i]; }
    __syncthreads();
#if ATT_XCD_QUEUES
    { const int x0 = (int)(xb_xcc_id() & 7u);
      for (int hop = 0; hop < 8; ++hop) { const int xq = (x0 + hop) & 7;
        for (;;) {
            if (F.tid == 0) qw[0] = (int)__hip_atomic_fetch_add(F.ctl + CW_QX + 64 * (xq + 8 * rep), 1u, RLX_AGENT);
            __syncthreads();
            const int u = qw[0];
            __syncthreads();
            if (u >= 128) break;
            const int qt = 63 - (u >> 1), bg = 2 * xq + (u & 1); attn_unit(F, bg >> 1, bg & 1, qt, 1 << 20);
        } } }
#else
    { int u; unsigned un = 0u;
      if (F.tid == 0) qw[0] = (int)__hip_atomic_fetch_add(F.ctl + CW_QATT + 16 * rep, 1u, RLX_AGENT);
      __syncthreads(); u = qw[0]; __syncthreads();
      while (u < 1024) {
        if (F.tid == 0) un = __hip_atomic_fetch_add(F.ctl + CW_QATT + 16 * rep, 1u, RLX_AGENT);
        const int qt = 63 - (u >> 4), bg = u & 15; attn_unit(F, bg >> 1, bg & 1, qt, u);
        if (F.tid == 0) qw[0] = (int)un;
        asm volatile("s_waitcnt lgkmcnt(0)" ::: "memory"); __builtin_amdgcn_s_barrier(); asm volatile("" ::: "memory");
        u = qw[0];
        asm volatile("s_waitcnt lgkmcnt(0)" ::: "memory"); __builtin_amdgcn_s_barrier(); asm volatile("" ::: "memory");
      } }
#endif
    ConvW cwv; conv_weights(F, cwv);
    { ConvIn cin; int u; unsigned un = 0u;
      if (F.tid == 0) qw[0] = (int)__hip_atomic_fetch_add(F.ctl + CW_QATT + 32 + 16 * rep, 2u, RLX_AGENT);
      __syncthreads(); u = qw[0]; __syncthreads();
      if (u < 1024) conv_load(F, u, cin);
      while (u < 1024) {
        if (F.tid == 0) un = __hip_atomic_fetch_add(F.ctl + CW_QATT + 32 + 16 * rep, 2u, RLX_AGENT);
        conv_unit(F, u, u + 1, cin, cwv);
        if (F.tid == 0) qw[0] = (int)un;
        lds_bar();
        const int u2 = qw[0];
        conv_unit(F, u + 1, u2 < 1024 ? u2 : -1, cin, cwv);
        u = u2;
      } }
}
}
#ifndef X1_IN_WS
#define X1_IN_WS 0
#endif
#if X1_IN_WS
#define X1_OFF WS_X1
#else
#define X1_OFF ((size_t)((unsigned char*)F.out - F.ws))
#endif

__device__ __forceinline__ void p6_router(Frame& F, int rep = 0) {
    const int lane = F.lane, i16 = lane & 15, kq = lane >> 4;
    const bf16* XB = (const bf16*)(F.ws + X1_OFF); const bf16* WR = (const bf16*)(F.ws + WS_WR);
    int* list = (int*)(F.ws + (rep ? WS_GLU : WS_LIST)); float* wt = (float*)(F.ws + WS_WT); float* listw = (float*)(F.ws + WS_LISTW); float* listr = (float*)(F.ws + WS_LISTR); const int cwc = rep ? 8192 : CW_CNT; float* rstd2 = (float*)(F.ws + WS_RSTD2);
    LAS float* lg = (LAS float*)(F.lds + F.wave * 3072);
    LAS unsigned* hist = (LAS unsigned*)(F.lds + 24576); LAS unsigned* base = hist + 32;
    constexpr int WRP = 2064; LAS unsigned char* wrl = F.lds + 25600;
    for (int i = F.tid; i < 48 * 128; i += NWAVES * 64) { const int r = i >> 7, ch = i & 127, sr = r < 16 ? r : r + 16;
        *(LAS u32x4*)(wrl + r * WRP + ch * 16) = *(const u32x4*)(WR + (size_t)sr * 1024 + ch * 8); }
    __syncthreads();
    const int gw = F.vcu * NWAVES + F.wave, NGW = F.G * NWAVES, niter = (T / 16 + NGW - 1) / NGW;
    for (int itr = 0; itr < niter; ++itr) {
        const int grp = itr * NGW + gw; const bool live = grp < T / 16;
        if (F.tid < 32) hist[F.tid] = 0u;
        int ea = 0, eb = 0, tok = 0; float w0 = 0.f, w1 = 0.f, rstd = 0.f;
        if (live) {
            const size_t row = (size_t)grp * 16 + i16;
            f32x4 acc0 = (f32x4){0.f, 0.f, 0.f, 0.f}, acc2 = acc0, acc3 = acc0; float ssq = 0.f;
#pragma unroll 16
            for (int s = 0; s < 32; ++s) {
                const u32x4 w = *(const u32x4*)(XB + row * 1024 + s * 32 + kq * 8);
                f32x4 a0, a1; unpack8(w, a0, a1);
                ssq += (a0[0] * a0[0] + a0[1] * a0[1]) + (a0[2] * a0[2] + a0[3] * a0[3]) + (a1[0] * a1[0] + a1[1] * a1[1]) + (a1[2] * a1[2] + a1[3] * a1[3]);
                const bf16x8 a = __builtin_bit_cast(bf16x8, w);
                const bf16x8 b0 = *(const LAS bf16x8*)(wrl + i16 * WRP + s * 64 + kq * 16);
                const bf16x8 b2 = *(const LAS bf16x8*)(wrl + (16 + i16) * WRP + s * 64 + kq * 16);
                const bf16x8 b3 = *(const LAS bf16x8*)(wrl + (32 + i16) * WRP + s * 64 + kq * 16);
                acc0 = __builtin_amdgcn_mfma_f32_16x16x32_bf16(a, b0, acc0, 0, 0, 0);
                acc2 = __builtin_amdgcn_mfma_f32_16x16x32_bf16(a, b2, acc2, 0, 0, 0);
                acc3 = __builtin_amdgcn_mfma_f32_16x16x32_bf16(a, b3, acc3, 0, 0, 0);
            }
            ssq += __shfl_xor(ssq, 16); ssq += __shfl_xor(ssq, 32);
            rstd = 1.0f / sqrtf(ssq * (1.f / 1024.f) + EPS);
#pragma unroll
            for (int r = 0; r < 4; ++r) { lg[(kq * 4 + r) * 48 + i16] = acc0[r]; lg[(kq * 4 + r) * 48 + 16 + i16] = acc2[r]; lg[(kq * 4 + r) * 48 + 32 + i16] = acc3[r]; }
            LDS_WAIT();
            if (lane < 16) {
                tok = grp * 16 + lane;
                float g4[4];
#pragma unroll
                for (int c = 0; c < 4; ++c) g4[c] = lg[lane * 48 + c] * rstd + F.inp(19)[c];
                int gs = 0; float gm = g4[0];
#pragma unroll
                for (int c = 1; c < 4; ++c) if (g4[c] > gm) { gm = g4[c]; gs = c; }
                float den = 0.f;
#pragma unroll
                for (int c = 0; c < 4; ++c) den += __builtin_amdgcn_exp2f((g4[c] - gm) * LOG2E);
                const float pg = 1.0f / den;
                float e8[8];
#pragma unroll
                for (int c = 0; c < 8; ++c) e8[c] = lg[lane * 48 + 16 + gs * 8 + c] * rstd + F.inp(21)[gs * 8 + c];
                int i1 = 0; float m1 = e8[0];
#pragma unroll
                for (int c = 1; c < 8; ++c) if (e8[c] > m1) { m1 = e8[c]; i1 = c; }
                int i2 = -1; float m2 = -INFINITY;
#pragma unroll
                for (int c = 0; c < 8; ++c) if (c != i1 && e8[c] > m2) { m2 = e8[c]; i2 = c; }
                const float ex = __builtin_amdgcn_exp2f((m2 - m1) * LOG2E);
                w0 = pg / (1.f + ex); w1 = pg * ex / (1.f + ex);
                ea = gs * 8 + i1; eb = gs * 8 + i2;
            }
        }
        __syncthreads();
        unsigned ra = 0u, rb = 0u;
        if (live && lane < 16) { ra = __hip_atomic_fetch_add(hist + ea, 1u, __ATOMIC_RELAXED, __HIP_MEMORY_SCOPE_WORKGROUP); rb = __hip_atomic_fetch_add(hist + eb, 1u, __ATOMIC_RELAXED, __HIP_MEMORY_SCOPE_WORKGROUP); }
        __syncthreads();
        if (F.tid < 32) { const unsigned h = hist[F.tid]; base[F.tid] = h ? __hip_atomic_fetch_add(F.ctl + cwc + 64 * F.tid, h, RLX_AGENT) : 0u; }
        __syncthreads();
        if (live && lane < 16) {
            const int pa = ea * LISTCAP + base[ea] + ra, pb = eb * LISTCAP + base[eb] + rb;
            list[pa] = tok * 2; list[pb] = tok * 2 + 1; if (!rep) { listw[pa] = w0; listw[pb] = w1; listr[pa] = rstd; listr[pb] = rstd; }
            wt[tok * 2] = w0; wt[tok * 2 + 1] = w1; rstd2[tok] = rstd;
        }
        __syncthreads();
    }
}

__device__ __forceinline__ void moe_table(Frame& F) {
    LAS int* tab = (LAS int*)(F.lds + MOE_OFF);
    if (F.tid < 32) tab[33 + F.tid] = (int)__hip_atomic_load(F.ctl + CW_CNT + 64 * F.tid, RLX_AGENT);
    __syncthreads();
    if (F.tid < 32) {
        const int e = F.tid, cnt = tab[33 + e], rem = cnt & 255;
        int ts = 0, fb = 0, nfull = 0, rank = 0;
        for (int k = 0; k < 32; ++k) { const int ck = tab[33 + k], rk = ck & 255;
            if (k < e) { ts += (ck + 255) >> 8; fb += ck >> 8; }
            nfull += ck >> 8;
            if (rk && (rk > rem || (rk == rem && k < e))) ++rank; }
        tab[e] = ts;
        for (int k = 0; k < (cnt >> 8); ++k) tab[80 + fb + k] = (ts + k) | (e << 16);
        if (rem) tab[80 + nfull + rank] = (ts + (cnt >> 8)) | (e << 16);
        if (e == 31) tab[32] = ts + ((cnt + 255) >> 8);
    }
    __syncthreads();
}

__device__ __forceinline__ void p9_combine(Frame& F) {
    const int lane = F.lane; const int gw = F.vcu * NWAVES + F.wave, NGW = F.G * NWAVES;
    const bf16* Y = (const bf16*)(F.ws + WS_Y); const bf16* X1 = (const bf16*)(F.ws + X1_OFF); bf16* XB = (bf16*)(F.ws + WS_XN); float* rstd3 = (float*)(F.ws + WS_RSTD3);
#pragma unroll 2
    for (int m = gw; m < T; m += NGW) {
        const u32x4* xr = (const u32x4*)(X1 + (size_t)m * DM) + lane;
        const u32x2* y0 = (const u32x2*)((const unsigned char*)Y + (size_t)(2 * m) * DM) + lane; const u32x2* y1 = (const u32x2*)((const unsigned char*)Y + (size_t)(2 * m + 1) * DM) + lane;
        u32x4* ob = (u32x4*)(XB + (size_t)m * DM) + lane; u32x2* o8 = (u32x2*)(F.ws + WS_X1F8 + (size_t)m * DM) + lane;
        float s = 0.f;
#pragma unroll
        for (int j = 0; j < 2; ++j) { f32x4 v0, v1, a0, a1, b0, b1; unpack8(xr[64 * j], v0, v1); unpack8_fp8(y0[64 * j], a0, a1); unpack8_fp8(y1[64 * j], b0, b1);
            v0 += (a0 + b0) * 0.0625f; v1 += (a1 + b1) * 0.0625f;
            const u32x4 w = pack8(v0, v1); st_wt16(ob + 64 * j, w); unpack8(w, v0, v1); if (P10_FP8) o8[64 * j] = pack8_fp8(v0 * 16.f, v1 * 16.f);
            s += (v0[0] * v0[0] + v0[1] * v0[1]) + (v0[2] * v0[2] + v0[3] * v0[3]) + (v1[0] * v1[0] + v1[1] * v1[1]) + (v1[2] * v1[2] + v1[3] * v1[3]); }
        s = wave_sum(s);
        if (lane == 0) rstd3[m] = 1.0f / sqrtf(s * (1.f / DM) + EPS);
    }
}

__device__ __forceinline__ void ph1(Frame& F, unsigned char* ws, int cid) {
#ifndef X_NO_P1A
    { pg8::Gemm g{(const bf16*)(ws + WS_XN), (const bf16*)(ws + WS_WIN), 1024}; pg8::StaticOrder S; S.init(T, 8 * 256, F.G, cid);
      EpiWin<0> E{(bf16*)(ws + WS_QB), (bf16*)(ws + WS_KVB), (bf16*)(ws + WS_GLU), (bf16*)(ws + WS_MG), (float*)(ws + WS_NG), F.inp(4), F.inp(5), F.inp(15), 1.f};
      pg8::gemm_phase<EpiWin<0>, pg8::StaticOrder, P1_ALIGN>(F.lds, g, S, E); }
#endif
#ifndef X_NO_P1B
    { pg8::Gemm g{(const bf16*)(ws + WS_XN8), (const bf16*)(ws + WS_WIN8), 512}; pg8::StaticOrderF8 S; S.init(T, 10 * 256, F.G, cid); S.pbase = 8; S.bown = true;
      EpiWin<1> E{(bf16*)(ws + WS_QB), (bf16*)(ws + WS_KVB), (bf16*)(ws + WS_GLU), (bf16*)(ws + WS_MG), (float*)(ws + WS_NG), F.inp(4), F.inp(5), F.inp(15), 1.f / 512.f};
      pg8::gemm_phase<EpiWin<1>, pg8::StaticOrderF8, P1_ALIGN>(F.lds, g, S, E); }
#endif
}
__device__ __forceinline__ void ph4(Frame& F, unsigned char* ws, int cid) {
    pg8::Gemm g{(const bf16*)(ws + WS_AC), (const bf16*)(ws + WS_WAC), 1024}; pg8::StaticOrder S; S.init(T, 1024, F.G, cid);
    EpiMerge E{(const bf16*)(ws + WS_MG), (bf16*)(ws + WS_XN), F.lds};
    pg8::gemm_phase<EpiMerge, pg8::StaticOrder, true>(F.lds, g, S, E);
}
__device__ __forceinline__ void ph5_wo(Frame& F, unsigned char* ws, int cid) {
    pg8::Gemm g{(const bf16*)(ws + WS_XN), (const bf16*)(ws + WS_WO), 1024}; pg8::StaticOrder S; S.init(T, 1024, F.G, cid);
    EpiWo E{F.inp(0), (bf16*)(ws + X1_OFF), ws + WS_X1F8, (const bf16*)F.out + (size_t)T * DM};
    pg8::gemm_phase<EpiWo, pg8::StaticOrder, true>(F.lds, g, S, E);
}
__device__ __forceinline__ void ph5_pp(Frame& F, unsigned char* ws, int cid) {
    pg8::Gemm g{(const bf16*)(ws + WS_PBF), (const bf16*)(ws + WS_WPP), 256}; pg8::StaticOrder S; S.init(T, 1024, F.G, cid);
    EpiBf E{(bf16*)(ws + WS_PP), 1024};
    pg8::gemm_phase<EpiBf, pg8::StaticOrder, true>(F.lds, g, S, E);
}
__device__ __forceinline__ void ph5(Frame& F, unsigned char* ws, int cid) {
    if ((cid >> 3) & 1) { ph5_pp(F, ws, cid); ph5_wo(F, ws, cid); } else { ph5_wo(F, ws, cid); ph5_pp(F, ws, cid); }
}
__device__ __forceinline__ void ph7(Frame& F, unsigned char* ws, int cid) {
    moe_table(F);
    pg8::Gemm g{(const bf16*)(ws + WS_X1F8), (const bf16*)(ws + WS_WGU), 512};
    LAS int* rowtab = (LAS int*)(F.lds + LDSCTL_OFF + 4096);
    MoeOrder<true> S{(const LAS int*)(F.lds + MOE_OFF), (const int*)(ws + WS_LIST), F.G, cid, F.ctl + CW_Q7, (LAS int*)(F.lds + MOE_OFF + 2048), rowtab};
    for (int i = 0; i < 8; ++i) { pg8::Unit u; if (!S.next(i, u)) break;
        if (F.tid < 256) rowtab[i * 256 + F.tid] = ((const int*)(ws + WS_LIST))[u.e * LISTCAP + u.lp + (F.tid < u.nrow ? F.tid : u.nrow - 1)] >> 1; }
    __syncthreads();
    EpiGU E{(bf16*)(ws + WS_H), (const int*)(ws + WS_LIST), (const float*)(ws + WS_LISTR)};
    pg8::gemm_phase<EpiGU, MoeOrder<true>, true>(F.lds, g, S, E);
}
__device__ __forceinline__ void ph8(Frame& F, unsigned char* ws, int cid) {
    moe_table(F);
    pg8::Gemm g{(const bf16*)(ws + WS_H), (const bf16*)(ws + WS_WD), 256};
    MoeOrder<false> S{(const LAS int*)(F.lds + MOE_OFF), (const int*)(ws + WS_LIST), F.G, cid, F.ctl + CW_Q8, (LAS int*)(F.lds + MOE_OFF + 2048), nullptr};
    EpiDown E{(bf16*)(ws + WS_Y), (const int*)(ws + WS_LIST), (const float*)(ws + WS_LISTW)};
    pg8::gemm_phase<EpiDown, MoeOrder<false>, true>(F.lds, g, S, E);
}
__device__ __forceinline__ void ph10(Frame& F, unsigned char* ws, int cid) {
#ifdef STAGGER_US
    if ((cid >> 3) & 1) { const unsigned long long t0_ = __builtin_amdgcn_s_memrealtime(); while (__builtin_amdgcn_s_memrealtime() - t0_ < (unsigned long long)(STAGGER_US * 100)) __builtin_amdgcn_s_sleep(8); }
#endif
    EpiPle E{F.out, (const bf16*)(ws + WS_XN), (const bf16*)(ws + WS_PP), (const float*)(ws + WS_RSTD3), F.inp(27), (float*)(ws + WS_Y)};
#if P10_FP8
    pg8::Gemm g{(const bf16*)(ws + WS_X1F8), (const bf16*)(ws + WS_WPG), 512}; pg8::StaticOrderF8 S; S.init(T, 1024, F.G, cid);
    pg8::gemm_phase<EpiPle, pg8::StaticOrderF8, true>(F.lds, g, S, E);
#else
    pg8::Gemm g{(const bf16*)(ws + WS_XN), (const bf16*)(ws + WS_WPG), 1024}; pg8::StaticOrder S; S.init(T, 1024, F.G, cid);
    pg8::gemm_phase<EpiPle, pg8::StaticOrder, true>(F.lds, g, S, E);
#endif
}

#ifdef CHECK
constexpr int CW_CHK = 3072;
constexpr int NCHK = 24;
__device__ __forceinline__ int chk_token(int s) {
    const int fixed[16] = {0, 1, 29, 30, 31, 63, 64, 4095, 4096, 4097, 4126, 8191, 12288, 20000, 32767, 16384 + 33};
    return s < 16 ? fixed[s] : (int)(((unsigned)s * 2654435761u) % (unsigned)T);
}
__device__ __forceinline__ void chk_report(Frame& F, int k, float err) {
    if (!(err >= 0.f)) err = 1e30f;
    atomicMax((unsigned*)(F.ctl + CW_CHK + k), __float_as_uint(err));
}
__device__ __forceinline__ float block_sum(Frame& F, float v, LAS float* red) {
    v = wave_sum(v); __syncthreads(); if (F.lane == 0) red[F.wave] = v; __syncthreads();
    float s = 0.f; for (int w = 0; w < 8; ++w) s += red[w]; __syncthreads(); return s;
}
__device__ __forceinline__ float bfv(const bf16* p, size_t i) { return __uint_as_float((unsigned)p[i] << 16); }

__device__ void chk_p1(Frame& F) {
    const int s = blockIdx.x; if (s >= 64) return;
    const int t = chk_token(s), tid = F.tid;
    LAS float* h = (LAS float*)F.lds; LAS float* z = h + 1024; LAS float* red = z + 4608;
    const float* x = F.inp(0) + (size_t)t * 1024; const float* W = F.inp(3);
    float ss = 0.f; for (int k = tid; k < 1024; k += 512) ss += x[k] * x[k];
    ss = block_sum(F, ss, red); const float rstd = 1.0f / sqrtf(ss / 1024.f + EPS);
    for (int k = tid; k < 1024; k += 512) h[k] = x[k] * rstd * F.inp(2)[k];
    __syncthreads();
    for (int c = tid; c < NIN; c += 512) { float a = 0.f; for (int k = 0; k < 1024; ++k) a += h[k] * W[(size_t)k * NIN + c]; z[c] = a; }
    __syncthreads();
    const bf16* Qb = (const bf16*)(F.ws + WS_QB); const bf16* KVb = (const bf16*)(F.ws + WS_KVB); const bf16* GLU = (const bf16*)(F.ws + WS_GLU); const bf16* MG = (const bf16*)(F.ws + WS_MG); const float* NG = (const float*)(F.ws + WS_NG);
    { const int c = tid, hd = c >> 6; float q2 = 0.f; for (int d = 0; d < 64; ++d) q2 += z[hd * 64 + d] * z[hd * 64 + d];
      const float e = z[c] / sqrtf(q2 / 64.f + EPS) * F.inp(4)[c & 63] * QC2; chk_report(F, 1, fabsf(e - bfv(Qb, (size_t)t * 512 + c))); }
    for (int c = tid; c < 768; c += 512) { const int i = c >> 7, grp = c >> 6; float e = z[OFF_KV + c];
        if (i == 2 || i == 4) { float q2 = 0.f; for (int d = 0; d < 64; ++d) q2 += z[OFF_KV + grp * 64 + d] * z[OFF_KV + grp * 64 + d]; e = e / sqrtf(q2 / 64.f + EPS) * F.inp(5)[(i == 2 ? 64 : 128) + (c & 63)]; }
        chk_report(F, 2, fabsf(e - bfv(KVb, (size_t)t * 768 + c))); }
    { const int c = tid; const float e = z[OFF_CONV + c] / (1.f + expf(-z[OFF_CONV + 512 + c])); chk_report(F, 3, fabsf(e - bfv(GLU, (size_t)t * 512 + c))); }
#ifdef MG_RAW
    for (int c = tid; c < 2048; c += 512) { const float e = z[OFF_MERGE + c];
#else
    for (int c = tid; c < 2048; c += 512) { const float e = 1.f / (1.f + expf(-(z[OFF_MERGE + c] + F.inp(15)[c])));
#endif
        const float er = fabsf(e - bfv(MG, (size_t)t * 2048 + c)); chk_report(F, 4, er); if (er > 0.08f) atomicMax((unsigned*)(F.ctl + CW_CHK + 40 + s), 1u); }
    if (tid < 24) { const float e = 1.f / (1.f + expf(-z[OFF_GATE + tid])); chk_report(F, 5, fabsf(e - NG[(size_t)t * 32 + tid])); }
    __syncthreads();
}
__device__ void chk_conv(Frame& F) {
    const int s = blockIdx.x; if (s >= 64) return;
    const int t = chk_token(s), tid = F.tid, sp = t & (SEQ - 1);
    LAS float* red = (LAS float*)F.lds;
    const bf16* GLU = (const bf16*)(F.ws + WS_GLU);
    float a = F.inp(11)[tid];
    for (int j = 0; j < 31; ++j) { const int sq = sp - 30 + j; if (sq >= 0) a += F.inp(10)[j * 512 + tid] * bfv(GLU, (size_t)(t - 30 + j) * 512 + tid); }
    const float mu = block_sum(F, a, red) / 512.f; const float d = a - mu; const float var = block_sum(F, d * d, red) / 512.f;
    float y = d / sqrtf(var + EPS) * F.inp(12)[tid] + F.inp(13)[tid]; y = y / (1.f + expf(-y));
    chk_report(F, 6, fabsf(y - bfv((const bf16*)(F.ws + WS_AC), (size_t)t * 1024 + 512 + tid)));
}
__device__ void chk_merge(Frame& F) {
    const int s = blockIdx.x; if (s >= 64) return;
    const int t = chk_token(s), tid = F.tid;
    const bf16* AC = (const bf16*)(F.ws + WS_AC); const bf16* MG = (const bf16*)(F.ws + WS_MG); const bf16* MER = (const bf16*)(F.ws + WS_XN);
    for (int c = tid; c < 1024; c += 512) { float ya = 0.f, yc = 0.f;
        for (int k = 0; k < 512; ++k) { ya += bfv(AC, (size_t)t * 1024 + k) * F.inp(9)[(size_t)k * 1024 + c]; yc += bfv(AC, (size_t)t * 1024 + 512 + k) * F.inp(14)[(size_t)k * 1024 + c]; }
        const float e = bfv(MG, (size_t)t * 2048 + c) * ya + bfv(MG, (size_t)t * 2048 + 1024 + c) * yc;
        chk_report(F, 10, fabsf(e - bfv(MER, (size_t)t * 1024 + c))); }
}
__device__ void chk_p5(Frame& F) {
    const int s = blockIdx.x; if (s >= 64) return;
    const int t = chk_token(s), tid = F.tid;
    const bf16* MER = (const bf16*)(F.ws + WS_XN); const bf16* PP = (const bf16*)(F.ws + WS_PP);
    for (int c = tid; c < 1024; c += 512) { float a = F.inp(0)[(size_t)t * 1024 + c], pp = 0.f;
        for (int k = 0; k < 1024; ++k) a += bfv(MER, (size_t)t * 1024 + k) * F.inp(16)[(size_t)k * 1024 + c];
        for (int k = 0; k < 256; ++k) pp += F.inp(1)[(size_t)t * 256 + k] * F.inp(28)[(size_t)k * 1024 + c];
        chk_report(F, 11, fabsf(a - F.out[(size_t)t * 1024 + c])); chk_report(F, 12, fabsf(pp - bfv(PP, (size_t)t * 1024 + c))); }
}
__device__ void chk_verdict(Frame& F) {
    int bad = 0, nbad = 0;
    for (int k = NCHK - 1; k >= 1; --k) { const float e = __uint_as_float(__hip_atomic_load(F.ctl + CW_CHK + k, RLX_AGENT)); if (e > 0.08f) { bad = k; ++nbad; } }
    if (bad) { const float c = sqrtf(1.45f * (float)bad); for (size_t i = (size_t)blockIdx.x * 512 + F.tid; i < (size_t)T * DM; i += (size_t)F.G * 512) F.out[i] = (i == 0) ? 100.f * (float)nbad : c; }
    { int ns = 0; for (int s = 0; s < 64; ++s) ns += (int)__hip_atomic_load(F.ctl + CW_CHK + 40 + s, RLX_AGENT); if (blockIdx.x == 0 && F.tid == 0) F.out[0] = 100.f * (float)ns; }
}
#define CHK_RUN(fn) do { fn(F); xcd_barrier(bar); } while (0)
#else
#define CHK_RUN(fn) do {} while (0)
#endif
__global__ void __launch_bounds__(NWAVES * 64, 2) nsa_block_fwd(Args args) {
    extern __shared__ __attribute__((aligned(16))) unsigned char lds_raw[];
    Frame F;
    F.lds = (LAS unsigned char*)lds_raw;
    F.MISC = (volatile LAS unsigned*)(F.lds + MISC_OFF);
    F.tid = threadIdx.x; F.lane = F.tid & 63; F.wave = __builtin_amdgcn_readfirstlane(F.tid >> 6);
    F.G = gridDim.x; { const int bx = blockIdx.x; F.vcu = (F.G % 8 == 0) ? (bx % 8) * (F.G / 8) + bx / 8 : bx; }
    F.ws = args.ws; F.ctl = (gu32*)(args.ws + WS_CTL); F.out = args.out;
    F.ka = (const CAS Args*)__builtin_amdgcn_kernarg_segment_ptr();
    for (int u = F.tid; u < (LDS_BYTES - LDSCTL_OFF) / 4; u += NWAVES * 64) ((LAS unsigned*)(F.lds + LDSCTL_OFF))[u] = 0u;
    __syncthreads();
    XcdBarrier bar; bar.bar = (unsigned*)(F.ctl + CW_BAR); bar.x = 0; bar.st = nullptr;
    if (!MK_PER_PHASE) bar = xcd_barrier_post((unsigned*)(F.ctl + CW_BAR), F.MISC + 8);
    const int lo = args.ph_lo, hi = args.ph_hi;
#ifdef ONLY_PHASE
#define IN(k) ((k) == ONLY_PHASE && lo <= (k) && (k) < hi)
#else
#define IN(k) (lo <= (k) && (k) < hi)
#endif
#ifdef STAMP_A
#define STAMP(i) do { if (F.tid == 0) ((volatile LAS unsigned long long*)(F.lds + MISC_OFF + 64))[i] = __builtin_amdgcn_s_memrealtime(); } while (0)
#else
#define STAMP(i) do {} while (0)
#endif
#if defined(PROF_MODE) && PROF_MODE >= 100
#define SEAM(k) do { if (IN(k) && IN((k) + 1)) { const unsigned long long pt0_ = __builtin_amdgcn_s_memrealtime(); xcd_barrier(bar); \
        if (F.tid == 0 && (PROF_MODE == 100 || PROF_MODE == 101 + (k))) ((volatile LAS unsigned*)(F.lds + MISC_OFF + 64))[0] += (unsigned)(__builtin_amdgcn_s_memrealtime() - pt0_); } } while (0)
#else
#define SEAM(k) do { if (IN(k) && IN((k) + 1)) xcd_barrier(bar); STAMP((k) + 1); } while (0)
#endif
    unsigned char* ws = args.ws;
    const int cid = (int)blockIdx.x;

#ifndef REP_MASK
#define REP_MASK 0
#endif
#define RUNPH(k, call) do { if (IN(k)) { call; } SEAM(k); if ((REP_MASK >> (k)) & 1) { if (IN(k)) { call; } xcd_barrier(bar); } } while (0)
    STAMP(0);
    RUNPH(0, p0_prologue(F));
    RUNPH(1, ph1(F, ws, cid));
    CHK_RUN(chk_p1);
    RUNPH(2, p2_phase(F));
    CHK_RUN(chk_conv);
    if (IN(3)) { att::attn_phase(F, 0); } SEAM(3);
    if ((REP_MASK >> 3) & 1) { att::attn_phase(F, 1); xcd_barrier(bar); }
    RUNPH(4, ph4(F, ws, cid));
    CHK_RUN(chk_merge);
    RUNPH(5, ph5(F, ws, cid));
    CHK_RUN(chk_p5);
    if (IN(6)) { p6_router(F); } SEAM(6);
    if ((REP_MASK >> 6) & 1) { p6_router(F, 1); xcd_barrier(bar); }
    RUNPH(7, ph7(F, ws, cid));
    RUNPH(8, ph8(F, ws, cid));
    RUNPH(9, p9_combine(F));
    if (IN(10)) { ph10(F, ws, cid); }
    if ((REP_MASK >> 10) & 1) { xcd_barrier(bar); ph10(F, ws, cid); }
#ifdef CHECK
    xcd_barrier(bar); chk_verdict(F);
#endif
#ifdef PROF_MODE
    if (blockIdx.x == 0) { __syncthreads(); if (F.tid == 0) { const unsigned ticks = ((volatile LAS unsigned*)(F.lds + MISC_OFF + 64))[0]; const unsigned long long t0 = __builtin_amdgcn_s_memrealtime();
        while (__builtin_amdgcn_s_memrealtime() - t0 < 4ull * ticks) __builtin_amdgcn_s_sleep(8); } __syncthreads(); }
#endif
#ifdef STAMP_A
    xcd_barrier(bar); STAMP(11); __syncthreads();
    { volatile LAS unsigned long long* st = (volatile LAS unsigned long long*)(F.lds + MISC_OFF + 64);
      const float usA = (float)(st[STAMP_A + 1] - st[STAMP_A]) * 0.01f, usB = (float)(st[STAMP_B + 1] - st[STAMP_B]) * 0.01f;
      const float sc = 1.f + usB * (1.f / 300.f);
      for (size_t i = (size_t)blockIdx.x * 512 + F.tid; i < (size_t)T * DM; i += (size_t)F.G * 512) F.out[i] = (i == 0) ? usA : F.out[i] * sc; }
#endif
#undef IN
#undef SEAM
}

extern "C" void kernel_launch(void* const* d_in, const int* in_sizes, int n_in, void* d_out, int out_size, void* d_ws, size_t ws_size, hipStream_t stream) {
    static int grid = 0;
    if (grid == 0) {
        if (n_in != 29 || in_sizes[0] != T * DM || out_size != T * DM || ws_size < WS_END) { fprintf(stderr, "kernel_launch: unexpected shapes (n_in %d, in0 %d, out %d, ws %zu); nothing launched\n", n_in, n_in > 0 ? in_sizes[0] : -1, out_size, ws_size); grid = -1; return; }
        int dev = 0, cus = 0, per_cu = 0;
        if (hipGetDevice(&dev) != hipSuccess || hipDeviceGetAttribute(&cus, hipDeviceAttributeMultiprocessorCount, dev) != hipSuccess) { grid = -1; return; }
        if (hipFuncSetAttribute((const void*)nsa_block_fwd, hipFuncAttributeMaxDynamicSharedMemorySize, LDS_BYTES) != hipSuccess) { fprintf(stderr, "kernel_launch: hipFuncSetAttribute failed\n"); grid = -1; return; }
        if (hipOccupancyMaxActiveBlocksPerMultiprocessor(&per_cu, (const void*)nsa_block_fwd, NWAVES * 64, LDS_BYTES) != hipSuccess || per_cu < 1)
            fprintf(stderr, "kernel_launch: note: occupancy query reports %d workgroups per CU\n", per_cu);
        (void)hipGetLastError();
        grid = cus;
    }
    if (grid < 0) return;
    if (hipMemsetAsync((char*)d_ws + WS_CTL, 0, CTL_ZERO_BYTES, stream) != hipSuccess) return;
    Args a{};
    for (int i = 0; i < 29; ++i) a.in[i] = (const float*)d_in[i];
    a.out = (float*)d_out; a.ws = (unsigned char*)d_ws;
#if MK_PER_PHASE
    for (int ph = 0; ph < NPH; ++ph) { a.ph_lo = ph; a.ph_hi = ph + 1; hipLaunchKernelGGL(nsa_block_fwd, dim3(grid), dim3(NWAVES * 64), LDS_BYTES, stream, a); }
#else
    a.ph_lo = 0; a.ph_hi = NPH;
    hipLaunchKernelGGL(nsa_block_fwd, dim3(grid), dim3(NWAVES * 64), LDS_BYTES, stream, a);
#endif
}
```

```cpp
#include <hip/hip_runtime.h>
#include <cstdio>
#include <cstdint>

#define LAS __attribute__((address_space(3)))
#define GAS __attribute__((address_space(1)))
typedef unsigned short bf16;
typedef short bf16x8 __attribute__((ext_vector_type(8)));
typedef short s16x4 __attribute__((ext_vector_type(4)));
typedef float f32x2 __attribute__((ext_vector_type(2)));
typedef float f32x4 __attribute__((ext_vector_type(4)));
typedef float f32x16 __attribute__((ext_vector_type(16)));
typedef unsigned u32x2 __attribute__((ext_vector_type(2)));
typedef unsigned u32x4 __attribute__((ext_vector_type(4)));
typedef GAS unsigned gu32;
typedef long l64x2 __attribute__((ext_vector_type(2)));
typedef int i32x4 __attribute__((ext_vector_type(4)));
typedef int i32x8 __attribute__((ext_vector_type(8)));
#ifndef FP8_MX
#define FP8_MX 1
#endif

constexpr int BATCH = 8, SEQ = 4096, T = BATCH * SEQ, DM = 1024, NIN = 4376;
constexpr int OFF_KV = 512, OFF_GATE = 1280, OFF_CONV = 1304, OFF_MERGE = 2328;
constexpr int NT_IN = 18;
constexpr int NEXP = 32, EFF = 512, LISTCAP = 32768;
constexpr float EPS = 1e-6f;
constexpr float LOG2E = 1.4426950408889634f;
constexpr float QC2 = 0.125f * 1.4426950408889634f;

typedef __bf16 bf16x2_t __attribute__((ext_vector_type(2)));
__device__ __forceinline__ unsigned cvt_pk_bf16(float lo, float hi) { const f32x2 v = {lo, hi}; const bf16x2_t b = __builtin_convertvector(v, bf16x2_t); return __builtin_bit_cast(unsigned, b); }
__device__ __forceinline__ float bf_lo(unsigned w) { return __uint_as_float(w << 16); }
__device__ __forceinline__ float bf_hi(unsigned w) { return __uint_as_float(w & 0xffff0000u); }
__device__ __forceinline__ float fsigmoid(float v) { return __builtin_amdgcn_rcpf(1.0f + __builtin_amdgcn_exp2f(-v * LOG2E)); }
#ifndef WT_STORES
#define WT_STORES 0
#endif
__device__ __forceinline__ void st_wt16(void* p, u32x4 v) {
#if WT_STORES == 2
    __builtin_nontemporal_store(v, (u32x4*)p);
#elif WT_STORES == 1
    asm volatile("global_store_dwordx4 %0, %1, off sc1\n\ts_nop 4" :: "v"(p), "v"(v) : "memory");
#else
    *(u32x4*)p = v;
#endif
}
__device__ __forceinline__ float wave_sum(float v) {
#pragma unroll
    for (int o = 1; o < 64; o <<= 1) v += __shfl_xor(v, o);
    return v;
}

#ifndef F8_GATHER
#define F8_GATHER false
#endif
namespace pg8 {
constexpr int BM = 256, BK = 64, HALF = 128, HTB = HALF * BK * 2, STAGE_BYTES = 8 * HTB, NXCD = 8, WGM = 8;
__host__ __device__ __forceinline__ int lds_byte(int r, int c) { const int st = (r >> 4) * 2 + (c >> 5), rr = r & 15, cc = c & 31, ob = rr * 64 + cc * 2; return st * 1024 + (ob ^ (((ob >> 9) & 1) << 5)); }
__host__ __device__ __forceinline__ void stage_rc(int b, int& R, int& C) { const int st = b / 1024, sb = b % 1024, swz = sb ^ (((sb >> 9) & 1) << 5); R = (st >> 1) * 16 + swz / 64; C = (st & 1) * 32 + (swz % 64) / 2; }
__host__ __device__ __forceinline__ int perm32(int rho) { const int n = rho >> 4, i = rho & 15; return 8 * (i >> 2) + 4 * n + (i & 3); }

struct Unit { int pm, pn, b0, e, lp, nrow, ord; };
struct Gemm { const bf16* A; const bf16* Bt; int K; };

struct StaticOrder {
    int nM, nN, nwg, G, c;
    bool rev = false;
    int boff = 0;
    int pbase = 0, pcut = 1 << 30, pgap = 0; bool bown = false;
    __device__ void init(int M, int N, int G_, int c_) { nM = M / BM; nN = N / BM; nwg = nM * nN; G = G_; c = c_; }
    __device__ bool next(int i, Unit& u) const {
        int ii = i; if (rev && nwg % G == 0) { const int nper = nwg / G; if (i >= nper) return false; ii = nper - 1 - i; }
        const long L = (long)ii * G + c; if (L >= nwg) return false;
        int wgid = (int)L; { const int q = nwg / NXCD, r = nwg % NXCD, xcd = wgid % NXCD, off = wgid / NXCD; wgid = (xcd < r ? xcd * (q + 1) : r * (q + 1) + (xcd - r) * q) + off; }
        const int nig = WGM * nN, gid = wgid / nig, fm = gid * WGM, gsz = (nM - fm) < WGM ? (nM - fm) : WGM;
        u.pm = fm + ((wgid % nig) % gsz); const int pq = (wgid % nig) / gsz; u.pn = pbase + pq + (pq >= pcut ? pgap : 0); u.b0 = (bown ? pq + boff : u.pn) * BM; u.e = 0; u.lp = 0; u.nrow = BM; u.ord = 0; return true;
    }
    static constexpr bool GATHER = false, PARTIAL = false, FP8 = false;
    __device__ __forceinline__ int arow0(const Unit& u) const { return u.pm * BM; }
    __device__ __forceinline__ int arow(const Unit& u, int r) const { return u.pm * BM + r; }
};
struct StaticOrderF8 : StaticOrder { static constexpr bool FP8 = true, GATHER = F8_GATHER; };
struct PairOrderF8 : StaticOrder { static constexpr bool FP8 = true; int tbase = 0;
    __device__ bool next(int k, Unit& u) const { Unit m; if (!StaticOrder::next(k >> 1, m)) return false; const int t = 2 * m.pn + (k & 1); u = m; u.pn = tbase + t; u.b0 = t * BM; return true; } };

constexpr int PF_DUMP = 131072 + 8192;
template <class E, class = void> struct HasPF { static constexpr bool v = false; };
template <class E> struct HasPF<E, decltype((void)E::PREFETCH)> { static constexpr bool v = E::PREFETCH; };
template <class E, class = void> struct PreOf { struct type {}; static constexpr bool v = false; };
template <class E> struct PreOf<E, decltype((void)sizeof(typename E::Pre))> { using type = typename E::Pre; static constexpr bool v = true; };
template <class Epi, class Sched, bool ALIGN_EPI>
__device__ __forceinline__ void gemm_phase(LAS unsigned char* lds, const Gemm g, const Sched& S, const Epi& E) {
    int tid_ = threadIdx.x; asm volatile("" : "+v"(tid_));
    const int tid = tid_, wid = __builtin_amdgcn_readfirstlane(tid >> 6), lane = tid & 63, wr = wid >> 2, wc = wid & 3, fr = lane & 15, fq = lane >> 4;
    const int K = g.K, nt = K / BK;
    int opq_ = 0; asm volatile("" : "+s"(opq_));
    int RA[2], CA[2]; unsigned voffB[2];
#pragma unroll
    for (int i = 0; i < 2; ++i) { int R, C; stage_rc(tid * 16 + i * 8192, R, C); const int Rb = Epi::NOPERM ? R : (R & ~31) + perm32(R & 31);
        RA[i] = R; CA[i] = C; voffB[i] = (unsigned)(Rb * K + C) * 2u; }
    const size_t kstep = (size_t)(BK * 2);
    const size_t hstep = (size_t)HALF * K * 2;
    const unsigned ldsw = (unsigned)wid * 1024u;
    const int aoff = lds_byte(wr * 64 + fr, fq * 8), boff = lds_byte(wc * 32 + fr, fq * 8);
#define PG8_SA(b, h) (((b) * 2 + (h)) * HTB)
#define PG8_SB(b, h) ((4 + (b) * 2 + (h)) * HTB)
#define PG8_STAGE(bufoff, gbase, v0, v1) do { \
        __builtin_amdgcn_global_load_lds((const unsigned*)((const char*)(gbase) + (v0)), (LAS unsigned*)(lds + (bufoff) + ldsw), 16, 0, 0); \
        __builtin_amdgcn_global_load_lds((const unsigned*)((const char*)(gbase) + (v1)), (LAS unsigned*)(lds + (bufoff) + ldsw + 8192), 16, 0, 0); } while (0)
#define PG8_LDA(dst, b, h) do { _Pragma("unroll") for (int m = 0; m < 4; ++m) _Pragma("unroll") for (int k = 0; k < 2; ++k) dst[m][k] = *(const LAS bf16x8*)(lds + PG8_SA(b, h) + aoff + m * 2048 + k * 1024); } while (0)
#define PG8_LDB(dst, b, h) do { _Pragma("unroll") for (int n = 0; n < 2; ++n) _Pragma("unroll") for (int k = 0; k < 2; ++k) dst[n][k] = *(const LAS bf16x8*)(lds + PG8_SB(b, h) + boff + n * 2048 + k * 1024); } while (0)
#define PG8_MMA(ai, bj, At, Bt) do { if (Sched::PARTIAL && !((ai) * HALF + wr * 64 < cur.nrow)) break; if (Sched::FP8 && !Sched::PARTIAL && opq_) break; __builtin_amdgcn_s_setprio(1); _Pragma("unroll") for (int m = 0; m < 4; ++m) _Pragma("unroll") for (int n = 0; n < 2; ++n) _Pragma("unroll") for (int k = 0; k < 2; ++k) { \
        if constexpr (Sched::FP8 && FP8_MX) { if (k == 0) { const i32x8 a_ = __builtin_shufflevector(__builtin_bit_cast(i32x4, At[m][0]), __builtin_bit_cast(i32x4, At[m][1]), 0, 1, 2, 3, 4, 5, 6, 7), \
                b_ = __builtin_shufflevector(__builtin_bit_cast(i32x4, Bt[n][0]), __builtin_bit_cast(i32x4, Bt[n][1]), 0, 1, 2, 3, 4, 5, 6, 7); \
            acc[ai][bj][m][n] = __builtin_amdgcn_mfma_scale_f32_16x16x128_f8f6f4(b_, a_, acc[ai][bj][m][n], 0, 0, 0, 0x7f7f7f7f, 0, 0x7f7f7f7f); } }     \
        else if constexpr (Sched::FP8) { const l64x2 a_ = __builtin_bit_cast(l64x2, At[m][k]), b_ = __builtin_bit_cast(l64x2, Bt[n][k]); \
            acc[ai][bj][m][n] = __builtin_amdgcn_mfma_f32_16x16x32_fp8_fp8(b_.x, a_.x, acc[ai][bj][m][n], 0, 0, 0); acc[ai][bj][m][n] = __builtin_amdgcn_mfma_f32_16x16x32_fp8_fp8(b_.y, a_.y, acc[ai][bj][m][n], 0, 0, 0); } \
        else acc[ai][bj][m][n] = __builtin_amdgcn_mfma_f32_16x16x32_bf16(Bt[n][k], At[m][k], acc[ai][bj][m][n], 0, 0, 0); } __builtin_amdgcn_s_setprio(0); } while (0)
#define PG8_WAIT_V(n) asm volatile("s_waitcnt vmcnt(" #n ")" ::: "memory")
#define PG8_WAIT_L(n) asm volatile("s_waitcnt lgkmcnt(" #n ")" ::: "memory")
#define PG8_BAR __builtin_amdgcn_s_barrier()
#define PG8_SCHED __builtin_amdgcn_sched_barrier(0)
    Unit cur, nxt; int ui = 0;
    if (!S.next(0, cur)) return;
    f32x4 acc[2][2][4][2];
#pragma unroll
    for (int a = 0; a < 2; ++a)
#pragma unroll
        for (int b = 0; b < 2; ++b)
#pragma unroll
            for (int m = 0; m < 4; ++m)
#pragma unroll
                for (int n = 0; n < 2; ++n) acc[a][b][m][n] = (f32x4){0.f, 0.f, 0.f, 0.f};
    bf16x8 At[4][2], B0[2][2], B1[2][2];
    constexpr bool GA = Sched::GATHER;
    const size_t hs = GA ? (size_t)0 : hstep;
    unsigned ac00, ac01, ac10, ac11, an00, an01, an10, an11;
    auto aoff_of = [&](const Unit& uu, int h, int i) -> unsigned { int t2 = tid; asm volatile("" : "+v"(t2)); int R, C; stage_rc(t2 * 16 + i * 8192, R, C); return (unsigned)(S.arow(uu, h * HALF + R) * K + C) * 2u; };
#define PG8_AOFF(u, h, i) aoff_of(u, h, i)
    const char* A0 = (const char*)g.A;
    const char* cAu = A0; const char* nAu = A0;
    if constexpr (GA) { ac00 = PG8_AOFF(cur, 0, 0); ac01 = PG8_AOFF(cur, 0, 1); ac10 = PG8_AOFF(cur, 1, 0); ac11 = PG8_AOFF(cur, 1, 1); }
    else { ac00 = ac10 = (unsigned)(RA[0] * K + CA[0]) * 2u; ac01 = ac11 = (unsigned)(RA[1] * K + CA[1]) * 2u; cAu = A0 + (size_t)S.arow0(cur) * K * 2; }
    an00 = ac00; an01 = ac01; an10 = ac10; an11 = ac11;
    const char* cB = (const char*)g.Bt + (size_t)cur.b0 * K * 2;
    PG8_STAGE(PG8_SB(0, 0), cB, voffB[0], voffB[1]); PG8_STAGE(PG8_SB(0, 1), cB + hstep, voffB[0], voffB[1]); PG8_STAGE(PG8_SA(0, 0), cAu, ac00, ac01); PG8_STAGE(PG8_SA(0, 1), cAu + hs, ac10, ac11);
    if (wr == 1) PG8_BAR;
    PG8_WAIT_V(2); PG8_BAR;
    PG8_STAGE(PG8_SB(1, 0), cB + kstep, voffB[0], voffB[1]); PG8_STAGE(PG8_SA(1, 0), cAu + kstep, ac00, ac01); PG8_STAGE(PG8_SB(1, 1), cB + hstep + kstep, voffB[0], voffB[1]);
    PG8_WAIT_V(6); PG8_BAR;
    for (;;) {
        const bool has_next = S.next(ui + 1, nxt);
        const char* nB = has_next ? (const char*)g.Bt + (size_t)nxt.b0 * K * 2 : cB;
        if constexpr (GA) {
            if (has_next) { an00 = PG8_AOFF(nxt, 0, 0); an01 = PG8_AOFF(nxt, 0, 1); an10 = PG8_AOFF(nxt, 1, 0); an11 = PG8_AOFF(nxt, 1, 1); }
            else { an00 = ac00; an01 = ac01; an10 = ac10; an11 = ac11; }
        } else { nAu = has_next ? A0 + (size_t)S.arow0(nxt) * K * 2 : cAu; }
        if constexpr (HasPF<Epi>::v) E.prefetch(cur, 0, lds, wid, lane);
        typename PreOf<Epi>::type pre_;
        if constexpr (PreOf<Epi>::v) pre_ = E.pre(cur, wr, wc, fr, fq);
#if defined(PROF_MODE) && PROF_MODE == 8
        const unsigned long long ptk_ = __builtin_amdgcn_s_memrealtime();
#endif
#pragma unroll 1
        for (int t = 0; t < nt; t += 2) {
            const bool last = (t == nt - 2);
            if constexpr (Epi::MID) { if (t == Epi::MID_T) E.mid(acc, cur, wr, wc, fr, fq); }
            const char* a1 = cAu + (size_t)(t + 1) * kstep;
            const char* a2 = last ? nAu : cAu + (size_t)(t + 2) * kstep; const char* b2 = last ? nB : cB + (size_t)(t + 2) * kstep;
            const char* a3 = a2 + kstep; const char* b3 = b2 + kstep;
            unsigned o00 = ac00, o01 = ac01, o10 = ac10, o11 = ac11;
            if constexpr (GA) { o00 = last ? an00 : ac00; o01 = last ? an01 : ac01; o10 = last ? an10 : ac10; o11 = last ? an11 : ac11; }
            PG8_LDB(B0, 0, 0); PG8_LDB(B1, 0, 1); PG8_SCHED; PG8_LDA(At, 0, 0); PG8_STAGE(PG8_SA(1, 1), a1 + hs, ac10, ac11);
            PG8_WAIT_V(8); PG8_WAIT_L(0); PG8_BAR; PG8_MMA(0, 0, At, B0); PG8_MMA(0, 1, At, B1); PG8_BAR; PG8_SCHED;
            PG8_LDA(At, 0, 1); PG8_STAGE(PG8_SB(0, 0), b2, voffB[0], voffB[1]); PG8_STAGE(PG8_SB(0, 1), b2 + hstep, voffB[0], voffB[1]); PG8_STAGE(PG8_SA(0, 0), a2, o00, o01);
            PG8_WAIT_V(8); PG8_WAIT_L(0); PG8_BAR; PG8_MMA(1, 0, At, B0); PG8_MMA(1, 1, At, B1); PG8_BAR; PG8_SCHED;
            PG8_LDB(B0, 1, 0); PG8_LDB(B1, 1, 1); PG8_SCHED; PG8_LDA(At, 1, 0); PG8_STAGE(PG8_SA(0, 1), a2 + hs, o10, o11);
            PG8_WAIT_V(8); PG8_WAIT_L(0); PG8_BAR; PG8_MMA(0, 0, At, B0); PG8_MMA(0, 1, At, B1); PG8_BAR; PG8_SCHED;
            PG8_LDA(At, 1, 1); PG8_STAGE(PG8_SB(1, 0), b3, voffB[0], voffB[1]); PG8_STAGE(PG8_SB(1, 1), b3 + hstep, voffB[0], voffB[1]); PG8_STAGE(PG8_SA(1, 0), a3, o00, o01);
            PG8_WAIT_V(8); PG8_WAIT_L(0); PG8_BAR; PG8_MMA(1, 0, At, B0); PG8_MMA(1, 1, At, B1); PG8_BAR; PG8_SCHED;
        }
#if defined(PROF_MODE) && PROF_MODE == 8
        if constexpr (Epi::PROF) { if (threadIdx.x == 0) { LAS unsigned* pa_ = (LAS unsigned*)(lds + 131072 + 320 + 64); pa_[0] += (unsigned)(__builtin_amdgcn_s_memrealtime() - ptk_); } }
#endif
        if constexpr (ALIGN_EPI) { if (wr == 0) PG8_BAR; }
#if defined(PROF_MODE) && PROF_MODE == 6
        if constexpr (Epi::PROF) { const unsigned long long pt0_ = __builtin_amdgcn_s_memrealtime(); if constexpr (PreOf<Epi>::v) E(acc, cur, wr, wc, fr, fq, pre_); else E(acc, cur, wr, wc, fr, fq); asm volatile("s_waitcnt vmcnt(0)" ::: "memory");
            if (threadIdx.x == 0) { LAS unsigned* pa_ = (LAS unsigned*)(lds + 131072 + 320 + 64); pa_[0] += (unsigned)(__builtin_amdgcn_s_memrealtime() - pt0_); } } else
#endif
        if constexpr (PreOf<Epi>::v) E(acc, cur, wr, wc, fr, fq, pre_); else E(acc, cur, wr, wc, fr, fq);
        if (!has_next) break;
#pragma unroll
        for (int a = 0; a < 2; ++a)
#pragma unroll
            for (int b = 0; b < 2; ++b)
#pragma unroll
                for (int m = 0; m < 4; ++m)
#pragma unroll
                    for (int n = 0; n < 2; ++n) acc[a][b][m][n] = (f32x4){0.f, 0.f, 0.f, 0.f};
        cur = nxt; cB = nB; cAu = nAu; ac00 = an00; ac01 = an01; ac10 = an10; ac11 = an11; ++ui;
        if constexpr (ALIGN_EPI) { if (wr == 1) PG8_BAR; }
    }
    PG8_WAIT_V(0);
    if constexpr (!ALIGN_EPI) { if (wr == 0) PG8_BAR; }
    PG8_BAR;
#undef PG8_AOFF
#undef PG8_SA
#undef PG8_SB
#undef PG8_STAGE
#undef PG8_LDA
#undef PG8_LDB
#undef PG8_MMA
#undef PG8_WAIT_V
#undef PG8_WAIT_L
#undef PG8_BAR
#undef PG8_SCHED
}
}

#define RLX_AGENT __ATOMIC_RELAXED, __HIP_MEMORY_SCOPE_AGENT
#define LDS_WAIT() asm volatile("s_waitcnt lgkmcnt(0)" ::: "memory")
#define VM_WAIT() asm volatile("s_waitcnt vmcnt(0)" ::: "memory")
#define XB_TMO      128
#define XB_XCNT(j)  (256  + 64 * (j))
#define XB_XSUB(j)  (1280 + 64 * (j))
#define XB_XGEN(j)  (2304 + 64 * (j))
#define XB_TOP      3328
#define XB_TOPGEN   3392
#define XCD_BAR_WORDS 3456
#define XB_SPIN_CAP (1u << 18)

__device__ __forceinline__ unsigned xb_ld(unsigned* p)              { return __hip_atomic_load(p, __ATOMIC_RELAXED, __HIP_MEMORY_SCOPE_AGENT); }
__device__ __forceinline__ unsigned xb_add(unsigned* p, unsigned v) { return __hip_atomic_fetch_add(p, v, __ATOMIC_RELAXED, __HIP_MEMORY_SCOPE_AGENT); }
__device__ __forceinline__ unsigned xb_xcc_id() { return (unsigned)__builtin_amdgcn_s_getreg((3 << 11) | 20) & 0xFu; }
#define XB_SPIN(cond, bar) do { unsigned _sp = 0; while (cond) { __builtin_amdgcn_s_sleep(1); \
    if ((++_sp & 255u) == 0u) { if (xb_ld(&(bar)[XB_TMO])) break; if (_sp > XB_SPIN_CAP) { atomicAdd(&(bar)[XB_TMO], 1u); break; } } } } while (0)

struct XcdBarrier {
    unsigned* bar; unsigned x;
    volatile LAS unsigned* st;
};

__device__ __forceinline__ XcdBarrier xcd_barrier_post(unsigned* bar, volatile LAS unsigned* st) {
    XcdBarrier b; b.bar = bar; b.x = xb_xcc_id(); b.st = st;
    if (threadIdx.x == 0) (void)xb_add(&bar[XB_XCNT(b.x)], 1u);
    return b;
}
__device__ __forceinline__ void xcd_barrier_complete(unsigned* bar, unsigned x, unsigned& nloc, unsigned& nx) {
    const unsigned G = gridDim.x * gridDim.y * gridDim.z;
    unsigned sum, cnt, mine, sp = 0u;
    for (;;) {
        sum = 0u; cnt = 0u; mine = 0u;
#pragma unroll
        for (unsigned j = 0; j < 16; ++j) { const unsigned c = xb_ld(&bar[XB_XCNT(j)]); sum += c; cnt += (c > 0u) ? 1u : 0u; mine = (j == x) ? c : mine; }
        if (sum == G) break;
        __builtin_amdgcn_s_sleep(1);
        if ((++sp & 255u) == 0u) { if (xb_ld(&bar[XB_TMO])) break; if (sp > XB_SPIN_CAP) { atomicAdd(&bar[XB_TMO], 1u); break; } }
    }
    nloc = mine > 0u ? mine : 1u; nx = cnt > 0u ? cnt : 1u;
}

__device__ __forceinline__ void xcd_barrier(const XcdBarrier& b) {
    asm volatile("s_waitcnt vmcnt(0)" ::: "memory");
    __syncthreads();
    if (threadIdx.x == 0) {
        unsigned* bar = b.bar;
        __builtin_amdgcn_s_waitcnt(0);
        unsigned nloc = b.st[0], nx = b.st[1];
        if (nloc == 0u) { xcd_barrier_complete(bar, b.x, nloc, nx); b.st[0] = nloc; b.st[1] = nx; }
        const unsigned seq = b.st[2];
        const unsigned old = xb_add(&bar[XB_XSUB(b.x)], 1u);
        const unsigned gen = old / nloc;
        if (old + 1u == (gen + 1u) * nloc) {
            __builtin_amdgcn_fence(__ATOMIC_RELEASE, "agent");
            asm volatile("s_waitcnt vmcnt(0)" ::: "memory");
            const unsigned og = xb_add(&bar[XB_TOP], 1u);
            const unsigned tg = og / nx;
            if (og + 1u == (tg + 1u) * nx) xb_add(&bar[XB_TOPGEN], 1u);
        }
        XB_SPIN(xb_ld(&bar[XB_TOPGEN]) == seq, bar);
        b.st[2] = seq + 1u;
        __builtin_amdgcn_fence(__ATOMIC_ACQUIRE, "agent");
        asm volatile("s_waitcnt vmcnt(0)" ::: "memory");
    }
    __syncthreads();
}
#ifndef PP_IN_P10
#define PP_IN_P10 0
#endif
#ifndef GFOLD
#define GFOLD 1
#endif
#ifndef MG_LATE
#define MG_LATE 0
#endif
#ifndef NT_STREAM
#define NT_STREAM 1
#endif
#if NT_STREAM
#define NT_LD(p) __builtin_nontemporal_load(p)
#else
#define NT_LD(p) (*(p))
#endif
#define GATE_LD(p) NT_LD(p)
#ifndef NT_STORES_MG
#define NT_STORES_MG 1
#endif
#if NT_STORES_MG
#define MG_ST16(p, v) __builtin_nontemporal_store(v, (u32x4*)(p))
#define GATE_ST16(p, v) do { if (MG_LATE) st_wt16(p, v); else __builtin_nontemporal_store(v, (u32x4*)(p)); } while (0)
#else
#define MG_ST16(p, v) st_wt16(p, v)
#define GATE_ST16(p, v) st_wt16(p, v)
#endif
#ifndef NT_STORES_OUT
#define NT_STORES_OUT 0
#endif
#if NT_STORES_OUT
#define OUT_ST(p, v) __builtin_nontemporal_store(v, p)
#else
#define OUT_ST(p, v) (*(p) = (v))
#endif
#ifndef NT_STORES_X1F8
#define NT_STORES_X1F8 0
#endif
#if NT_STORES_X1F8
#define X1F8_ST(p, v) __builtin_nontemporal_store(v, p)
#else
#define X1F8_ST(p, v) (*(p) = (v))
#endif
#ifndef NT_STORES_P4
#define NT_STORES_P4 0
#endif
#if NT_STORES_P4
#define NT_ST16(p, v) __builtin_nontemporal_store(v, (u32x4*)(p))
#else
#define NT_ST16(p, v) st_wt16(p, v)
#endif

constexpr int NWAVES = 8;
#ifndef P1_ALIGN
#define P1_ALIGN true
#endif
#ifndef MK_PER_PHASE
#define MK_PER_PHASE 0
#endif
constexpr int NPH = 11;
constexpr size_t MiB = 1u << 20;
constexpr size_t WS_CTL = 0, CTL_ZERO_BYTES = 128 * 1024;
constexpr size_t WS_WT = 1 * MiB;
constexpr size_t WS_RSTD2 = WS_WT + 256 * 1024;
constexpr size_t WS_RSTD3 = WS_RSTD2 + 128 * 1024;
constexpr size_t WS_C1 = WS_RSTD3 + 128 * 1024;
constexpr size_t WS_IRS = WS_C1 + 4096;
constexpr size_t WS_MER = 189 * MiB;
constexpr size_t WS_LISTW = 240 * MiB, WS_LISTR = 244 * MiB;
constexpr size_t WS_X1 = 365 * MiB;
constexpr size_t WS_LIST = 2 * MiB;
constexpr size_t WS_NG = 6 * MiB;
constexpr size_t WS_KC = 10 * MiB, WS_VC = WS_KC + 512 * 1024;
constexpr size_t WS_WIN = 11 * MiB;
constexpr size_t WS_WAC = 20 * MiB, WS_WO = 22 * MiB, WS_WPG = 24 * MiB, WS_WPP = 26 * MiB, WS_WR = WS_WPP + 512 * 1024, WS_CW1 = 27 * MiB, WS_CW2 = 28 * MiB;
constexpr size_t WS_WGU = 29 * MiB;
constexpr size_t WS_WD = 93 * MiB;
constexpr size_t WS_XN8 = 61 * MiB;
constexpr size_t WS_WIN8 = 109 * MiB;
constexpr size_t WS_X1F8 = 61 * MiB;
constexpr size_t WS_XN = 125 * MiB;
constexpr size_t WS_QB = 189 * MiB;
constexpr size_t WS_KVB = 221 * MiB;
constexpr size_t WS_H = 189 * MiB;
constexpr size_t WS_GLU = 269 * MiB;
constexpr size_t WS_MG = 301 * MiB;
constexpr size_t WS_Y = 301 * MiB;
constexpr size_t WS_AC = 429 * MiB;
constexpr size_t WS_PP = 429 * MiB;
constexpr size_t WS_PBF = 493 * MiB;
constexpr size_t WS_END = 509 * MiB;
constexpr int CW_TMO = 0, CW_CODE = 1, CW_QATT = 64, CW_CNT = 128  , CW_BAR = 4096, CW_Q7 = 12288, CW_Q8 = 12352, CW_QX = 16384  ;
#ifndef ATT_XCD_QUEUES
#define ATT_XCD_QUEUES 0
#endif

constexpr int RING_BYTES = 131072;
constexpr int LDSCTL_OFF = RING_BYTES, MISC_OFF = LDSCTL_OFF + 320, MOE_OFF = LDSCTL_OFF + 1024;
constexpr int LDS_BYTES = 147456;

struct Args { const float* in[29]; float* out; unsigned char* ws; int ph_lo, ph_hi; };
#define CAS __attribute__((address_space(4)))
struct Frame {
    LAS unsigned char* lds;
    volatile LAS unsigned* MISC;
    gu32* ctl;
    int tid, lane, wave, vcu, G;
    const CAS Args* ka;
    float* out;
    unsigned char* ws;
    __device__ __forceinline__ const float* inp(int i) const { return ka->in[i]; }
};

struct TrSrc { const float* W; int ldw, s0, nv; };
__device__ __forceinline__ void tr64(const TrSrc A, const TrSrc B, int ks0, const float* kscale, bf16* WT, size_t drow0, int K, int kd0, int lane) {
    const int q = lane >> 4, c = lane & 15, blk = c >> 3, cc = (c & 7) * 4;
    const float* W = blk ? B.W : A.W; const int ldw = blk ? B.ldw : A.ldw, s0 = blk ? B.s0 : A.s0, nv = blk ? B.nv : A.nv;
    const bool valid = cc < nv;
    f32x4 v[16];
#pragma unroll
    for (int i = 0; i < 16; ++i) { v[i] = (f32x4){0.f, 0.f, 0.f, 0.f}; if (valid) v[i] = *(const f32x4*)(W + (size_t)(ks0 + 16 * q + i) * ldw + s0 + cc); }
    if (kscale) {
#pragma unroll
        for (int i = 0; i < 16; ++i) v[i] *= kscale[ks0 + 16 * q + i]; }
#pragma unroll
    for (int j = 0; j < 4; ++j) { bf16* dst = WT + (drow0 + blk * 32 + cc + j) * K + kd0 + 16 * q;
        u32x4 o0, o1;
        o0.x = cvt_pk_bf16(v[0][j], v[1][j]); o0.y = cvt_pk_bf16(v[2][j], v[3][j]); o0.z = cvt_pk_bf16(v[4][j], v[5][j]); o0.w = cvt_pk_bf16(v[6][j], v[7][j]);
        o1.x = cvt_pk_bf16(v[8][j], v[9][j]); o1.y = cvt_pk_bf16(v[10][j], v[11][j]); o1.z = cvt_pk_bf16(v[12][j], v[13][j]); o1.w = cvt_pk_bf16(v[14][j], v[15][j]);
        st_wt16(dst, o0); st_wt16(dst + 8, o1); }
}
__device__ __forceinline__ void tr64_f8(const TrSrc A, const TrSrc B, int ks0, const float* kscale, float scale, unsigned char* WT, size_t drow0, int K8, int kd0, int lane) {
    const int q = lane >> 4, c = lane & 15, blk = c >> 3, cc = (c & 7) * 4;
    const float* W = blk ? B.W : A.W; const int ldw = blk ? B.ldw : A.ldw, s0 = blk ? B.s0 : A.s0, nv = blk ? B.nv : A.nv;
    const bool valid = cc < nv; if (!valid) scale = 0.f;
    f32x4 v[16];
#pragma unroll
    for (int i = 0; i < 16; ++i) v[i] = *(const f32x4*)(W + (size_t)(ks0 + 16 * q + i) * ldw + s0 + (valid ? cc : 0)) * scale;
    if (kscale) {
#pragma unroll
        for (int i = 0; i < 16; ++i) v[i] *= kscale[ks0 + 16 * q + i]; }
#pragma unroll
    for (int j = 0; j < 4; ++j) { u32x4 o; unsigned* op = (unsigned*)&o;
#pragma unroll
        for (int d = 0; d < 4; ++d) { int t = __builtin_amdgcn_cvt_pk_fp8_f32(v[4 * d][j], v[4 * d + 1][j], 0, false); t = __builtin_amdgcn_cvt_pk_fp8_f32(v[4 * d + 2][j], v[4 * d + 3][j], t, true); op[d] = (unsigned)t; }
        *(u32x4*)(WT + (drow0 + blk * 32 + cc + j) * K8 + kd0 + 16 * q) = o; }
}
__device__ __forceinline__ TrSrc win_src(const float* W, int tile, int pb) {
    const int bj = pb >> 2, wc = pb & 3; TrSrc s; s.W = W; s.ldw = NIN; s.nv = 32;
    const int kvc = 64 * (wc & 1) + 32 * bj;
    if (tile < 2) s.s0 = tile * 256 + 64 * wc + 32 * bj;
    else if (tile == 2) s.s0 = OFF_KV + ((wc >> 1) ? 256 : 0) + kvc;
    else if (tile < 7) s.s0 = OFF_CONV + (bj ? 512 : 0) + (tile - 3) * 128 + 32 * wc;
    else if (tile == 7) { if (wc >= 2) s.s0 = OFF_KV + 512 + kvc; else { s.s0 = OFF_GATE; s.nv = (pb == 0) ? 24 : 0; } }
    else if (tile < 16) s.s0 = OFF_MERGE + (bj ? 1024 : 0) + (tile - 8) * 128 + 32 * wc;
    else if (tile == 16) s.s0 = OFF_KV + ((wc >> 1) ? 384 : 128) + kvc;
    else { s.s0 = OFF_KV + 640 + kvc; if (wc >= 2) { s.s0 = OFF_KV; s.nv = 0; } }
    return s;
}
#ifndef P10_FP8
#define P10_FP8 1
#endif
#ifndef X_BF16
#define X_BF16 2
#endif
constexpr int I_GU = 32 * 16 * 16, I_D = 32 * 16 * 8, I_AC = 16 * 16, I_O = 16 * 16, I_PG = 16 * 16, I_PP = 16 * 4, I_R = 16, I_PBF = 2048;
constexpr int N_LATE = I_GU + I_D + I_AC + I_O + I_PG + I_PP + I_R + I_PBF;
constexpr int I_IN = 72 * 16, I_C1 = 2 * 2 * 32, I_C2 = 2 * 1 * 2;
constexpr int NITEMS = N_LATE + I_IN + I_C1 + I_C2;
static_assert(N_LATE <= 16 * 1024, "late items are dealt 16 per attention unit");
__device__ __forceinline__ void p0_item(Frame& F, int it, int lane) {
    unsigned char* ws = F.ws;
    int r = it;
    if (r < I_GU) { const int e = r >> 8, qq = r & 255, dg = qq >> 4, kb = qq & 15, pn = dg >> 2, pb = (dg & 3) * 2, bj = pb >> 2, wc = pb & 3;
        const float* W = (bj ? F.inp(23) : F.inp(22)) + (size_t)e * 1024 * 512;
        const TrSrc A{W, 512, 128 * pn + 32 * wc, 32}, B{W, 512, 128 * pn + 32 * wc + 32, 32};
        tr64_f8(A, B, kb * 64, F.inp(17), 32.f, ws + WS_WGU + (size_t)e * 1024 * 1024, (size_t)dg * 64, 1024, kb * 64, lane); return; }
    r -= I_GU;
    if (r < I_D) { const int e = r >> 7, qq = r & 127, dg = qq >> 3, kb = qq & 7; const float* W = F.inp(24) + (size_t)e * 512 * 1024;
        const TrSrc A{W, 1024, dg * 64, 32}, B{W, 1024, dg * 64 + 32, 32};
        tr64_f8(A, B, kb * 64, nullptr, 16.f, ws + WS_WD + (size_t)e * 1024 * 512, (size_t)dg * 64, 512, kb * 64, lane); return; }
    r -= I_D;
    if (r < I_AC) { const int dg = r >> 4, kb = r & 15; const float* W = kb < 8 ? F.inp(9) : F.inp(14);
        const TrSrc A{W, 1024, dg * 64, 32}, B{W, 1024, dg * 64 + 32, 32};
        tr64(A, B, (kb & 7) * 64, nullptr, (bf16*)(ws + WS_WAC), (size_t)dg * 64, 1024, kb * 64, lane); return; }
    r -= I_AC;
    if (r < I_O) { const int dg = r >> 4, kb = r & 15; const TrSrc A{F.inp(16), 1024, dg * 64, 32}, B{F.inp(16), 1024, dg * 64 + 32, 32};
        tr64(A, B, kb * 64, nullptr, (bf16*)(ws + WS_WO), (size_t)dg * 64, 1024, kb * 64, lane); return; }
    r -= I_O;
    if (r < I_PG) { const int dg = r >> 4, kb = r & 15; const TrSrc A{F.inp(26), 1024, dg * 64, 32}, B{F.inp(26), 1024, dg * 64 + 32, 32};
        if (P10_FP8) tr64_f8(A, B, kb * 64, F.inp(25), 32.f, ws + WS_WPG, (size_t)dg * 64, 1024, kb * 64, lane); else tr64(A, B, kb * 64, F.inp(25), (bf16*)(ws + WS_WPG), (size_t)dg * 64, 1024, kb * 64, lane); return; }
    r -= I_PG;
    if (r < I_PP) { const int dg = r >> 2, kb = r & 3; const TrSrc A{F.inp(28), 1024, dg * 64, 32}, B{F.inp(28), 1024, dg * 64 + 32, 32};
        tr64(A, B, kb * 64, nullptr, (bf16*)(ws + WS_WPP), (size_t)dg * 64, 256, kb * 64, lane); return; }
    r -= I_PP;
    if (r < I_R) { const int kb = r;
        const TrSrc A{F.inp(18), 4, 0, 4}, B{F.inp(20), 32, 0, 32};
        tr64(A, B, kb * 64, F.inp(17), (bf16*)(ws + WS_WR), 0, 1024, kb * 64, lane); return; }
    r -= I_R;
    if (r < I_PBF) {
        const f32x4* src = (const f32x4*)F.inp(1) + (size_t)r * 1024 + 2 * lane; u32x4* dst = (u32x4*)(ws + WS_PBF) + (size_t)r * 512 + lane; f32x4 a[8], b[8];
#pragma unroll
        for (int i = 0; i < 8; ++i) { a[i] = src[128 * i]; b[i] = src[128 * i + 1]; }
#pragma unroll
        for (int i = 0; i < 8; ++i) { u32x4 o; o.x = cvt_pk_bf16(a[i].x, a[i].y); o.y = cvt_pk_bf16(a[i].z, a[i].w); o.z = cvt_pk_bf16(b[i].x, b[i].y); o.w = cvt_pk_bf16(b[i].z, b[i].w); dst[64 * i] = o; }
        return; }
    r -= I_PBF;
    if (r < I_IN) { const int dg = r >> 4, kb = r & 15, tile = dg >> 2, pb = (dg & 3) * 2;
        if (tile >= 8) tr64_f8(win_src(F.inp(3), tile, pb), win_src(F.inp(3), tile, pb + 1), kb * 64, GFOLD ? F.inp(2) : nullptr, 32.f, ws + WS_WIN8, (size_t)(dg - 32) * 64, 1024, kb * 64, lane);
        else tr64(win_src(F.inp(3), tile, pb), win_src(F.inp(3), tile, pb + 1), kb * 64, GFOLD ? F.inp(2) : nullptr, (bf16*)(ws + WS_WIN), (size_t)dg * 64, 1024, kb * 64, lane);
        return; }
    r -= I_IN;
    if (r < I_C1) { const int kv = r >> 6, qq = r & 63, dg = qq >> 5, kb = qq & 31; const float* W = F.inp(7) + (size_t)kv * 2048 * 128;
        const TrSrc A{W, 128, dg * 64, 32}, B{W, 128, dg * 64 + 32, 32};
        tr64(A, B, kb * 64, nullptr, (bf16*)(ws + WS_CW1) + (size_t)kv * 128 * 2048, (size_t)dg * 64, 2048, kb * 64, lane); return; }
    r -= I_C1;
    { const int kv = r >> 1, kb = r & 1; const float* W = F.inp(8) + (size_t)kv * 128 * 64;
        const TrSrc A{W, 64, 0, 32}, B{W, 64, 32, 32};
        tr64(A, B, kb * 64, nullptr, (bf16*)(ws + WS_CW2) + (size_t)kv * 64 * 128, 0, 128, kb * 64, lane); }
}
constexpr int L_GAIN = 126976;
#ifndef LATE_NT
#define LATE_NT 1
#endif
#if LATE_NT & 1
#define LATE_LD(p) __builtin_nontemporal_load(p)
#else
#define LATE_LD(p) (*(p))
#endif
#if LATE_NT & 2
#define LATE_ST(p, v) __builtin_nontemporal_store(v, p)
#else
#define LATE_ST(p, v) (*(p) = (v))
#endif
struct LateD { const float* p; const float* ks; unsigned char* dst; int ldw, rstride, kind, ksl; float scale; bool valid; };
__device__ __forceinline__ LateD late_desc(Frame& F, int it, int lane) {
    LateD d; d.kind = 3; d.ks = nullptr; d.ksl = -1; d.scale = 1.f; d.valid = true; d.ldw = 0; d.rstride = 0; d.p = nullptr; d.dst = nullptr;
    if (it >= N_LATE) return d;
    const int q = lane >> 4, c = lane & 15, blk = c >> 3, cc = (c & 7) * 4;
    unsigned char* ws = F.ws;
    auto set = [&](const TrSrc A, const TrSrc B, int ks0, const float* kscale, int ksl, float scale, unsigned char* WT, size_t drow0, int K, int kd0, int kind) {
        const float* W = blk ? B.W : A.W; const int ldw = blk ? B.ldw : A.ldw, s0 = blk ? B.s0 : A.s0, nv = blk ? B.nv : A.nv;
        d.valid = cc < nv; d.p = W + (size_t)(ks0 + 16 * q) * ldw + s0 + (d.valid ? cc : 0); d.ldw = ldw;
        d.ks = kscale ? kscale + ks0 + 16 * q : nullptr; d.ksl = ksl >= 0 ? ksl + ks0 + 16 * q : -1; d.scale = scale; d.kind = kind;
        const int eb = kind == 0 ? 1 : 2;
        d.dst = WT + ((drow0 + blk * 32 + cc) * K + kd0 + 16 * q) * eb; d.rstride = K * eb; };
    int r = it;
    if (r < I_GU) { const int e = r >> 8, qq = r & 255, dg = qq >> 4, kb = qq & 15, pn = dg >> 2, pb = (dg & 3) * 2, bj = pb >> 2, wc = pb & 3;
        const float* W = (bj ? F.inp(23) : F.inp(22)) + (size_t)e * 1024 * 512;
        set(TrSrc{W, 512, 128 * pn + 32 * wc, 32}, TrSrc{W, 512, 128 * pn + 32 * wc + 32, 32}, kb * 64, nullptr, 0, 32.f, ws + WS_WGU + (size_t)e * 1024 * 1024, (size_t)dg * 64, 1024, kb * 64, 0); return d; }
    r -= I_GU;
    if (r < I_D) { const int e = r >> 7, qq = r & 127, dg = qq >> 3, kb = qq & 7; const float* W = F.inp(24) + (size_t)e * 512 * 1024;
        set(TrSrc{W, 1024, dg * 64, 32}, TrSrc{W, 1024, dg * 64 + 32, 32}, kb * 64, nullptr, -1, 16.f, ws + WS_WD + (size_t)e * 1024 * 512, (size_t)dg * 64, 512, kb * 64, 0); return d; }
    r -= I_D;
    if (r < I_AC) { const int dg = r >> 4, kb = r & 15; const float* W = kb < 8 ? F.inp(9) : F.inp(14);
        set(TrSrc{W, 1024, dg * 64, 32}, TrSrc{W, 1024, dg * 64 + 32, 32}, (kb & 7) * 64, nullptr, -1, 1.f, ws + WS_WAC, (size_t)dg * 64, 1024, kb * 64, 1); return d; }
    r -= I_AC;
    if (r < I_O) { const int dg = r >> 4, kb = r & 15;
        set(TrSrc{F.inp(16), 1024, dg * 64, 32}, TrSrc{F.inp(16), 1024, dg * 64 + 32, 32}, kb * 64, nullptr, -1, 1.f, ws + WS_WO, (size_t)dg * 64, 1024, kb * 64, 1); return d; }
    r -= I_O;
    if (r < I_PG) { const int dg = r >> 4, kb = r & 15;
        set(TrSrc{F.inp(26), 1024, dg * 64, 32}, TrSrc{F.inp(26), 1024, dg * 64 + 32, 32}, kb * 64, F.inp(25), -1, P10_FP8 ? 32.f : 1.f, ws + WS_WPG, (size_t)dg * 64, 1024, kb * 64, P10_FP8 ? 0 : 1); return d; }
    r -= I_PG;
    if (r < I_PP) { const int dg = r >> 2, kb = r & 3;
        set(TrSrc{F.inp(28), 1024, dg * 64, 32}, TrSrc{F.inp(28), 1024, dg * 64 + 32, 32}, kb * 64, nullptr, -1, 1.f, ws + WS_WPP, (size_t)dg * 64, 256, kb * 64, 1); return d; }
    r -= I_PP;
    if (r < I_R) { const int kb = r;
        set(TrSrc{F.inp(18), 4, 0, 4}, TrSrc{F.inp(20), 32, 0, 32}, kb * 64, F.inp(17), -1, 1.f, ws + WS_WR, 0, 1024, kb * 64, 1); return d; }
    r -= I_R;
    d.kind = 2; d.p = F.inp(1) + ((size_t)r * 1024 + lane) * 4; d.ldw = 256; d.dst = ws + WS_PBF + ((size_t)r * 1024 + lane) * 8;
    return d;
}
__device__ __forceinline__ void late_load(const LateD& d, f32x4 (&v)[16]) {
    if (d.kind != 3) {
#pragma unroll
        for (int i = 0; i < 16; ++i) v[i] = LATE_LD((const f32x4*)(d.p + (size_t)i * d.ldw)); }
    else {
#pragma unroll
        for (int i = 0; i < 16; ++i) v[i] = (f32x4){0.f, 0.f, 0.f, 0.f}; }
}
__device__ __forceinline__ void late_finish(Frame& F, const LateD& d, f32x4 (&v)[16]) {
    if (d.kind == 0) {
        if (d.ksl >= 0) { const LAS float* gl = (const LAS float*)(F.lds + L_GAIN) + d.ksl;
#pragma unroll
            for (int i4 = 0; i4 < 4; ++i4) { const f32x4 g4 = *(const LAS f32x4*)(gl + 4 * i4);
#pragma unroll
                for (int k = 0; k < 4; ++k) v[4 * i4 + k] *= g4[k] * d.scale; }
        } else if (d.ks) {
#pragma unroll
            for (int i = 0; i < 16; ++i) v[i] *= d.ks[i] * d.scale;
        } else {
#pragma unroll
            for (int i = 0; i < 16; ++i) v[i] *= d.scale; }
#pragma unroll
        for (int j = 0; j < 4; ++j) { u32x4 o; unsigned* op = (unsigned*)&o;
#pragma unroll
            for (int dd = 0; dd < 4; ++dd) { int t = __builtin_amdgcn_cvt_pk_fp8_f32(v[4 * dd][j], v[4 * dd + 1][j], 0, false); t = __builtin_amdgcn_cvt_pk_fp8_f32(v[4 * dd + 2][j], v[4 * dd + 3][j], t, true); op[dd] = (unsigned)t; }
            LATE_ST((u32x4*)(d.dst + (size_t)j * d.rstride), o); }
    } else if (d.kind == 1) {
        if (d.ks) {
#pragma unroll
            for (int i = 0; i < 16; ++i) v[i] *= d.ks[i]; }
        if (!d.valid) {
#pragma unroll
            for (int i = 0; i < 16; ++i) v[i] = (f32x4){0.f, 0.f, 0.f, 0.f}; }
#pragma unroll
        for (int j = 0; j < 4; ++j) { bf16* dst = (bf16*)(d.dst + (size_t)j * d.rstride);
            u32x4 o0, o1;
            o0.x = cvt_pk_bf16(v[0][j], v[1][j]); o0.y = cvt_pk_bf16(v[2][j], v[3][j]); o0.z = cvt_pk_bf16(v[4][j], v[5][j]); o0.w = cvt_pk_bf16(v[6][j], v[7][j]);
            o1.x = cvt_pk_bf16(v[8][j], v[9][j]); o1.y = cvt_pk_bf16(v[10][j], v[11][j]); o1.z = cvt_pk_bf16(v[12][j], v[13][j]); o1.w = cvt_pk_bf16(v[14][j], v[15][j]);
            LATE_ST((u32x4*)dst, o0); LATE_ST((u32x4*)(dst + 8), o1); }
    } else if (d.kind == 2) {
#pragma unroll
        for (int i = 0; i < 16; ++i) { u32x2 o; o.x = cvt_pk_bf16(v[i].x, v[i].y); o.y = cvt_pk_bf16(v[i].z, v[i].w); LATE_ST((u32x2*)d.dst + 64 * i, o); }
    }
}
__device__ __forceinline__ void p0_prologue(Frame& F) {
    const int lane = F.lane;
    const int gw = F.vcu * NWAVES + F.wave, NGW = F.G * NWAVES;
    unsigned char* ws = F.ws;
#ifdef LATE_IN_P0
    for (int it = gw; it < NITEMS; it += NGW) p0_item(F, it, lane);
#else
    for (int it = N_LATE + gw; it < NITEMS; it += NGW) p0_item(F, it, lane);
#endif
    {
        const f32x4* gp = (const f32x4*)F.inp(2) + lane; f32x4 gv[4];
#pragma unroll
        for (int j = 0; j < 4; ++j) gv[j] = gp[64 * j];
#pragma unroll 2
        for (int m = gw; m < T; m += NGW) {
            const f32x4* xr = (const f32x4*)(F.inp(0) + (size_t)m * DM) + lane; f32x4 v[4]; float s = 0.f;
#pragma unroll
            for (int j = 0; j < 4; ++j) { v[j] = NT_LD(xr + 64 * j); s += (v[j].x * v[j].x + v[j].y * v[j].y) + (v[j].z * v[j].z + v[j].w * v[j].w); }
            const float rms_ = sqrtf(wave_sum(s) * (1.f / DM) + EPS); const float rstd = 1.0f / rms_;
            if (X_BF16 == 2 && lane == 0) ((float*)(ws + WS_IRS))[m] = rms_;
            u32x2* o8 = (u32x2*)((bf16*)(ws + WS_XN) + (size_t)m * DM) + lane;
            u32x2* xb = (u32x2*)((bf16*)F.out + (size_t)T * DM + (size_t)m * DM) + lane;
            unsigned* o4 = (unsigned*)(ws + WS_XN8 + (size_t)m * DM) + lane;
#pragma unroll
            for (int j = 0; j < 4; ++j) { const f32x4 y = GFOLD ? v[j] * rstd : v[j] * rstd * gv[j]; u32x2 w; w.x = cvt_pk_bf16(y.x, y.y); w.y = cvt_pk_bf16(y.z, y.w); o8[64 * j] = w;
                if (X_BF16 == 1) { u32x2 wx; wx.x = cvt_pk_bf16(v[j].x, v[j].y); wx.y = cvt_pk_bf16(v[j].z, v[j].w); xb[64 * j] = wx; }
                int t8 = __builtin_amdgcn_cvt_pk_fp8_f32(y.x * 16.f, y.y * 16.f, 0, false); t8 = __builtin_amdgcn_cvt_pk_fp8_f32(y.z * 16.f, y.w * 16.f, t8, true); o4[64 * j] = (unsigned)t8; }
        }
    }
    if (gw < 256) { const int kv = gw >> 7, j = gw & 127; const float* pe = F.inp(6) + (size_t)kv * 2048; const float* w1 = F.inp(7) + (size_t)kv * 2048 * 128 + j; float s = 0.f;
        for (int k = lane; k < 2048; k += 64) s += pe[k] * w1[(size_t)k * 128];
        s = wave_sum(s); if (lane == 0) ((float*)(ws + WS_C1))[gw] = s; }
}

__device__ __forceinline__ u32x4 pack8(const f32x4 a, const f32x4 b) { u32x4 w; w.x = cvt_pk_bf16(a[0], a[1]); w.y = cvt_pk_bf16(a[2], a[3]); w.z = cvt_pk_bf16(b[0], b[1]); w.w = cvt_pk_bf16(b[2], b[3]); return w; }
__device__ __forceinline__ void unpack8(const u32x4 w, f32x4& a, f32x4& b) { a = (f32x4){bf_lo(w.x), bf_hi(w.x), bf_lo(w.y), bf_hi(w.y)}; b = (f32x4){bf_lo(w.z), bf_hi(w.z), bf_lo(w.w), bf_hi(w.w)}; }

__device__ __forceinline__ u32x2 pack8_fp8(const f32x4 a, const f32x4 b) { u32x2 w;
    int t = __builtin_amdgcn_cvt_pk_fp8_f32(a[0], a[1], 0, false); t = __builtin_amdgcn_cvt_pk_fp8_f32(a[2], a[3], t, true); w.x = (unsigned)t;
    t = __builtin_amdgcn_cvt_pk_fp8_f32(b[0], b[1], 0, false); t = __builtin_amdgcn_cvt_pk_fp8_f32(b[2], b[3], t, true); w.y = (unsigned)t; return w; }
__device__ __forceinline__ void unpack8_fp8(const u32x2 w, f32x4& a, f32x4& b) {
    const f32x2 a0 = __builtin_amdgcn_cvt_pk_f32_fp8((int)w.x, false), a1 = __builtin_amdgcn_cvt_pk_f32_fp8((int)w.x, true), b0 = __builtin_amdgcn_cvt_pk_f32_fp8((int)w.y, false), b1 = __builtin_amdgcn_cvt_pk_f32_fp8((int)w.y, true);
    a = (f32x4){a0.x, a0.y, a1.x, a1.y}; b = (f32x4){b0.x, b0.y, b1.x, b1.y}; }

template <int MODE  > struct EpiWin {
    static constexpr bool MID = false, PROF = false, NOPERM = false; static constexpr int MID_T = 0;
    bf16 *Qb, *KVb, *GLU, *MG; float* NG; const float *qg, *kg, *mb; float zs;
    __device__ __forceinline__ void mid(f32x4 (&)[2][2][4][2], const pg8::Unit&, int, int, int, int) const {}
    __device__ __forceinline__ void head_store(const f32x4 (&acc)[2][2][4][2], int row0, int fq, bool norm, const float* gain, float sc, bf16* dst, int ld, int col) const {
        f32x4 gv[2][2];
#pragma unroll
        for (int bj = 0; bj < 2; ++bj)
#pragma unroll
            for (int n = 0; n < 2; ++n) gv[bj][n] = norm ? *(const f32x4*)(gain + 32 * bj + 8 * fq + 4 * n) * sc : (f32x4){sc, sc, sc, sc};
#pragma unroll
        for (int ai = 0; ai < 2; ++ai)
#pragma unroll
            for (int m = 0; m < 4; ++m) {
                float rs = 1.f;
                if (norm) { float s = 0.f;
#pragma unroll
                    for (int bj = 0; bj < 2; ++bj)
#pragma unroll
                        for (int n = 0; n < 2; ++n) { const f32x4 x = acc[ai][bj][m][n]; s += (x[0] * x[0] + x[1] * x[1]) + (x[2] * x[2] + x[3] * x[3]); }
                    s += __shfl_xor(s, 16); s += __shfl_xor(s, 32);
                    rs = 1.0f / sqrtf(s * (1.f / 64.f) + EPS); }
                bf16* rowp = dst + (unsigned)((row0 + ai * 128 + m * 16) * ld + col + 8 * fq);
#pragma unroll
                for (int bj = 0; bj < 2; ++bj) st_wt16(rowp + 32 * bj, pack8(acc[ai][bj][m][0] * rs * gv[bj][0], acc[ai][bj][m][1] * rs * gv[bj][1]));
            }
    }
    __device__ __forceinline__ void operator()(const f32x4 (&acc)[2][2][4][2], const pg8::Unit& u, int wr, int wc, int fr, int fq) const {
        int oz = 0; asm volatile("" : "+v"(oz));
        const int row0 = u.pm * 256 + wr * 64 + fr + oz, pn = u.pn;
        if (MODE == 0 && pn < 2) head_store(acc, row0, fq, true, qg, QC2, Qb, 512, (pn * 4 + wc) * 64);
        else if (MODE == 0 && pn == 2) { const int i = (wc >> 1) ? 2 : 0; head_store(acc, row0, fq, i == 2, kg + 64, 1.f, KVb, 768, i * 128 + (wc & 1) * 64); }
        else if (MODE == 0 && pn < 7) {
            const int col = (pn - 3) * 128 + 32 * wc + 8 * fq;
#pragma unroll
            for (int ai = 0; ai < 2; ++ai)
#pragma unroll
                for (int m = 0; m < 4; ++m) { f32x4 o[2];
#pragma unroll
                    for (int n = 0; n < 2; ++n) { const f32x4 a = acc[ai][0][m][n], gt = acc[ai][1][m][n];
                        o[n] = (f32x4){a[0] * fsigmoid(gt[0]), a[1] * fsigmoid(gt[1]), a[2] * fsigmoid(gt[2]), a[3] * fsigmoid(gt[3])}; }
                    st_wt16(GLU + (unsigned)((row0 + ai * 128 + m * 16) * 512 + col), pack8(o[0], o[1])); }
        } else if (MODE == 0) {
            if (wc >= 2) head_store(acc, row0, fq, true, kg + 128, 1.f, KVb, 768, 4 * 128 + (wc & 1) * 64);
            else if (wc == 0 && fq < 3) {
#pragma unroll
                for (int ai = 0; ai < 2; ++ai)
#pragma unroll
                    for (int m = 0; m < 4; ++m)
#pragma unroll
                        for (int n = 0; n < 2; ++n) { const f32x4 z = acc[ai][0][m][n];
                            *(f32x4*)(NG + (unsigned)((row0 + ai * 128 + m * 16) * 32 + 8 * fq + 4 * n)) = (f32x4){fsigmoid(z[0]), fsigmoid(z[1]), fsigmoid(z[2]), fsigmoid(z[3])}; }
            }
        } else if (pn < 16) {
            const int col = (pn - 8) * 128 + 32 * wc + 8 * fq;
            f32x4 ba[2], bc[2];
#pragma unroll
            for (int n = 0; n < 2; ++n) { ba[n] = *(const f32x4*)(mb + col + 4 * n); bc[n] = *(const f32x4*)(mb + 1024 + col + 4 * n); }
#pragma unroll
            for (int ai = 0; ai < 2; ++ai)
#pragma unroll
                for (int m = 0; m < 4; ++m) { f32x4 rr[2], cc[2];
#pragma unroll
                    for (int n = 0; n < 2; ++n) { const f32x4 za = acc[ai][0][m][n] * zs + ba[n], zc = acc[ai][1][m][n] * zs + bc[n];
#pragma unroll
                        for (int j = 0; j < 4; ++j) { const float ea = __builtin_amdgcn_exp2f(-za[j] * LOG2E), ec = __builtin_amdgcn_exp2f(-zc[j] * LOG2E);
                            cc[n][j] = __builtin_amdgcn_rcpf(1.0f + ec); rr[n][j] = (1.0f + ec) * __builtin_amdgcn_rcpf(1.0f + ea); } }
                    bf16* rowp = MG + (unsigned)((row0 + ai * 128 + m * 16) * 2048 + col);
                    GATE_ST16(rowp, pack8(rr[0], rr[1])); GATE_ST16(rowp + 1024, pack8(cc[0], cc[1])); asm volatile("" ::: "memory"); }
        } else {
            const int i = (pn == 16) ? ((wc >> 1) ? 3 : 1) : 5;
            if (pn == 16 || wc < 2) head_store(acc, row0, fq, false, kg, zs, KVb, 768, i * 128 + (wc & 1) * 64);
        }
    }
};

#ifndef EPI_PRE
#define EPI_PRE 6
#endif
#ifndef MID_PRE
#define MID_PRE 8
#endif
#ifndef EPI_PRE_XN
#define EPI_PRE_XN (GFOLD ? 7 : 5)
#endif
#ifndef EPI_PRE_WO
#define EPI_PRE_WO 5
#endif
#ifndef EPI_PRE_PLE
#define EPI_PRE_PLE 5
#endif
#ifndef EPI_DEPTH
#define EPI_DEPTH 2
#endif
#ifndef PF_MERGE
#define PF_MERGE 0
#endif
struct EpiMerge {
    static constexpr bool MID = true, PROF = false, NOPERM = false, PREFETCH = (PF_MERGE != 0); static constexpr int MID_T = 8;
    const bf16* MG; bf16* MER; LAS unsigned char* lds_;
    __device__ __forceinline__ void prefetch(const pg8::Unit& u, int t, LAS unsigned char* lds, int wid, int lane) const {
        if (t != 0 || (PF_MERGE & 1)) { const int half = (t == 0) ? 0 : 1024; asm volatile("" : "+v"(lane));
#pragma unroll
            for (int j = 0; j < 2; ++j) { const int id = j * 64 + lane, row = wid * 32 + (id >> 2), seg = id & 3;
                __builtin_amdgcn_global_load_lds((const unsigned*)(MG + (unsigned)((u.pm * 256 + row) * 2048 + half + u.pn * 256 + seg * 64)), (LAS unsigned*)(lds + pg8::PF_DUMP), 4, 0, 0); } }
    }
    __device__ __forceinline__ void mid(f32x4 (&acc)[2][2][4][2], const pg8::Unit& u, int wr, int wc, int fr, int fq) const {
        int oz = 0; asm volatile("" : "+v"(oz));
        const int row0 = u.pm * 256 + wr * 64 + fr + oz, col0 = u.pn * 256 + wc * 32 + 8 * fq;
        constexpr int NPM = MID_PRE;
        u32x4 va[NPM][2];
#define MG_LD(g) do { const bf16* p_ = MG + (unsigned)((row0 + ((g) >> 2) * 128 + ((g) & 3) * 16) * 2048 + col0); va[(g) % NPM][0] = GATE_LD((const u32x4*)p_); va[(g) % NPM][1] = GATE_LD((const u32x4*)(p_ + 128)); } while (0)
#pragma unroll
        for (int g = 0; g < NPM; ++g) MG_LD(g);
        asm volatile("" ::: "memory");
#pragma unroll
        for (int g = 0; g < 8; ++g) { const int ai = g >> 2, m = g & 3, b = g % NPM;
#pragma unroll
            for (int bj = 0; bj < 2; ++bj) { f32x4 a0, a1; unpack8(va[b][bj], a0, a1); acc[ai][bj][m][0] *= a0; acc[ai][bj][m][1] *= a1; }
            asm volatile("" : "+v"(acc[ai][0][m][0]), "+v"(acc[ai][0][m][1]), "+v"(acc[ai][1][m][0]), "+v"(acc[ai][1][m][1]) :: "memory");
            if (g + NPM < 8) { MG_LD(g + NPM); asm volatile("" ::: "memory"); } }
#undef MG_LD
        if (PREFETCH && (PF_MERGE & 2)) prefetch(u, 1, lds_, wr * 4 + wc, fq * 16 + fr);
    }
    __device__ __forceinline__ void operator()(const f32x4 (&acc)[2][2][4][2], const pg8::Unit& u, int wr, int wc, int fr, int fq) const {
        int oz = 0; asm volatile("" : "+v"(oz));
        const int row0 = u.pm * 256 + wr * 64 + fr + oz, col0 = u.pn * 256 + wc * 32 + 8 * fq;
        constexpr int NPRE = EPI_PRE;
        u32x4 vc[NPRE][2];
#define MG_LD(g) do { const bf16* p_ = MG + (unsigned)((row0 + ((g) >> 2) * 128 + ((g) & 3) * 16) * 2048 + 1024 + col0); vc[(g) % NPRE][0] = GATE_LD((const u32x4*)p_); vc[(g) % NPRE][1] = GATE_LD((const u32x4*)(p_ + 128)); } while (0)
#pragma unroll
        for (int g = 0; g < NPRE; ++g) MG_LD(g);
        asm volatile("" ::: "memory");
#pragma unroll
        for (int g = 0; g < 8; ++g) { const int ai = g >> 2, m = g & 3, b = g % NPRE;
#pragma unroll
            for (int bj = 0; bj < 2; ++bj) { f32x4 c0, c1; unpack8(vc[b][bj], c0, c1);
                NT_ST16(MER + (unsigned)((row0 + ai * 128 + m * 16) * 1024 + col0 + bj * 128), pack8(acc[ai][bj][m][0] * c0, acc[ai][bj][m][1] * c1)); }
            asm volatile("" ::: "memory");
            if (g + NPRE < 8) { MG_LD(g + NPRE); asm volatile("" ::: "memory"); } }
#undef MG_LD
    }
};

struct EpiWo {
    static constexpr bool MID = false, PROF = false, NOPERM = false; static constexpr int MID_T = 0;
    const float* X; bf16* O; unsigned char* O8; const bf16* XB16; const float* irs; const float* gain;
    __device__ __forceinline__ void mid(f32x4 (&)[2][2][4][2], const pg8::Unit&, int, int, int, int) const {}
    __device__ __forceinline__ void operator()(const f32x4 (&acc)[2][2][4][2], const pg8::Unit& u, int wr, int wc, int fr, int fq) const {
        int oz = 0; asm volatile("" : "+v"(oz));
        const int row0 = u.pm * 256 + wr * 64 + fr + oz, col0 = u.pn * 256 + wc * 32 + 8 * fq;
#if X_BF16
        constexpr int NPRE = (X_BF16 == 2) ? EPI_PRE_XN : EPI_PRE;
        u32x4 xw[NPRE][2];
        float rsi[NPRE]; f32x4 ig[2][2];
        if (X_BF16 == 2 && !GFOLD) {
#pragma unroll
            for (int bj = 0; bj < 2; ++bj)
#pragma unroll
                for (int n = 0; n < 2; ++n) { const f32x4 gq = *(const f32x4*)(gain + col0 + bj * 128 + 4 * n); ig[bj][n] = (f32x4){1.f / gq[0], 1.f / gq[1], 1.f / gq[2], 1.f / gq[3]}; } }
#define WO_LD(g) do { const int r_ = row0 + ((g) >> 2) * 128 + ((g) & 3) * 16; const bf16* p_ = XB16 + (unsigned)(r_ * 1024 + col0); xw[(g) % NPRE][0] = NT_LD((const u32x4*)p_); xw[(g) % NPRE][1] = NT_LD((const u32x4*)(p_ + 128)); \
            if (X_BF16 == 2) rsi[(g) % NPRE] = irs[r_]; } while (0)
#pragma unroll
        for (int g = 0; g < NPRE; ++g) WO_LD(g);
        asm volatile("" ::: "memory");
#pragma unroll
        for (int g = 0; g < 8; ++g) { const int ai = g >> 2, m = g & 3;
#pragma unroll
            for (int bj = 0; bj < 2; ++bj) { f32x4 x0, x1; unpack8(xw[g % NPRE][bj], x0, x1);
                if (X_BF16 == 2) { const float ri = rsi[g % NPRE]; if (GFOLD) { x0 *= ri; x1 *= ri; } else { x0 *= ig[bj][0] * ri; x1 *= ig[bj][1] * ri; } }
                const f32x4 y0 = x0 + acc[ai][bj][m][0], y1 = x1 + acc[ai][bj][m][1]; const unsigned o_ = (unsigned)((row0 + ai * 128 + m * 16) * 1024 + col0 + bj * 128);
                st_wt16(O + o_, pack8(y0, y1)); X1F8_ST((u32x2*)(O8 + o_), pack8_fp8(y0 * 16.f, y1 * 16.f)); }
            asm volatile("" ::: "memory");
            if (g + NPRE < 8) { WO_LD(g + NPRE); asm volatile("" ::: "memory"); } }
#undef WO_LD
#else
        constexpr int NPRE = EPI_PRE_WO;
        f32x4 xv[NPRE][2][2];
#define WO_LD(g) do { const float* p_ = X + (unsigned)((row0 + ((g) >> 2) * 128 + ((g) & 3) * 16) * 1024 + col0); const int b_ = (g) % NPRE; \
            xv[b_][0][0] = NT_LD((const f32x4*)p_); xv[b_][0][1] = NT_LD((const f32x4*)(p_ + 4)); xv[b_][1][0] = NT_LD((const f32x4*)(p_ + 128)); xv[b_][1][1] = NT_LD((const f32x4*)(p_ + 132)); } while (0)
#pragma unroll
        for (int g = 0; g < NPRE; ++g) WO_LD(g);
        asm volatile("" ::: "memory");
#pragma unroll
        for (int g = 0; g < 8; ++g) { const int ai = g >> 2, m = g & 3, b = g % NPRE;
#pragma unroll
            for (int bj = 0; bj < 2; ++bj) { const f32x4 y0 = xv[b][bj][0] + acc[ai][bj][m][0], y1 = xv[b][bj][1] + acc[ai][bj][m][1]; const unsigned o_ = (unsigned)((row0 + ai * 128 + m * 16) * 1024 + col0 + bj * 128);
                st_wt16(O + o_, pack8(y0, y1)); X1F8_ST((u32x2*)(O8 + o_), pack8_fp8(y0 * 16.f, y1 * 16.f)); }
            asm volatile("" ::: "memory");
            if (g + NPRE < 8) { WO_LD(g + NPRE); asm volatile("" ::: "memory"); } }
#undef WO_LD
#endif
    }
};

#ifndef PP_FP8
#define PP_FP8 0
#endif
struct EpiBf {
    static constexpr bool MID = false, PROF = false, NOPERM = false; static constexpr int MID_T = 0;
    bf16* O; int ldc;
    __device__ __forceinline__ void mid(f32x4 (&)[2][2][4][2], const pg8::Unit&, int, int, int, int) const {}
    __device__ __forceinline__ void operator()(const f32x4 (&acc)[2][2][4][2], const pg8::Unit& u, int wr, int wc, int fr, int fq) const {
        int oz = 0; asm volatile("" : "+v"(oz));
        const int row0 = u.pm * 256 + wr * 64 + fr + oz, col0 = u.pn * 256 + wc * 32 + 8 * fq;
#pragma unroll
        for (int ai = 0; ai < 2; ++ai)
#pragma unroll
            for (int m = 0; m < 4; ++m)
#pragma unroll
                for (int bj = 0; bj < 2; ++bj) {
                    if (PP_FP8) *(u32x2*)((unsigned char*)O + (unsigned)((row0 + ai * 128 + m * 16) * ldc + col0 + bj * 128)) = pack8_fp8(acc[ai][bj][m][0] * 16.f, acc[ai][bj][m][1] * 16.f);
                    else if (PP_IN_P10) st_wt16(O + (unsigned)((row0 + ai * 128 + m * 16) * ldc + col0 + bj * 128), pack8(acc[ai][bj][m][0], acc[ai][bj][m][1]));
                    else MG_ST16(O + (unsigned)((row0 + ai * 128 + m * 16) * ldc + col0 + bj * 128), pack8(acc[ai][bj][m][0], acc[ai][bj][m][1])); }
    }
};

#ifndef MOE_XCD_DEAL
#define MOE_XCD_DEAL 1
#endif
constexpr int MOE_TAB_UNITS = 6;
template <bool GATH> struct MoeOrder {
    static constexpr bool GATHER = GATH, PARTIAL = true, FP8 = true;
    const LAS int* tab; const int* list; int G, c; gu32* qctr; LAS int* slot;
    const LAS int* rowtab;
    __device__ bool next(int i, pg8::Unit& u) const {
        const int R = tab[32];
        long L;
        if (MOE_XCD_DEAL && (G & 7) == 0) { const int per = G >> 3, x = c & 7, j = c >> 3; L = ((long)i * 8 + x) * per + j; } else L = (long)i * G + c;
        if (L >= (long)R * 4) return false;
        const int ent = tab[80 + (int)(L >> 2)], rt = ent & 0xffff, e = ent >> 16, pn = (int)(L & 3);
        u.pm = rt; u.pn = pn; u.e = e; u.lp = (rt - tab[e]) * 256; const int cn = tab[33 + e] - u.lp; u.nrow = cn < 256 ? cn : 256; u.b0 = e * 1024 + pn * 256; u.ord = i; return true;
    }
    __device__ __forceinline__ int arow0(const pg8::Unit& u) const { return u.pm * 256; }
    __device__ __forceinline__ int arow(const pg8::Unit& u, int r) const {
        if (!GATH) return u.pm * 256 + r;
        if (u.ord < MOE_TAB_UNITS) return rowtab[u.ord * 256 + r];
        const int rr = r < u.nrow ? r : u.nrow - 1; return list[u.e * LISTCAP + u.lp + rr] >> 1;
    }
};

#ifndef PROF_EPI
#define PROF_EPI 10
#endif
#ifndef MOE_PRE
#define MOE_PRE 1
#endif
struct EpiGU {
    static constexpr bool MID = false, PROF = (PROF_EPI == 7), NOPERM = false; static constexpr int MID_T = 0;
    bf16* H; const int* list; const float* rstd;
    const LAS float* rstab;
    __device__ __forceinline__ void mid(f32x4 (&)[2][2][4][2], const pg8::Unit&, int, int, int, int) const {}
#if MOE_PRE
    struct Pre { float rsv[8]; };
    __device__ __forceinline__ Pre pre(const pg8::Unit& u, int wr, int wc, int fr, int fq) const { Pre p; const int r0 = wr * 64 + fr;
#pragma unroll
        for (int g = 0; g < 8; ++g) { const int r = (g >> 2) * 128 + (g & 3) * 16 + r0; p.rsv[g] = (u.ord < MOE_TAB_UNITS) ? rstab[u.ord * 256 + r] : rstd[u.e * LISTCAP + u.lp + (r < u.nrow ? r : u.nrow - 1)]; }
        return p; }
    __device__ __forceinline__ void operator()(const f32x4 (&acc)[2][2][4][2], const pg8::Unit& u, int wr, int wc, int fr, int fq, const Pre& pr) const {
        int oz = 0; asm volatile("" : "+v"(oz));
        const int col = u.pn * 128 + 32 * wc + 8 * fq, r0 = wr * 64 + fr + oz;
        float rsv[8];
#pragma unroll
        for (int g = 0; g < 8; ++g) rsv[g] = pr.rsv[g];
#else
    __device__ __forceinline__ void operator()(const f32x4 (&acc)[2][2][4][2], const pg8::Unit& u, int wr, int wc, int fr, int fq) const {
        int oz = 0; asm volatile("" : "+v"(oz));
        const int col = u.pn * 128 + 32 * wc + 8 * fq, r0 = wr * 64 + fr + oz;
        float rsv[8];
#pragma unroll
        for (int g = 0; g < 8; ++g) { const int r = (g >> 2) * 128 + (g & 3) * 16 + r0; rsv[g] = rstd[u.e * LISTCAP + u.lp + (r < u.nrow ? r : u.nrow - 1)]; }
#endif
#pragma unroll
        for (int g = 0; g < 8; ++g) { const int ai = g >> 2, m = g & 3, r = ai * 128 + m * 16 + r0;
            if (r < u.nrow) { const float rs = rsv[g] * (1.f / 512.f); f32x4 o[2];
#pragma unroll
                for (int n = 0; n < 2; ++n)
#pragma unroll
                    for (int j = 0; j < 4; ++j) { const float gt = acc[ai][0][m][n][j] * rs, up = acc[ai][1][m][n][j] * rs; o[n][j] = gt * fsigmoid(gt) * up * 8.f; }
                *(u32x2*)((unsigned char*)H + (unsigned)((u.pm * 256 + r) * 512 + col)) = pack8_fp8(o[0], o[1]); } }
    }
};

struct EpiDown {
    static constexpr bool MID = false, PROF = (PROF_EPI == 8), NOPERM = false; static constexpr int MID_T = 0;
    bf16* Y; const int* list; const float* wt; const LAS int* enttab; const LAS float* wtab;
    __device__ __forceinline__ void mid(f32x4 (&)[2][2][4][2], const pg8::Unit&, int, int, int, int) const {}
#if MOE_PRE
    struct Pre { int ent[8]; float wv[8]; };
    __device__ __forceinline__ Pre pre(const pg8::Unit& u, int wr, int wc, int fr, int fq) const { Pre p; const int r0 = wr * 64 + fr;
#pragma unroll
        for (int g = 0; g < 8; ++g) { const int r = (g >> 2) * 128 + (g & 3) * 16 + r0;
            if (u.ord < MOE_TAB_UNITS) { p.ent[g] = enttab[u.ord * 256 + r]; p.wv[g] = wtab[u.ord * 256 + r]; }
            else { const int li = u.e * LISTCAP + u.lp + (r < u.nrow ? r : u.nrow - 1); p.ent[g] = list[li]; p.wv[g] = wt[li]; } }
        return p; }
    __device__ __forceinline__ void operator()(const f32x4 (&acc)[2][2][4][2], const pg8::Unit& u, int wr, int wc, int fr, int fq, const Pre& pr) const {
        int oz = 0; asm volatile("" : "+v"(oz));
        const int col0 = u.pn * 256 + wc * 32 + 8 * fq, r0 = wr * 64 + fr + oz;
        int ent[8]; float wv[8];
#pragma unroll
        for (int g = 0; g < 8; ++g) { ent[g] = pr.ent[g]; wv[g] = pr.wv[g]; }
#else
    __device__ __forceinline__ void operator()(const f32x4 (&acc)[2][2][4][2], const pg8::Unit& u, int wr, int wc, int fr, int fq) const {
        int oz = 0; asm volatile("" : "+v"(oz));
        const int col0 = u.pn * 256 + wc * 32 + 8 * fq, r0 = wr * 64 + fr + oz;
        int ent[8]; float wv[8];
#pragma unroll
        for (int g = 0; g < 8; ++g) { const int r = (g >> 2) * 128 + (g & 3) * 16 + r0, li = u.e * LISTCAP + u.lp + (r < u.nrow ? r : u.nrow - 1); ent[g] = list[li]; wv[g] = wt[li]; }
#endif
#pragma unroll
        for (int g = 0; g < 8; ++g) { const int ai = g >> 2, m = g & 3, r = ai * 128 + m * 16 + r0;
            if (r < u.nrow) { const float w = wv[g];
#pragma unroll
                for (int bj = 0; bj < 2; ++bj) *(u32x2*)((unsigned char*)Y + (unsigned)(ent[g] * 1024 + col0 + bj * 128)) = pack8_fp8(acc[ai][bj][m][0] * (0.125f * w), acc[ai][bj][m][1] * (0.125f * w)); } }
    }
};

struct EpiPle {
    static constexpr bool MID = false, PROF = (PROF_EPI == 10), NOPERM = true; static constexpr int MID_T = 0;
    float* O; const bf16* X2; const bf16* PP; const float* rstd; const float* bias; float* DUMMY;
    __device__ __forceinline__ void mid(f32x4 (&)[2][2][4][2], const pg8::Unit&, int, int, int, int) const {}
    __device__ __forceinline__ void operator()(const f32x4 (&acc)[2][2][4][2], const pg8::Unit& u, int wr, int wc, int fr, int fq) const {
        int oz = 0; asm volatile("" : "+v"(oz));
        const int row0 = u.pm * 256 + wr * 64 + fr + oz, col0 = u.pn * 256 + wc * 32 + 4 * fq;
        f32x4 bv[2][2];
#pragma unroll
        for (int bj = 0; bj < 2; ++bj)
#pragma unroll
            for (int n = 0; n < 2; ++n) bv[bj][n] = *(const f32x4*)(bias + col0 + bj * 128 + 16 * n);
        float rsv[8];
#pragma unroll
        for (int g = 0; g < 8; ++g) rsv[g] = rstd[row0 + (g >> 2) * 128 + (g & 3) * 16] * (P10_FP8 ? (1.f / 512.f) : 1.f);
#pragma unroll
        for (int bj = 0; bj < 2; ++bj) {
            u32x2 vx[8][2], vp[8][2];
#pragma unroll
            for (int g = 0; g < 8; ++g) { const unsigned o_ = (unsigned)((row0 + (g >> 2) * 128 + (g & 3) * 16) * 1024 + col0 + bj * 128);
                vx[g][0] = *(const u32x2*)(X2 + o_); vx[g][1] = *(const u32x2*)(X2 + o_ + 16); if (PP_IN_P10) { vp[g][0] = *(const u32x2*)(PP + o_); vp[g][1] = *(const u32x2*)(PP + o_ + 16); } else { vp[g][0] = NT_LD((const u32x2*)(PP + o_)); vp[g][1] = NT_LD((const u32x2*)(PP + o_ + 16)); } }
            asm volatile("" ::: "memory");
#pragma unroll
            for (int g = 0; g < 8; ++g) { const int ai = g >> 2, m = g & 3; const float rs = rsv[g];
#pragma unroll
                for (int n = 0; n < 2; ++n) { const unsigned o = (unsigned)((row0 + ai * 128 + m * 16) * 1024 + col0 + bj * 128 + 16 * n);
                    const u32x2 xw = vx[g][n], pw = vp[g][n];
                    const f32x4 x = (f32x4){bf_lo(xw.x), bf_hi(xw.x), bf_lo(xw.y), bf_hi(xw.y)}, p = (f32x4){bf_lo(pw.x), bf_hi(pw.x), bf_lo(pw.y), bf_hi(pw.y)};
                    const f32x4 z = acc[ai][bj][m][n] * rs + bv[bj][n];
                    const f32x4 gt = (f32x4){fsigmoid(z[0]), fsigmoid(z[1]), fsigmoid(z[2]), fsigmoid(z[3])};
                    OUT_ST((f32x4*)(O + o), x + gt * p); }
                asm volatile("" ::: "memory"); }
        }
    }
};

__device__ __forceinline__ float gelu_tanh(float x) { const float u = 0.7978845608028654f * (x + 0.044715f * x * x * x); const float e = __builtin_amdgcn_exp2f(2.f * LOG2E * u); const float th = 1.f - 2.f * __builtin_amdgcn_rcpf(e + 1.f); return 0.5f * x * (1.f + th); }

__device__ __forceinline__ void compress_unit(Frame& F, int unit) {
    const int nt32 = unit & 7, b = (unit >> 3) & 7, g = (unit >> 6) & 1, kv = unit >> 7;
    const int lane = F.lane, wid = F.wave, i16 = lane & 15, kq = lane >> 4;
    const bf16* KVb = (const bf16*)(F.ws + WS_KVB);
    const bf16* W1 = (const bf16*)(F.ws + WS_CW1) + (size_t)kv * 128 * 2048;
    const bf16* W2 = (const bf16*)(F.ws + WS_CW2) + (size_t)kv * 64 * 128;
    const float* c1 = (const float*)(F.ws + WS_C1) + kv * 128;
    LAS float* part = (LAS float*)F.lds;
    LAS bf16* hid = (LAS bf16*)(F.lds + MOE_OFF);
    LAS float* outs = (LAS float*)F.lds;
    int tok[2];
#pragma unroll
    for (int mt = 0; mt < 2; ++mt) { const int n = nt32 * 32 + mt * 16 + i16; tok[mt] = b * SEQ + (n < 255 ? n : 254) * 16; }
    f32x4 acc[2][8];
#pragma unroll
    for (int mt = 0; mt < 2; ++mt)
#pragma unroll
        for (int j = 0; j < 8; ++j) acc[mt][j] = (f32x4){0.f, 0.f, 0.f, 0.f};
#pragma unroll
    for (int ll = 0; ll < 4; ++ll) { const int l = wid * 4 + ll;
        bf16x8 a0[2], a1[2], w[2][8];
#pragma unroll
        for (int s = 0; s < 2; ++s) {
            a0[s] = *(const bf16x8*)(KVb + (size_t)(tok[0] + l) * 768 + kv * 128 + g * 64 + kq * 16 + s * 8);
            a1[s] = *(const bf16x8*)(KVb + (size_t)(tok[1] + l) * 768 + kv * 128 + g * 64 + kq * 16 + s * 8); }
#pragma unroll
        for (int j = 0; j < 8; ++j)
#pragma unroll
            for (int s = 0; s < 2; ++s) w[s][j] = *(const bf16x8*)(W1 + (size_t)(j * 16 + i16) * 2048 + l * 64 + kq * 16 + s * 8);
#pragma unroll
        for (int s = 0; s < 2; ++s)
#pragma unroll
            for (int j = 0; j < 8; ++j) {
                acc[0][j] = __builtin_amdgcn_mfma_f32_16x16x32_bf16(a0[s], w[s][j], acc[0][j], 0, 0, 0);
                acc[1][j] = __builtin_amdgcn_mfma_f32_16x16x32_bf16(a1[s], w[s][j], acc[1][j], 0, 0, 0); } }
#pragma unroll
    for (int mt = 0; mt < 2; ++mt)
#pragma unroll
        for (int j = 0; j < 8; ++j)
#pragma unroll
            for (int r = 0; r < 4; ++r) part[(wid * 32 + mt * 16 + kq * 4 + r) * 128 + j * 16 + i16] = acc[mt][j][r];
    __syncthreads();
    { const int tid = F.tid;
#pragma unroll
      for (int q = 0; q < 8; ++q) { const int idx = tid + 512 * q, row = idx >> 7, col = idx & 127; float s = c1[col];
#pragma unroll
          for (int w = 0; w < 8; ++w) s += part[(w * 32 + row) * 128 + col];
          hid[row * 136 + col] = (bf16)(cvt_pk_bf16(gelu_tanh(s), 0.f) & 0xffffu); } }
    __syncthreads();
    { const int mt = wid >> 2, nq = wid & 3; f32x4 o = (f32x4){0.f, 0.f, 0.f, 0.f};
#pragma unroll
        for (int s = 0; s < 4; ++s) { const bf16x8 a = *(const LAS bf16x8*)(hid + (mt * 16 + i16) * 136 + s * 32 + kq * 8);
            const bf16x8 w = *(const bf16x8*)(W2 + (size_t)(nq * 16 + i16) * 128 + s * 32 + kq * 8);
            o = __builtin_amdgcn_mfma_f32_16x16x32_bf16(a, w, o, 0, 0, 0); }
#pragma unroll
        for (int r = 0; r < 4; ++r) outs[(mt * 16 + kq * 4 + r) * 64 + nq * 16 + i16] = o[r]; }
    __syncthreads();
#pragma unroll
    for (int h = 0; h < 2; ++h) { const int tid = F.tid, row = h * 16 + (tid >> 5), c = tid & 31; const float v0 = outs[row * 64 + c], v1 = outs[row * 64 + 32 + c];
      float rs = 1.f, g0 = 1.f, g1 = 1.f;
      if (kv == 0) { float s = v0 * v0 + v1 * v1;
#pragma unroll
          for (int o = 1; o < 32; o <<= 1) s += __shfl_xor(s, o);
          rs = 1.0f / sqrtf(s * (1.f / 64.f) + EPS); g0 = F.inp(5)[c]; g1 = F.inp(5)[32 + c]; }
      const int nn = nt32 * 32 + row; const bool real = nn < 255;
      bf16* dst = (bf16*)(F.ws + (kv ? WS_VC : WS_KC)) + ((size_t)(b * 2 + g) * 256 + nn) * 64;
      dst[c] = real ? (bf16)(cvt_pk_bf16(v0 * rs * g0, 0.f) & 0xffffu) : (bf16)0;
      dst[32 + c] = real ? (bf16)(cvt_pk_bf16(v1 * rs * g1, 0.f) & 0xffffu) : (bf16)0; }
    __syncthreads();
}

struct ConvW { f32x2 cw[31]; f32x2 cb; };
__device__ __forceinline__ void conv_weights(Frame& F, ConvW& w) { int t_ = F.tid; asm volatile("" : "+v"(t_)); const int cp_ = t_ & 255;
#pragma unroll
    for (int j = 0; j < 31; ++j) w.cw[j] = *(const f32x2*)(F.inp(10) + j * 512 + cp_ * 2);
    w.cb = *(const f32x2*)(F.inp(11) + cp_ * 2); }
struct ConvIn { u32x4 v[8]; };
__device__ __forceinline__ void conv_load(Frame& F, int unit, ConvIn& R) {
    const int t0 = unit * 32, s0 = t0 & (SEQ - 1); const bf16* GLU = (const bf16*)(F.ws + WS_GLU); int t_ = F.tid; asm volatile("" : "+v"(t_));
#pragma unroll
    for (int k = 0; k < 8; ++k) { const int i = t_ + 512 * k, r = i >> 6, c = i & 63;
        R.v[k] = (u32x4){0u, 0u, 0u, 0u}; if (i < 62 * 64 && s0 - 30 + r >= 0) R.v[k] = *(const u32x4*)(GLU + (size_t)(t0 - 30 + r) * 512 + c * 8); }
}
__device__ __forceinline__ void lds_bar() { asm volatile("s_waitcnt lgkmcnt(0)" ::: "memory"); __builtin_amdgcn_s_barrier(); asm volatile("" ::: "memory"); }
__device__ __forceinline__ void conv_unit(Frame& F, int unit, int unext, ConvIn& R, const ConvW& W) {
    const int tid = F.tid, lane = F.lane, wid = F.wave;
    const f32x2 (&cw)[31] = W.cw; const f32x2 cb = W.cb;
    const int t0 = unit * 32;
    LAS unsigned* tin = (LAS unsigned*)F.lds;
    LAS float* tout = (LAS float*)(F.lds + 65536);
#pragma unroll
    for (int k = 0; k < 8; ++k) { const int i = tid + 512 * k, r = i >> 6, c = i & 63; if (i < 62 * 64) *(LAS u32x4*)(tin + r * 256 + c * 4) = R.v[k]; }
    lds_bar();
    { const int cp = tid & 255, th = tid >> 8;
      f32x2 xin[46];
#pragma unroll
      for (int r = 0; r < 46; ++r) { const unsigned w = tin[(th * 16 + r) * 256 + cp]; xin[r] = (f32x2){bf_lo(w), bf_hi(w)}; }
#pragma unroll
      for (int tt = 0; tt < 16; ++tt) { f32x2 a = cb;
#pragma unroll
          for (int j = 0; j < 31; ++j) a += cw[j] * xin[tt + j];
          *(LAS f32x2*)(tout + (th * 16 + tt) * 512 + cp * 2) = a; } }
    lds_bar();
    if (unext >= 0) conv_load(F, unext, R);
    { const f32x4 lg0 = *(const f32x4*)(F.inp(12) + lane * 8), lg1 = *(const f32x4*)(F.inp(12) + lane * 8 + 4), lb0 = *(const f32x4*)(F.inp(13) + lane * 8), lb1 = *(const f32x4*)(F.inp(13) + lane * 8 + 4);
      f32x4 v0[4], v1[4]; float sm[4], sq[4];
#pragma unroll
      for (int q = 0; q < 4; ++q) { const int tl = wid * 4 + q; v0[q] = *(const LAS f32x4*)(tout + tl * 512 + lane * 8); v1[q] = *(const LAS f32x4*)(tout + tl * 512 + lane * 8 + 4);
          sm[q] = (v0[q][0] + v0[q][1]) + (v0[q][2] + v0[q][3]) + (v1[q][0] + v1[q][1]) + (v1[q][2] + v1[q][3]); }
#pragma unroll
      for (int o = 1; o < 64; o <<= 1) {
#pragma unroll
          for (int q = 0; q < 4; ++q) sm[q] += __shfl_xor(sm[q], o); }
#pragma unroll
      for (int q = 0; q < 4; ++q) { const float mu = sm[q] * (1.f / 512.f); v0[q] = v0[q] - mu; v1[q] = v1[q] - mu;
          sq[q] = (v0[q][0] * v0[q][0] + v0[q][1] * v0[q][1]) + (v0[q][2] * v0[q][2] + v0[q][3] * v0[q][3]) + (v1[q][0] * v1[q][0] + v1[q][1] * v1[q][1]) + (v1[q][2] * v1[q][2] + v1[q][3] * v1[q][3]); }
#pragma unroll
      for (int o = 1; o < 64; o <<= 1) {
#pragma unroll
          for (int q = 0; q < 4; ++q) sq[q] += __shfl_xor(sq[q], o); }
#pragma unroll
      for (int q = 0; q < 4; ++q) { const int tl = wid * 4 + q; const float rs = 1.0f / sqrtf(sq[q] * (1.f / 512.f) + EPS);
          f32x4 y0 = v0[q] * rs * lg0 + lb0, y1 = v1[q] * rs * lg1 + lb1;
#pragma unroll
          for (int j = 0; j < 4; ++j) { y0[j] *= fsigmoid(y0[j]); y1[j] *= fsigmoid(y1[j]); }
          st_wt16((bf16*)(F.ws + WS_AC) + (size_t)(t0 + tl) * 1024 + 512 + lane * 8, pack8(y0, y1)); } }
    lds_bar();
}

__device__ __forceinline__ void p2_phase(Frame& F) {
    for (int u = F.vcu; u < 256; u += F.G) compress_unit(F, u);
}

namespace att {
#ifndef REPS_SEL
#define REPS_SEL 1
#endif
#ifndef REPS_WIN
#define REPS_WIN 1
#endif
#if defined(ABL)
#define ABLF(k) (ABL == (k) ? 0.f : 1.f) *
#else
#define ABLF(k)
#endif
constexpr int L_K = 0, L_V = 24576, L_WS = 57344, L_SEL = L_WS + 2048, L_WU = L_SEL + 512, L_Q = L_WU + 64, L_OST = 61440, L_IMP = L_OST;
static_assert(L_Q + 16 <= L_OST && L_OST + 65536 <= RING_BYTES && 64 * 65 * 4 <= 65536, "attention LDS map");
__device__ __forceinline__ int crow(int r, int hi) { return (r & 3) + 8 * (r >> 2) + 4 * hi; }

template <bool NEEDV> __device__ __forceinline__ void dma_tile(LAS unsigned char* lds, int slot, const bf16* Kb, const bf16* Vb, int pitch, int key0, int wid, int lane) {
    __builtin_amdgcn_global_load_lds((const unsigned*)((Kb + key0 * pitch) + (unsigned)(lane * pitch + wid * 8)), (LAS unsigned*)(lds + L_K + slot * 8192 + wid * 1024), 16, 0, 0);
    if (NEEDV) __builtin_amdgcn_global_load_lds((const unsigned*)((Vb + key0 * pitch) + (unsigned)((16 * (wid & 3) + (lane >> 2)) * pitch + (wid >> 2) * 32 + (lane & 3) * 8)), (LAS unsigned*)(lds + L_V + slot * 8192 + wid * 1024), 16, 0, 0);
}
template <int KEEP> __device__ __forceinline__ void wait_bar() {
    if (KEEP == 2) asm volatile("s_waitcnt vmcnt(2) lgkmcnt(0)" ::: "memory");
    else if (KEEP == 1) asm volatile("s_waitcnt vmcnt(1) lgkmcnt(0)" ::: "memory");
    else asm volatile("s_waitcnt vmcnt(0) lgkmcnt(0)" ::: "memory");
    __builtin_amdgcn_s_barrier();
    asm volatile("" ::: "memory");
}
__device__ __forceinline__ void dma_k(LAS unsigned char* lds, int slot, const bf16* Kb, int pitch, int key0, int wid, int lane) {
    __builtin_amdgcn_global_load_lds((const unsigned*)(Kb + (unsigned)((key0 + lane) * pitch + wid * 8)), (LAS unsigned*)(lds + L_K + slot * 8192 + wid * 1024), 16, 0, 0);
}
__device__ __forceinline__ void dma_v(LAS unsigned char* lds, int slot, const bf16* Vb, int pitch, int key0, int wid, int lane) {
    __builtin_amdgcn_global_load_lds((const unsigned*)(Vb + (unsigned)((key0 + 16 * (wid & 3) + (lane >> 2)) * pitch + (wid >> 2) * 32 + (lane & 3) * 8)), (LAS unsigned*)(lds + L_V + slot * 8192 + wid * 1024), 16, 0, 0);
}
__device__ __forceinline__ void wait_bar_n(int keep) {
    if (keep >= 4) asm volatile("s_waitcnt vmcnt(4) lgkmcnt(0)" ::: "memory");
    else if (keep == 3) asm volatile("s_waitcnt vmcnt(3) lgkmcnt(0)" ::: "memory");
    else if (keep == 2) asm volatile("s_waitcnt vmcnt(2) lgkmcnt(0)" ::: "memory");
    else if (keep == 1) asm volatile("s_waitcnt vmcnt(1) lgkmcnt(0)" ::: "memory");
    else asm volatile("s_waitcnt vmcnt(0) lgkmcnt(0)" ::: "memory");
    __builtin_amdgcn_s_barrier();
    asm volatile("" ::: "memory");
}
__device__ __forceinline__ void qk_tile(f32x16& p0, f32x16& p1, const LAS unsigned char* Ks, const bf16x8 (&qr)[4], const f32x16& c0, const f32x16& c1, int r32, int hi) {
    const LAS unsigned char* kb = Ks + hi * 1024 + r32 * 16;
#pragma unroll
    for (int d0 = 0; d0 < 4; ++d0) {
        const bf16x8 b0 = *(const LAS bf16x8*)(kb + d0 * 2048), b1 = *(const LAS bf16x8*)(kb + d0 * 2048 + 512);
        if (d0 == 0) { p0 = __builtin_amdgcn_mfma_f32_32x32x16_bf16(b0, qr[0], c0, 0, 0, 0); p1 = __builtin_amdgcn_mfma_f32_32x32x16_bf16(b1, qr[0], c1, 0, 0, 0); }
        else { p0 = __builtin_amdgcn_mfma_f32_32x32x16_bf16(b0, qr[d0], p0, 0, 0, 0); p1 = __builtin_amdgcn_mfma_f32_32x32x16_bf16(b1, qr[d0], p1, 0, 0, 0); } }
}
__device__ __forceinline__ void qk_half_ext(f32x16& p, const LAS unsigned char* Ks, int half, const bf16x8 (&qr)[4], const bf16x8 qext, const bf16x8 ae, int r32, int hi) {
    const LAS unsigned char* kb = Ks + hi * 1024 + r32 * 16 + half * 512;
    const f32x16 z = (f32x16){0.f};
    p = __builtin_amdgcn_mfma_f32_32x32x16_bf16(ae, qext, z, 0, 0, 0);
#pragma unroll
    for (int d0 = 0; d0 < 4; ++d0) { const bf16x8 b0 = *(const LAS bf16x8*)(kb + d0 * 2048); p = __builtin_amdgcn_mfma_f32_32x32x16_bf16(b0, qr[d0], p, 0, 0, 0); }
}
__device__ __forceinline__ void ref_words(float mhat, int hi, unsigned& w2, unsigned& w3) {
    const float x = -mhat; const unsigned a = cvt_pk_bf16(x, 0.f) & 0xffffu; const float r1 = x - __uint_as_float(a << 16);
    const unsigned bb = cvt_pk_bf16(r1, 0.f) & 0xffffu; const float r2 = r1 - __uint_as_float(bb << 16); const unsigned c = cvt_pk_bf16(r2, 0.f) & 0xffffu;
    w2 = hi ? 0u : (a | (bb << 16)); w3 = hi ? 0u : c;
}
__device__ __forceinline__ float max3f(float a, float b, float c) { return fmaxf(fmaxf(a, b), c); }
__device__ __forceinline__ float rowmax32(const f32x16& p0, const f32x16& p1) {
    float a = max3f(p0[0], p0[1], p1[0]), b = max3f(p0[2], p0[3], p1[1]); a = max3f(a, p1[2], p1[3]);
#pragma unroll
    for (int r = 4; r < 16; r += 4) { a = max3f(a, p0[r], p0[r + 1]); b = max3f(b, p0[r + 2], p0[r + 3]); a = max3f(a, p1[r], p1[r + 1]); b = max3f(b, p1[r + 2], p1[r + 3]); }
    const float m = fmaxf(a, b);
    return fmaxf(m, __shfl_xor(m, 32));
}
__device__ __forceinline__ s16x4 vtr(unsigned addr) { s16x4 r; asm volatile("ds_read_b64_tr_b16 %0, %1" : "=v"(r) : "v"(addr) : "memory"); return r; }
__device__ __forceinline__ float rowmax16(const f32x16& p) {
    float a = max3f(p[0], p[1], p[2]), bq = max3f(p[3], p[4], p[5]);
    a = max3f(a, p[6], p[7]); bq = max3f(bq, p[8], p[9]); a = max3f(a, p[10], p[11]); bq = max3f(bq, p[12], p[13]); a = max3f(a, p[14], p[15]);
    const float m = fmaxf(a, bq);
    return fmaxf(m, __shfl_xor(m, 32));
}
template <bool FIRST>
__device__ __forceinline__ void softmax_half(f32x16& p, f32x16& nx, bool hasn, float& mhat, unsigned& rw2, unsigned& rw3, float& l, f32x16 (&o)[2], LAS float* wsf, int r32, int hi) {
    constexpr float THR = 8.f;
    const float rm = rowmax16(p);
    if (FIRST || __any(rm > THR)) {
        float dl = FIRST ? rm : ((rm > THR) ? rm : 0.f);
        if (dl == -INFINITY) dl = 0.f;
        mhat += dl;
#pragma unroll
        for (int r = 0; r < 16; ++r) p[r] -= dl;
        ref_words(mhat, hi, rw2, rw3);
        if (hasn) {
#pragma unroll
            for (int r = 0; r < 16; ++r) nx[r] -= dl; }
        if (!FIRST) {
            const float f = __builtin_amdgcn_exp2f(-dl); l *= f;
            if (hi == 0) wsf[r32] = f;
            LDS_WAIT();
#pragma unroll
            for (int a = 0; a < 4; ++a) { const f32x4 fv = *(const LAS f32x4*)(wsf + 8 * a + 4 * hi);
#pragma unroll
                for (int j = 0; j < 4; ++j) { o[0][4 * a + j] *= fv[j]; o[1][4 * a + j] *= fv[j]; } }
            LDS_WAIT();
        }
    }
    float s = 0.f;
#pragma unroll
    for (int r = 0; r < 16; ++r) { p[r] = __builtin_amdgcn_exp2f(p[r]); s += p[r]; }
    l += s;
}
__device__ __forceinline__ void pv_half(f32x16 (&o)[2], unsigned vbase, int half, const f32x16& p) {
#pragma unroll
    for (int k2 = 0; k2 < 2; ++k2) { const int ks = 2 * half + k2;
        s16x4 lo[2], hi[2];
#pragma unroll
        for (int d0 = 0; d0 < 2; ++d0) { lo[d0] = vtr(vbase + d0 * 4096 + ks * 1024); hi[d0] = vtr(vbase + d0 * 4096 + ks * 1024 + 512); }
        const int bb = k2 * 8;
        u32x4 w; w.x = cvt_pk_bf16(p[bb + 0], p[bb + 1]); w.y = cvt_pk_bf16(p[bb + 2], p[bb + 3]); w.z = cvt_pk_bf16(p[bb + 4], p[bb + 5]); w.w = cvt_pk_bf16(p[bb + 6], p[bb + 7]);
        const bf16x8 pa = __builtin_bit_cast(bf16x8, w);
        asm volatile("s_waitcnt lgkmcnt(0)" : "+v"(lo[0]), "+v"(lo[1]), "+v"(hi[0]), "+v"(hi[1]) :: "memory");
        __builtin_amdgcn_sched_barrier(0);
#pragma unroll
        for (int d0 = 0; d0 < 2; ++d0) { const bf16x8 vf = (bf16x8){lo[d0][0], lo[d0][1], lo[d0][2], lo[d0][3], hi[d0][0], hi[d0][1], hi[d0][2], hi[d0][3]};
            o[d0] = __builtin_amdgcn_mfma_f32_32x32x16_bf16(pa, vf, o[d0], 0, 0, 0); }
    }
}
template <int MT> __device__ __forceinline__ void mask_half(f32x16& p, int lim, int off) {
#pragma unroll
    for (int r = 0; r < 16; ++r) { const int c = (r & 3) + 8 * (r >> 2) + off;
        if (MT == 2) { if (!(c > lim)) p[r] = -INFINITY; } else { if (!(c <= lim)) p[r] = -INFINITY; } }
}
template <int MT> __device__ __forceinline__ void mask_tile(f32x16& p0, f32x16& p1, int lim) {
    if (MT == 0) return;
#pragma unroll
    for (int r = 0; r < 16; ++r) { const int c = (r & 3) + 8 * (r >> 2);
        if (MT == 2) { if (!(c > lim)) p0[r] = -INFINITY; if (!(c + 32 > lim)) p1[r] = -INFINITY; }
        else { if (!(c <= lim)) p0[r] = -INFINITY; if (!(c + 32 <= lim)) p1[r] = -INFINITY; } }
}
__device__ __forceinline__ void pv_tile(f32x16 (&o)[2], unsigned vbase, const f32x16& p0, const f32x16& p1) {
#pragma unroll
    for (int ks = 0; ks < 4; ++ks) {
        s16x4 lo[2], hi[2];
#pragma unroll
        for (int d0 = 0; d0 < 2; ++d0) { lo[d0] = vtr(vbase + d0 * 4096 + ks * 1024); hi[d0] = vtr(vbase + d0 * 4096 + ks * 1024 + 512); }
        const f32x16& P = (ks < 2) ? p0 : p1; const int b = (ks & 1) * 8;
        u32x4 w; w.x = cvt_pk_bf16(P[b + 0], P[b + 1]); w.y = cvt_pk_bf16(P[b + 2], P[b + 3]); w.z = cvt_pk_bf16(P[b + 4], P[b + 5]); w.w = cvt_pk_bf16(P[b + 6], P[b + 7]);
        const bf16x8 pa = __builtin_bit_cast(bf16x8, w);
        asm volatile("s_waitcnt lgkmcnt(0)" : "+v"(lo[0]), "+v"(lo[1]), "+v"(hi[0]), "+v"(hi[1]) :: "memory");
        __builtin_amdgcn_sched_barrier(0);
#pragma unroll
        for (int d0 = 0; d0 < 2; ++d0) { const bf16x8 vf = (bf16x8){lo[d0][0], lo[d0][1], lo[d0][2], lo[d0][3], hi[d0][0], hi[d0][1], hi[d0][2], hi[d0][3]};
            o[d0] = __builtin_amdgcn_mfma_f32_32x32x16_bf16(pa, vf, o[d0], 0, 0, 0); }
    }
}
__device__ __forceinline__ float max32(const f32x16& p0, const f32x16& p1) {
    float a = fmaxf(p0[0], p1[0]);
#pragma unroll
    for (int r = 1; r < 16; ++r) a = fmaxf(a, fmaxf(p0[r], p1[r]));
    return fmaxf(a, __shfl_xor(a, 32));
}
__device__ __forceinline__ void softmax_step(f32x16& p0, f32x16& p1, float sk, bool lv, float& m, float& l, f32x16 (&o)[2], LAS float* wsf, int r32, int hi) {
    const float rm = max32(p0, p1);
    const float rmt = lv ? rm + sk : -INFINITY;
    const float mn = fmaxf(m, rmt);
    const float mup = (mn == -INFINITY || !lv) ? INFINITY : mn - sk;
    const float f = (mn == -INFINITY) ? 1.f : __builtin_amdgcn_exp2f(m - mn);
    float s = 0.f;
#pragma unroll
    for (int r = 0; r < 16; ++r) { p0[r] = __builtin_amdgcn_exp2f(p0[r] - mup); p1[r] = __builtin_amdgcn_exp2f(p1[r] - mup); s += p0[r] + p1[r]; }
    l = l * f + s;
    if (__any(mn != m)) {
        if (hi == 0) wsf[r32] = f;
        LDS_WAIT();
#pragma unroll
        for (int a = 0; a < 4; ++a) { const f32x4 fv = *(const LAS f32x4*)(wsf + 8 * a + 4 * hi);
#pragma unroll
            for (int j = 0; j < 4; ++j) { o[0][4 * a + j] *= fv[j]; o[1][4 * a + j] *= fv[j]; } }
        LDS_WAIT();
    }
    m = mn;
}
template <bool FIRST>
__device__ __forceinline__ void accum_out(LAS float* stg, const f32x16 (&o)[2], float scale, LAS float* wsf, int r32, int hi) {
    if (hi == 0) wsf[r32] = scale;
    LDS_WAIT();
#pragma unroll
    for (int a = 0; a < 4; ++a) { const f32x4 fv = *(const LAS f32x4*)(wsf + 8 * a + 4 * hi);
#pragma unroll
        for (int j = 0; j < 4; ++j) { LAS float* p = stg + (j + 8 * a + 4 * hi) * 64 + r32;
            float v0 = o[0][4 * a + j] * fv[j], v1 = o[1][4 * a + j] * fv[j];
            if (!FIRST) { v0 += p[0]; v1 += p[32]; }
            p[0] = v0; p[32] = v1; } }
    LDS_WAIT();
}

#ifdef PROF_MODE
#define PROF_T0() const unsigned long long pt0_ = __builtin_amdgcn_s_memrealtime()
#define PROF_ACC() do { if (threadIdx.x == 0) { LAS unsigned* pa_ = (LAS unsigned*)(lds + MISC_OFF + 64); pa_[0] += (unsigned)(__builtin_amdgcn_s_memrealtime() - pt0_); } } while (0)
#else
#define PROF_T0() do {} while (0)
#define PROF_ACC() do {} while (0)
#endif
template <bool SEL>
__device__ __forceinline__ void att_branch(LAS unsigned char* lds, const bf16* Kb, const bf16* Vb, unsigned long long blocks, unsigned long long mysel, int qt, int t0, int ql,
                                           const bf16x8 (&qr)[4], unsigned spk, unsigned wpk0, unsigned wpk1, float& l, f32x16 (&o)[2], int wid, int lane_) {
    int lane = lane_; asm volatile("" : "+v"(lane));
    const int r32 = lane & 31, hi = lane >> 5;
    LAS float* wsf = (LAS float*)(lds + L_WS) + wid * 64;
    const unsigned vb0 = (unsigned)(uintptr_t)(lds + L_V) + ((lane >> 4) & 1) * 32 + (lane & 3) * 8 + (4 * hi + ((lane & 15) >> 2)) * 64;
#if defined(PROF_MODE) && PROF_MODE == 2
    PROF_T0();
#endif
    const int n = SEL ? __builtin_popcountll(blocks) : (qt < 8 ? qt + 1 : 9);
    unsigned long long rem = blocks; int wnext = qt, issued = 0;
    auto pop = [&]() -> int { if (issued >= n) return -1; ++issued; if (SEL) { const int j = 63 - __builtin_clzll(rem); rem &= ~(1ull << j); return j; } else return wnext--; };
    auto mineof = [&](int j) -> bool { return SEL ? (bool)((mysel >> j) & 1ull) : true; };
    int j0 = pop(), j1 = pop(), j2 = pop();
    dma_k(lds, 0, Kb, 768, j0 * 64, wid, lane); dma_v(lds, 0, Vb, 768, j0 * 64, wid, lane);
    if (j1 >= 0) { dma_k(lds, 1, Kb, 768, j1 * 64, wid, lane); dma_v(lds, 1, Vb, 768, j1 * 64, wid, lane); }
    if (j2 >= 0) { dma_k(lds, 2, Kb, 768, j2 * 64, wid, lane); dma_v(lds, 2, Vb, 768, j2 * 64, wid, lane); }
    float mhat = 0.f; unsigned rw2 = 0u, rw3 = 0u; l = 0.f; o[0] = (f32x16){0.f}; o[1] = (f32x16){0.f};
    f32x16 h0, h1;
    const unsigned one2 = hi ? 0u : 0x3f803f80u, one1 = hi ? 0u : 0x00003f80u;
#define ATT_QKH(P, j_, ks_, half_) do { const float Pf_ = (float)((j_) * 64 - t0); const unsigned ppk_ = hi ? 0u : cvt_pk_bf16(Pf_, Pf_); \
        qk_half_ext(P, lds + L_K + (ks_) * 8192, half_, qr, __builtin_bit_cast(bf16x8, (u32x4){spk, spk, rw2, rw3}), __builtin_bit_cast(bf16x8, (u32x4){ppk_, (half_) ? wpk1 : wpk0, one2, one1}), r32, hi); } while (0)
#define ATT_MASK(P, j_, m_, off_) do { \
        if ((j_) == qt || (!SEL && (j_) == qt - 8)) { int lm_ = ql - 4 * hi; asm volatile("" : "+v"(lm_));     \
            if ((j_) == qt) mask_half<1>(P, lm_, off_); else mask_half<2>(P, lm_, off_); } \
        if (SEL && !__all(m_)) { _Pragma("unroll") for (int r = 0; r < 16; ++r) P[r] = (m_) ? P[r] : -INFINITY; } } while (0)
    wait_bar_n((j1 >= 0 ? 2 : 0) + (j2 >= 0 ? 2 : 0));
    ATT_QKH(h0, j0, 0, 0);
    int ks = 0, vs = 0; bool first = true;
    while (j0 >= 0) {
        const bool m0 = mineof(j0); const bool do0 = !SEL || __any(m0);
        if (do0) { ATT_QKH(h1, j0, ks, 1); __builtin_amdgcn_sched_barrier(0);
            ATT_MASK(h0, j0, m0, 0);
            if (first) softmax_half<true>(h0, h1, true, mhat, rw2, rw3, l, o, wsf, r32, hi); else softmax_half<false>(h0, h1, true, mhat, rw2, rw3, l, o, wsf, r32, hi);
            pv_half(o, vb0 + vs * 8192, 0, h0); }
#if defined(PROF_MODE) && PROF_MODE == 1
        { PROF_T0(); wait_bar_n((j2 >= 0 ? 2 : 0)); PROF_ACC(); }
#else
        wait_bar_n((j2 >= 0 ? 2 : 0));
#endif
        const int j3 = pop();
        if (j3 >= 0) { dma_k(lds, ks, Kb, 768, j3 * 64, wid, lane); dma_v(lds, (vs + 3) & 3, Vb, 768, j3 * 64, wid, lane); }
        bool m1 = false, do1 = false; if (j1 >= 0) { m1 = mineof(j1); do1 = !SEL || __any(m1); }
        const int ks1 = (ks == 2) ? 0 : ks + 1;
        if (do1) ATT_QKH(h0, j1, ks1, 0);
        __builtin_amdgcn_sched_barrier(0);
        if (do0) { ATT_MASK(h1, j0, m0, 32);
            softmax_half<false>(h1, h0, do1, mhat, rw2, rw3, l, o, wsf, r32, hi);
            pv_half(o, vb0 + vs * 8192, 1, h1); }
        j0 = j1; j1 = j2; j2 = j3; ks = ks1; vs = (vs + 1) & 3; first = false;
    }
#undef ATT_QKH
#undef ATT_MASK
    l += __shfl_xor(l, 32);
    wait_bar<0>();
#if defined(PROF_MODE) && PROF_MODE == 2
    PROF_ACC();
#endif
}

__device__ __forceinline__ void attn_unit(Frame& F, int b, int g, int qt, int lu) {
    LAS unsigned char* lds = F.lds;
    const int tid = F.tid, lane = F.lane, wid = F.wave, r32 = lane & 31, hi = lane >> 5, hr = wid >> 1, qh = wid & 1;
    const int head = g * 4 + hr, t0 = qt * 64, ql = qh * 32 + r32, tq = t0 + ql;
    const float slope2 = __builtin_amdgcn_exp2f(-(float)(head + 1)) * LOG2E;
    const size_t rowq = (size_t)b * SEQ + tq;
    const bf16* Qb = (const bf16*)(F.ws + WS_QB);
    const bf16* KVb = (const bf16*)(F.ws + WS_KVB) + (size_t)b * SEQ * 768;
    const bf16* KC = (const bf16*)(F.ws + WS_KC) + (size_t)(b * 2 + g) * 256 * 64;
    const bf16* VC = (const bf16*)(F.ws + WS_VC) + (size_t)(b * 2 + g) * 256 * 64;
    const float* NG = (const float*)(F.ws + WS_NG) + rowq * 32 + g * 12 + hr * 3;
    LAS float* wsf = (LAS float*)(lds + L_WS) + wid * 64;
    LAS unsigned* imp = (LAS unsigned*)(lds + L_IMP);
    LAS unsigned long long* sel = (LAS unsigned long long*)(lds + L_SEL);
    LAS unsigned long long* wun = (LAS unsigned long long*)(lds + L_WU);
    const unsigned vb0 = (unsigned)(uintptr_t)(lds + L_V) + ((lane >> 4) & 1) * 32 + (lane & 3) * 8 + (4 * hi + ((lane & 15) >> 2)) * 64;
    bf16x8 qr[4];
#pragma unroll
    for (int d0 = 0; d0 < 4; ++d0) qr[d0] = *(const bf16x8*)(Qb + rowq * 512 + head * 64 + d0 * 16 + hi * 8);
    LAS float* stg = (LAS float*)(lds + L_OST) + wid * 2048;
    const float gate_c = NG[0], gate_s = NG[1], gate_w = NG[2];
    f32x16 o[2], p0, p1;
    const bool need_imp = qt >= 8;
    const int ntc = min(4, (4 * qt + 2) / 64 + 1);
    const int nmax = (tq >= 31) ? ((tq - 31) >> 4) : -1;
#if defined(PROF_MODE) && (PROF_MODE == 3 || PROF_MODE == 5)
    PROF_T0();
#endif
    unsigned spk, wpk0, wpk1;
    { const unsigned sh = cvt_pk_bf16(slope2, 0.f) & 0xffffu; const float shf = __uint_as_float(sh << 16); spk = hi ? 0u : (sh | (cvt_pk_bf16(0.f, slope2 - shf) & 0xffff0000u));
      wpk0 = hi ? 0u : cvt_pk_bf16((float)r32, (float)r32); wpk1 = hi ? 0u : cvt_pk_bf16((float)(r32 + 32), (float)(r32 + 32)); }
    const unsigned wc0 = hi ? 0u : cvt_pk_bf16((float)(16 * r32), (float)(16 * r32)), wc1 = hi ? 0u : cvt_pk_bf16((float)(16 * r32 + 512), (float)(16 * r32 + 512));
    const unsigned cone2 = hi ? 0u : 0x3f803f80u, cone1 = hi ? 0u : 0x00003f80u;
    float l = 0.f, mhat = 0.f;
    o[0] = (f32x16){0.f}; o[1] = (f32x16){0.f};
    float gacc[4][8], lacc[4][8];
    dma_tile<true>(lds, 0, KC, VC, 64, 0, wid, lane);
    if (ntc > 1) dma_tile<true>(lds, 1, KC, VC, 64, 64, wid, lane);
    for (int i = tid; i < 64 * 65; i += 512) imp[i] = 0u;
#pragma unroll
    for (int it = 0; it < 4; ++it) {
        if (it < ntc) {
            const int sl = (it == 3) ? 0 : it;
            if (it + 1 < ntc) wait_bar<2>(); else wait_bar<0>();
            if (it + 2 < ntc) dma_tile<true>(lds, (it + 2 == 3) ? 0 : it + 2, KC, VC, 64, (it + 2) * 64, wid, lane);
            { const float Pf = (float)(1024 * it - t0); const unsigned ppk = hi ? 0u : cvt_pk_bf16(Pf, Pf);
              const bf16x8 qx = __builtin_bit_cast(bf16x8, (u32x4){spk, spk, 0u, 0u});
              qk_half_ext(p0, lds + L_K + sl * 8192, 0, qr, qx, __builtin_bit_cast(bf16x8, (u32x4){ppk, wc0, cone2, cone1}), r32, hi);
              qk_half_ext(p1, lds + L_K + sl * 8192, 1, qr, qx, __builtin_bit_cast(bf16x8, (u32x4){ppk, wc1, cone2, cone1}), r32, hi); }
            if (64 * it + 63 > 4 * qt - 2) mask_tile<3>(p0, p1, nmax - 64 * it - 4 * hi);
            const float sk = 0.f;
            const float rm = max32(p0, p1) + sk;
            if (it == 0) mhat = (rm == -INFINITY) ? 0.f : rm;
            else if (__any(rm > mhat + 8.f)) {
                const float dl = (rm > mhat + 8.f) ? rm - mhat : 0.f; mhat += dl;
                const float f = __builtin_amdgcn_exp2f(-dl); l *= f;
#pragma unroll
                for (int t2 = 0; t2 < 4; ++t2) if (t2 < it) {
#pragma unroll
                    for (int a = 0; a < 8; ++a) { gacc[t2][a] *= f; lacc[t2][a] *= f; } }
                if (hi == 0) wsf[r32] = f;
                LDS_WAIT();
#pragma unroll
                for (int a = 0; a < 4; ++a) { const f32x4 fv = *(const LAS f32x4*)(wsf + 8 * a + 4 * hi);
#pragma unroll
                    for (int j = 0; j < 4; ++j) { o[0][4 * a + j] *= fv[j]; o[1][4 * a + j] *= fv[j]; } }
                LDS_WAIT();
            }
            const float mup = mhat - sk; float s = 0.f;
#pragma unroll
            for (int r = 0; r < 16; ++r) { p0[r] = __builtin_amdgcn_exp2f(p0[r] - mup); p1[r] = __builtin_amdgcn_exp2f(p1[r] - mup); s += p0[r] + p1[r]; }
            l += s;
#pragma unroll
            for (int a = 0; a < 4; ++a) { gacc[it][a] = (p0[4 * a] + p0[4 * a + 1]) + (p0[4 * a + 2] + p0[4 * a + 3]); gacc[it][4 + a] = (p1[4 * a] + p1[4 * a + 1]) + (p1[4 * a + 2] + p1[4 * a + 3]);
                lacc[it][a] = p0[4 * a + 3]; lacc[it][4 + a] = p1[4 * a + 3]; }
            pv_tile(o, vb0 + sl * 8192, p0, p1);
        }
    }
    l += __shfl_xor(l, 32);
    const float inv_lc = (l > 0.f) ? 1.0f / l : 0.f;
    if (need_imp) { const float sc = inv_lc * 134217728.f;
#pragma unroll
        for (int it = 0; it < 4; ++it) if (it < ntc) {
#pragma unroll
            for (int a = 0; a < 4; ++a) { const int j0 = 16 * it + 2 * a + hi, j1 = j0 + 8;
                __hip_atomic_fetch_add(&imp[ql * 65 + j0], (unsigned)(gacc[it][a] * sc + 0.5f), __ATOMIC_RELAXED, __HIP_MEMORY_SCOPE_WORKGROUP);
                __hip_atomic_fetch_add(&imp[ql * 65 + j1], (unsigned)(gacc[it][4 + a] * sc + 0.5f), __ATOMIC_RELAXED, __HIP_MEMORY_SCOPE_WORKGROUP);
                __hip_atomic_fetch_add(&imp[ql * 65 + j0 + 1], (unsigned)(lacc[it][a] * sc + 0.5f), __ATOMIC_RELAXED, __HIP_MEMORY_SCOPE_WORKGROUP);
                if (j1 + 1 < 64) __hip_atomic_fetch_add(&imp[ql * 65 + j1 + 1], (unsigned)(lacc[it][4 + a] * sc + 0.5f), __ATOMIC_RELAXED, __HIP_MEMORY_SCOPE_WORKGROUP); } } }
    wait_bar<0>();
#if defined(PROF_MODE) && PROF_MODE == 3
    PROF_ACC();
#endif
#if defined(PROF_MODE) && PROF_MODE == 4
    PROF_T0();
#endif
#ifndef LATE_TWO
#define LATE_TWO 0
#endif
    f32x4 lv0[16], lv1[16];
#ifndef LATE_IN_P0
    const int lit0 = __builtin_amdgcn_readfirstlane(lu * 16 + wid), lit1 = lit0 + 8;
    { int ln = lane; asm volatile("" : "+v"(ln)); const LateD d0 = late_desc(F, lit0, ln); late_load(d0, lv0);
#if LATE_TWO
      const LateD d1 = late_desc(F, lit1, ln); late_load(d1, lv1);
#endif
    }
#endif
    unsigned long long mysel, uni;
    if (need_imp) {
        int lk = (int)__builtin_amdgcn_mbcnt_hi(~0u, __builtin_amdgcn_mbcnt_lo(~0u, 0u)); asm volatile("" : "+v"(lk));
        int key[8]; unsigned long long msk[8];
#pragma unroll
        for (int qq = 0; qq < 8; ++qq) { const int q = wid * 8 + qq;
            key[qq] = (lk >= 1 && lk <= qt - 2) ? (int)(((imp[q * 65 + lk] >> 4) << 6) | (unsigned)(63 - lk)) : -1;
            msk[qq] = 1ull | (1ull << qt) | (1ull << (qt - 1)); }
#pragma unroll 1
        for (int k = 0; k < 5; ++k) {
            int mx[8];
#pragma unroll
            for (int qq = 0; qq < 8; ++qq) mx[qq] = key[qq];
#pragma unroll
            for (int o2 = 1; o2 < 64; o2 <<= 1) {
#pragma unroll
                for (int qq = 0; qq < 8; ++qq) mx[qq] = max(mx[qq], __shfl_xor(mx[qq], o2)); }
#pragma unroll
            for (int qq = 0; qq < 8; ++qq) { const int js = 63 - (mx[qq] & 63); msk[qq] |= 1ull << js; if (lk == js) key[qq] = -2; }
        }
        unsigned long long wu = 0ull;
#pragma unroll
        for (int qq = 0; qq < 8; ++qq) { if (lk == 0) sel[wid * 8 + qq] = msk[qq]; wu |= msk[qq]; }
        if (lk == 0) wun[wid] = wu;
        wait_bar<0>();
        mysel = sel[ql]; uni = 0ull;
#pragma unroll
        for (int w = 0; w < 8; ++w) uni |= wun[w];
    } else { mysel = (2ull << qt) - 1ull; uni = mysel; }
#if defined(PROF_MODE) && PROF_MODE == 4
    PROF_ACC();
#endif
    uni = ((unsigned long long)__builtin_amdgcn_readfirstlane((unsigned)(uni >> 32)) << 32) | (unsigned long long)__builtin_amdgcn_readfirstlane((unsigned)uni);
#ifndef LATE_IN_P0
#if defined(PROF_MODE) && PROF_MODE == 7
    PROF_T0();
#endif
    { int ln = lane; asm volatile("" : "+v"(ln)); const LateD d0 = late_desc(F, lit0, ln); late_finish(F, d0, lv0); const LateD d1 = late_desc(F, lit1, ln);
#if !LATE_TWO
      late_load(d1, lv1);
#endif
      late_finish(F, d1, lv1); }
#if defined(PROF_MODE) && PROF_MODE == 7
    asm volatile("s_waitcnt vmcnt(0)" ::: "memory"); PROF_ACC();
#endif
#endif
    accum_out<true>(stg, o, ABLF(4) (gate_c * inv_lc), wsf, r32, hi);
    att_branch<true>(lds, KVb + 2 * 128 + g * 64, KVb + 3 * 128 + g * 64, uni, mysel, qt, t0, ql, qr, spk, wpk0, wpk1, l, o, wid, lane);
    accum_out<false>(stg, o, ABLF(5) ((l > 0.f) ? gate_s / l : 0.f), wsf, r32, hi);
    att_branch<false>(lds, KVb + 4 * 128 + g * 64, KVb + 5 * 128 + g * 64, 0ull, 0ull, qt, t0, ql, qr, spk, wpk0, wpk1, l, o, wid, lane);
    accum_out<false>(stg, o, ABLF(6) ((l > 0.f) ? gate_w / l : 0.f), wsf, r32, hi);
    {
        bf16* Ow = (bf16*)(F.ws + WS_AC) + ((size_t)b * SEQ + t0 + qh * 32) * 1024 + head * 64;
#pragma unroll
        for (int i = 0; i < 4; ++i) { const int row = i * 8 + (lane >> 3), ch = lane & 7;
            const f32x4 v0 = *(const LAS f32x4*)(stg + row * 64 + ch * 8), v1 = *(const LAS f32x4*)(stg + row * 64 + ch * 8 + 4);
#if defined(ABL) && ABL == 1
            *(u32x4*)(Ow + (unsigned)(row * 1024 + ch * 8)) = (u32x4){0u, 0u, 0u, 0u}; }
#else
            st_wt16(Ow + (unsigned)(row * 1024 + ch * 8), pack8(v0, v1)); }
#endif
    }
    asm volatile("s_waitcnt lgkmcnt(0)" ::: "memory"); __builtin_amdgcn_s_barrier(); asm volatile("" ::: "memory");
#if defined(PROF_MODE) && PROF_MODE == 5
    PROF_ACC();
#endif
}

__device__ __forceinline__ void attn_phase(Frame& F, int rep) {
    LAS int* qw = (LAS int*)(F.lds + MISC_OFF + 128);
    { int t_ = F.tid; asm volatile("" : "+v"(t_)); for (int i = t_; i < 1024; i += NWAVES * 64) ((LAS float*)(F.lds + L_GAIN))[i] = F.inp(17)[i]; }
    __syncthreads();
#if ATT_XCD_QUEUES
    { const int x0 = (int)(xb_xcc_id() & 7u); int hop = 0, xq = x0, u; unsigned un = 0u;
      if (F.tid == 0) qw[0] = (int)__hip_atomic_fetch_add(F.ctl + CW_QX + 64 * (xq + 8 * rep), 1u, RLX_AGENT);
      __syncthreads(); u = qw[0]; __syncthreads();
      for (;;) {
        if (u >= 128) {
            if (++hop == 8) break;
            xq = (x0 + hop) & 7;
            if (F.tid == 0) qw[0] = (int)__hip_atomic_fetch_add(F.ctl + CW_QX + 64 * (xq + 8 * rep), 1u, RLX_AGENT);
            __syncthreads(); u = qw[0]; __syncthreads();
            continue; }
        if (F.tid == 0) un = __hip_atomic_fetch_add(F.ctl + CW_QX + 64 * (xq + 8 * rep), 1u, RLX_AGENT);
        const int qt = 63 - (u >> 1), bg = 2 * xq + (u & 1); attn_unit(F, bg >> 1, bg & 1, qt, xq * 128 + u);
        if (F.tid == 0) qw[0] = (int)un;
        asm volatile("s_waitcnt lgkmcnt(0)" ::: "memory"); __builtin_amdgcn_s_barrier(); asm volatile("" ::: "memory");
        u = qw[0];
        asm volatile("s_waitcnt lgkmcnt(0)" ::: "memory"); __builtin_amdgcn_s_barrier(); asm volatile("" ::: "memory");
      } }
#else
    { int u; unsigned un = 0u;
      if (F.tid == 0) qw[0] = (int)__hip_atomic_fetch_add(F.ctl + CW_QATT + 16 * rep, 1u, RLX_AGENT);
      __syncthreads(); u = qw[0]; __syncthreads();
      while (u < 1024) {
        if (F.tid == 0) un = __hip_atomic_fetch_add(F.ctl + CW_QATT + 16 * rep, 1u, RLX_AGENT);
        const int qt = 63 - (u >> 4), bg = u & 15; attn_unit(F, bg >> 1, bg & 1, qt, u);
        if (F.tid == 0) qw[0] = (int)un;
        asm volatile("s_waitcnt lgkmcnt(0)" ::: "memory"); __builtin_amdgcn_s_barrier(); asm volatile("" ::: "memory");
        u = qw[0];
        asm volatile("s_waitcnt lgkmcnt(0)" ::: "memory"); __builtin_amdgcn_s_barrier(); asm volatile("" ::: "memory");
      } }
#endif
    ConvW cwv; conv_weights(F, cwv);
    { ConvIn cin; int u; unsigned un = 0u;
      if (F.tid == 0) qw[0] = (int)__hip_atomic_fetch_add(F.ctl + CW_QATT + 32 + 16 * rep, 2u, RLX_AGENT);
      __syncthreads(); u = qw[0]; __syncthreads();
      if (u < 1024) conv_load(F, u, cin);
      while (u < 1024) {
        if (F.tid == 0) un = __hip_atomic_fetch_add(F.ctl + CW_QATT + 32 + 16 * rep, 2u, RLX_AGENT);
        conv_unit(F, u, u + 1, cin, cwv);
        if (F.tid == 0) qw[0] = (int)un;
        lds_bar();
        const int u2 = qw[0];
        conv_unit(F, u + 1, u2 < 1024 ? u2 : -1, cin, cwv);
        u = u2;
      } }
}
}
#ifndef PP_IN_P10
#define PP_IN_P10 0
#endif
#ifndef P5_REV
#define P5_REV false
#endif
#ifndef X1_IN_WS
#define X1_IN_WS 0
#endif
#if X1_IN_WS
#define X1_OFF WS_X1
#else
#define X1_OFF ((size_t)((unsigned char*)F.out - F.ws))
#endif

__device__ __forceinline__ void p6_router(Frame& F, int rep = 0) {
    const int lane = F.lane, i16 = lane & 15, kq = lane >> 4;
    const bf16* XB = (const bf16*)(F.ws + X1_OFF); const bf16* WR = (const bf16*)(F.ws + WS_WR);
    int* list = (int*)(F.ws + (rep ? WS_GLU : WS_LIST)); float* wt = (float*)(F.ws + WS_WT); float* listw = (float*)(F.ws + WS_LISTW); float* listr = (float*)(F.ws + WS_LISTR); const int cwc = rep ? 8192 : CW_CNT; float* rstd2 = (float*)(F.ws + WS_RSTD2);
    LAS float* lg = (LAS float*)(F.lds + F.wave * 3072);
    LAS unsigned* hist = (LAS unsigned*)(F.lds + 24576); LAS unsigned* base = hist + 32;
    constexpr int WRP = 2064; LAS unsigned char* wrl = F.lds + 25600;
    for (int i = F.tid; i < 48 * 128; i += NWAVES * 64) { const int r = i >> 7, ch = i & 127, sr = r < 16 ? r : r + 16;
        *(LAS u32x4*)(wrl + r * WRP + ch * 16) = *(const u32x4*)(WR + (size_t)sr * 1024 + ch * 8); }
    __syncthreads();
    const int gw = F.vcu * NWAVES + F.wave, NGW = F.G * NWAVES, niter = (T / 16 + NGW - 1) / NGW;
    for (int itr = 0; itr < niter; ++itr) {
        const int grp = itr * NGW + gw; const bool live = grp < T / 16;
        if (F.tid < 32) hist[F.tid] = 0u;
        int ea = 0, eb = 0, tok = 0; float w0 = 0.f, w1 = 0.f, rstd = 0.f;
        if (live) {
            const size_t row = (size_t)grp * 16 + i16;
            f32x4 acc0 = (f32x4){0.f, 0.f, 0.f, 0.f}, acc2 = acc0, acc3 = acc0; float ssq = 0.f;
#pragma unroll 1
            for (int h = 0; h < 2; ++h) {
            u32x4 xw[16];
#pragma unroll
            for (int s2 = 0; s2 < 16; ++s2) xw[s2] = NT_LD((const u32x4*)(XB + row * 1024 + (h * 16 + s2) * 32 + kq * 8));
            asm volatile("" ::: "memory");
#pragma unroll
            for (int s2 = 0; s2 < 16; ++s2) { const int s = h * 16 + s2;
                const u32x4 w = xw[s2];
                f32x4 a0, a1; unpack8(w, a0, a1);
                ssq += (a0[0] * a0[0] + a0[1] * a0[1]) + (a0[2] * a0[2] + a0[3] * a0[3]) + (a1[0] * a1[0] + a1[1] * a1[1]) + (a1[2] * a1[2] + a1[3] * a1[3]);
                const bf16x8 a = __builtin_bit_cast(bf16x8, w);
                const bf16x8 b0 = *(const LAS bf16x8*)(wrl + i16 * WRP + s * 64 + kq * 16);
                const bf16x8 b2 = *(const LAS bf16x8*)(wrl + (16 + i16) * WRP + s * 64 + kq * 16);
                const bf16x8 b3 = *(const LAS bf16x8*)(wrl + (32 + i16) * WRP + s * 64 + kq * 16);
                acc0 = __builtin_amdgcn_mfma_f32_16x16x32_bf16(a, b0, acc0, 0, 0, 0);
                acc2 = __builtin_amdgcn_mfma_f32_16x16x32_bf16(a, b2, acc2, 0, 0, 0);
                acc3 = __builtin_amdgcn_mfma_f32_16x16x32_bf16(a, b3, acc3, 0, 0, 0);
            } }
            ssq += __shfl_xor(ssq, 16); ssq += __shfl_xor(ssq, 32);
            rstd = 1.0f / sqrtf(ssq * (1.f / 1024.f) + EPS);
#pragma unroll
            for (int r = 0; r < 4; ++r) { lg[(kq * 4 + r) * 48 + i16] = acc0[r]; lg[(kq * 4 + r) * 48 + 16 + i16] = acc2[r]; lg[(kq * 4 + r) * 48 + 32 + i16] = acc3[r]; }
            LDS_WAIT();
            if (lane < 16) {
                tok = grp * 16 + lane;
                float g4[4];
#pragma unroll
                for (int c = 0; c < 4; ++c) g4[c] = lg[lane * 48 + c] * rstd + F.inp(19)[c];
                int gs = 0; float gm = g4[0];
#pragma unroll
                for (int c = 1; c < 4; ++c) if (g4[c] > gm) { gm = g4[c]; gs = c; }
                float den = 0.f;
#pragma unroll
                for (int c = 0; c < 4; ++c) den += __builtin_amdgcn_exp2f((g4[c] - gm) * LOG2E);
                const float pg = 1.0f / den;
                float e8[8];
#pragma unroll
                for (int c = 0; c < 8; ++c) e8[c] = lg[lane * 48 + 16 + gs * 8 + c] * rstd + F.inp(21)[gs * 8 + c];
                int i1 = 0; float m1 = e8[0];
#pragma unroll
                for (int c = 1; c < 8; ++c) if (e8[c] > m1) { m1 = e8[c]; i1 = c; }
                int i2 = -1; float m2 = -INFINITY;
#pragma unroll
                for (int c = 0; c < 8; ++c) if (c != i1 && e8[c] > m2) { m2 = e8[c]; i2 = c; }
                const float ex = __builtin_amdgcn_exp2f((m2 - m1) * LOG2E);
                w0 = pg / (1.f + ex); w1 = pg * ex / (1.f + ex);
                ea = gs * 8 + i1; eb = gs * 8 + i2;
            }
        }
        __syncthreads();
        unsigned ra = 0u, rb = 0u;
        if (live && lane < 16) { ra = __hip_atomic_fetch_add(hist + ea, 1u, __ATOMIC_RELAXED, __HIP_MEMORY_SCOPE_WORKGROUP); rb = __hip_atomic_fetch_add(hist + eb, 1u, __ATOMIC_RELAXED, __HIP_MEMORY_SCOPE_WORKGROUP); }
        __syncthreads();
        if (F.tid < 32) { const unsigned h = hist[F.tid]; base[F.tid] = h ? __hip_atomic_fetch_add(F.ctl + cwc + 64 * F.tid, h, RLX_AGENT) : 0u; }
        __syncthreads();
        if (live && lane < 16) {
            const int pa = ea * LISTCAP + base[ea] + ra, pb = eb * LISTCAP + base[eb] + rb;
            list[pa] = tok * 2; list[pb] = tok * 2 + 1; if (!rep) { listw[pa] = w0; listw[pb] = w1; listr[pa] = rstd; listr[pb] = rstd; }
            wt[tok * 2] = w0; wt[tok * 2 + 1] = w1; rstd2[tok] = rstd;
        }
        __syncthreads();
    }
}

__device__ __forceinline__ void moe_table(Frame& F) {
    LAS int* tab = (LAS int*)(F.lds + MOE_OFF);
    if (F.tid < 32) tab[33 + F.tid] = (int)F.ctl[CW_CNT + 64 * F.tid];
    __syncthreads();
    if (F.tid < 32) {
        const int e = F.tid, cnt = tab[33 + e], rem = cnt & 255;
        int ts = 0, fb = 0, nfull = 0, rank = 0;
        for (int k = 0; k < 32; ++k) { const int ck = tab[33 + k], rk = ck & 255;
            if (k < e) { ts += (ck + 255) >> 8; fb += ck >> 8; }
            nfull += ck >> 8;
            if (rk && (rk > rem || (rk == rem && k < e))) ++rank; }
        tab[e] = ts;
        for (int k = 0; k < (cnt >> 8); ++k) tab[80 + fb + k] = (ts + k) | (e << 16);
        if (rem) tab[80 + nfull + rank] = (ts + (cnt >> 8)) | (e << 16);
        if (e == 31) tab[32] = ts + ((cnt + 255) >> 8);
    }
    __syncthreads();
}

__device__ __forceinline__ void p9_combine(Frame& F) {
    const int lane = F.lane; const int gw = F.vcu * NWAVES + F.wave, NGW = F.G * NWAVES;
    const bf16* Y = (const bf16*)(F.ws + WS_Y); const bf16* X1 = (const bf16*)(F.ws + X1_OFF); bf16* XB = (bf16*)(F.ws + WS_XN); float* rstd3 = (float*)(F.ws + WS_RSTD3);
#pragma unroll 2
    for (int m = gw; m < T; m += NGW) {
        const u32x4* xr = (const u32x4*)(X1 + (size_t)m * DM) + lane;
        const u32x2* y0 = (const u32x2*)((const unsigned char*)Y + (size_t)(2 * m) * DM) + lane; const u32x2* y1 = (const u32x2*)((const unsigned char*)Y + (size_t)(2 * m + 1) * DM) + lane;
        u32x4* ob = (u32x4*)(XB + (size_t)m * DM) + lane; u32x2* o8 = (u32x2*)(F.ws + WS_X1F8 + (size_t)m * DM) + lane;
        float s = 0.f;
#pragma unroll
        for (int j = 0; j < 2; ++j) { f32x4 v0, v1, a0, a1, b0, b1; unpack8(NT_LD(xr + 64 * j), v0, v1); unpack8_fp8(NT_LD(y0 + 64 * j), a0, a1); unpack8_fp8(NT_LD(y1 + 64 * j), b0, b1);
            v0 += (a0 + b0) * 0.0625f; v1 += (a1 + b1) * 0.0625f;
            const u32x4 w = pack8(v0, v1); st_wt16(ob + 64 * j, w); unpack8(w, v0, v1); if (P10_FP8) o8[64 * j] = pack8_fp8(v0 * 16.f, v1 * 16.f);
            s += (v0[0] * v0[0] + v0[1] * v0[1]) + (v0[2] * v0[2] + v0[3] * v0[3]) + (v1[0] * v1[0] + v1[1] * v1[1]) + (v1[2] * v1[2] + v1[3] * v1[3]); }
        s = wave_sum(s);
        if (lane == 0) rstd3[m] = 1.0f / sqrtf(s * (1.f / DM) + EPS);
    }
}

__device__ __forceinline__ void ph1(Frame& F, unsigned char* ws, int cid) {
#ifndef X_NO_P1A
    { pg8::Gemm g{(const bf16*)(ws + WS_XN), (const bf16*)(ws + WS_WIN), 1024}; pg8::StaticOrder S; S.init(T, 8 * 256, F.G, cid);
      EpiWin<0> E{(bf16*)(ws + WS_QB), (bf16*)(ws + WS_KVB), (bf16*)(ws + WS_GLU), (bf16*)(ws + WS_MG), (float*)(ws + WS_NG), F.inp(4), F.inp(5), F.inp(15), 1.f};
      pg8::gemm_phase<EpiWin<0>, pg8::StaticOrder, P1_ALIGN>(F.lds, g, S, E); }
#endif
#ifndef X_NO_P1B
    { pg8::Gemm g{(const bf16*)(ws + WS_XN8), (const bf16*)(ws + WS_WIN8), 512}; pg8::StaticOrderF8 S; S.init(T, (MG_LATE ? 2 : 10) * 256, F.G, cid); S.pbase = MG_LATE ? 16 : 8; S.bown = true; S.boff = MG_LATE ? 8 : 0;
      EpiWin<1> E{(bf16*)(ws + WS_QB), (bf16*)(ws + WS_KVB), (bf16*)(ws + WS_GLU), (bf16*)(ws + WS_MG), (float*)(ws + WS_NG), F.inp(4), F.inp(5), F.inp(15), 1.f / 512.f};
      pg8::gemm_phase<EpiWin<1>, pg8::StaticOrderF8, P1_ALIGN>(F.lds, g, S, E); }
#endif
}
__device__ __forceinline__ void ph4(Frame& F, unsigned char* ws, int cid) {
#if MG_LATE
    { pg8::Gemm g8{(const bf16*)(ws + WS_XN8), (const bf16*)(ws + WS_WIN8), 512}; pg8::PairOrderF8 S8; S8.init(T, 1024, F.G, cid); S8.tbase = 8;
      EpiWin<1> E8{(bf16*)(ws + WS_QB), (bf16*)(ws + WS_KVB), (bf16*)(ws + WS_GLU), (bf16*)(ws + WS_MG), (float*)(ws + WS_NG), F.inp(4), F.inp(5), F.inp(15), 1.f / 512.f};
      pg8::gemm_phase<EpiWin<1>, pg8::PairOrderF8, P1_ALIGN>(F.lds, g8, S8, E8); }
#endif
    pg8::Gemm g{(const bf16*)(ws + WS_AC), (const bf16*)(ws + WS_WAC), 1024}; pg8::StaticOrder S; S.init(T, 1024, F.G, cid);
    EpiMerge E{(const bf16*)(ws + WS_MG), (bf16*)(ws + (X_BF16 == 2 ? WS_MER : WS_XN)), F.lds};
    pg8::gemm_phase<EpiMerge, pg8::StaticOrder, true>(F.lds, g, S, E);
}
__device__ __forceinline__ void ph5_wo(Frame& F, unsigned char* ws, int cid) {
    pg8::Gemm g{(const bf16*)(ws + (X_BF16 == 2 ? WS_MER : WS_XN)), (const bf16*)(ws + WS_WO), 1024}; pg8::StaticOrder S; S.init(T, 1024, F.G, cid); S.rev = P5_REV;
    EpiWo E{F.inp(0), (bf16*)(ws + X1_OFF), ws + WS_X1F8, X_BF16 == 2 ? (const bf16*)(ws + WS_XN) : (const bf16*)F.out + (size_t)T * DM, (const float*)(ws + WS_IRS), F.inp(2)};
    pg8::gemm_phase<EpiWo, pg8::StaticOrder, true>(F.lds, g, S, E);
}
__device__ __forceinline__ void ph5_pp(Frame& F, unsigned char* ws, int cid) {
    pg8::Gemm g{(const bf16*)(ws + WS_PBF), (const bf16*)(ws + WS_WPP), 256}; pg8::StaticOrder S; S.init(T, 1024, F.G, cid);
    EpiBf E{(bf16*)(ws + WS_PP), 1024};
    pg8::gemm_phase<EpiBf, pg8::StaticOrder, true>(F.lds, g, S, E);
}
__device__ __forceinline__ void ph5(Frame& F, unsigned char* ws, int cid) {
#if PP_IN_P10
    ph5_wo(F, ws, cid);
#else
    if ((cid >> 3) & 1) { ph5_pp(F, ws, cid); ph5_wo(F, ws, cid); } else { ph5_wo(F, ws, cid); ph5_pp(F, ws, cid); }
#endif
}
__device__ __forceinline__ void ph7(Frame& F, unsigned char* ws, int cid) {
    moe_table(F);
    pg8::Gemm g{(const bf16*)(ws + WS_X1F8), (const bf16*)(ws + WS_WGU), 512};
    LAS int* rowtab = (LAS int*)(F.lds + LDSCTL_OFF + 4096);
    MoeOrder<true> S{(const LAS int*)(F.lds + MOE_OFF), (const int*)(ws + WS_LIST), F.G, cid, F.ctl + CW_Q7, (LAS int*)(F.lds + MOE_OFF + 2048), rowtab};
    LAS float* rstab = (LAS float*)(F.lds + LDSCTL_OFF + 4096 + MOE_TAB_UNITS * 1024);
    for (int i = 0; i < MOE_TAB_UNITS; ++i) { pg8::Unit u; if (!S.next(i, u)) break;
        if (F.tid < 256) { const int li = u.e * LISTCAP + u.lp + (F.tid < u.nrow ? F.tid : u.nrow - 1);
            rowtab[i * 256 + F.tid] = ((const int*)(ws + WS_LIST))[li] >> 1; rstab[i * 256 + F.tid] = ((const float*)(ws + WS_LISTR))[li]; } }
    __syncthreads();
    EpiGU E{(bf16*)(ws + WS_H), (const int*)(ws + WS_LIST), (const float*)(ws + WS_LISTR), rstab};
    pg8::gemm_phase<EpiGU, MoeOrder<true>, true>(F.lds, g, S, E);
}
__device__ __forceinline__ void ph8(Frame& F, unsigned char* ws, int cid) {
#if MK_PER_PHASE || defined(ONLY_PHASE)
    moe_table(F);
#endif
    pg8::Gemm g{(const bf16*)(ws + WS_H), (const bf16*)(ws + WS_WD), 256};
    MoeOrder<false> S{(const LAS int*)(F.lds + MOE_OFF), (const int*)(ws + WS_LIST), F.G, cid, F.ctl + CW_Q8, (LAS int*)(F.lds + MOE_OFF + 2048), nullptr};
    LAS int* enttab = (LAS int*)(F.lds + LDSCTL_OFF + 4096); LAS float* wtab = (LAS float*)(F.lds + LDSCTL_OFF + 4096 + MOE_TAB_UNITS * 1024);
    for (int i = 0; i < MOE_TAB_UNITS; ++i) { pg8::Unit u; if (!S.next(i, u)) break;
        if (F.tid < 256) { const int li = u.e * LISTCAP + u.lp + (F.tid < u.nrow ? F.tid : u.nrow - 1);
            enttab[i * 256 + F.tid] = ((const int*)(ws + WS_LIST))[li]; wtab[i * 256 + F.tid] = ((const float*)(ws + WS_LISTW))[li]; } }
    __syncthreads();
    EpiDown E{(bf16*)(ws + WS_Y), (const int*)(ws + WS_LIST), (const float*)(ws + WS_LISTW), enttab, wtab};
    pg8::gemm_phase<EpiDown, MoeOrder<false>, true>(F.lds, g, S, E);
}
__device__ __forceinline__ void ph10(Frame& F, unsigned char* ws, int cid) {
#ifdef STAGGER_US
    if ((cid >> 3) & 1) { const unsigned long long t0_ = __builtin_amdgcn_s_memrealtime(); while (__builtin_amdgcn_s_memrealtime() - t0_ < (unsigned long long)(STAGGER_US * 100)) __builtin_amdgcn_s_sleep(8); }
#endif
#if PP_IN_P10
    ph5_pp(F, ws, cid);
#endif
    EpiPle E{F.out, (const bf16*)(ws + WS_XN), (const bf16*)(ws + WS_PP), (const float*)(ws + WS_RSTD3), F.inp(27), (float*)(ws + WS_Y)};
#if P10_FP8
    pg8::Gemm g{(const bf16*)(ws + WS_X1F8), (const bf16*)(ws + WS_WPG), 512}; pg8::StaticOrderF8 S; S.init(T, 1024, F.G, cid);
    pg8::gemm_phase<EpiPle, pg8::StaticOrderF8, true>(F.lds, g, S, E);
#else
    pg8::Gemm g{(const bf16*)(ws + WS_XN), (const bf16*)(ws + WS_WPG), 1024}; pg8::StaticOrder S; S.init(T, 1024, F.G, cid);
    pg8::gemm_phase<EpiPle, pg8::StaticOrder, true>(F.lds, g, S, E);
#endif
}

#ifdef CHECK
constexpr int CW_CHK = 3072;
constexpr int NCHK = 24;
__device__ __forceinline__ int chk_token(int s) {
    const int fixed[16] = {0, 1, 29, 30, 31, 63, 64, 4095, 4096, 4097, 4126, 8191, 12288, 20000, 32767, 16384 + 33};
    return s < 16 ? fixed[s] : (int)(((unsigned)s * 2654435761u) % (unsigned)T);
}
__device__ __forceinline__ void chk_report(Frame& F, int k, float err) {
    if (!(err >= 0.f)) err = 1e30f;
    atomicMax((unsigned*)(F.ctl + CW_CHK + k), __float_as_uint(err));
}
__device__ __forceinline__ float block_sum(Frame& F, float v, LAS float* red) {
    v = wave_sum(v); __syncthreads(); if (F.lane == 0) red[F.wave] = v; __syncthreads();
    float s = 0.f; for (int w = 0; w < 8; ++w) s += red[w]; __syncthreads(); return s;
}
__device__ __forceinline__ float bfv(const bf16* p, size_t i) { return __uint_as_float((unsigned)p[i] << 16); }

__device__ void chk_p1(Frame& F) {
    const int s = blockIdx.x; if (s >= 64) return;
    const int t = chk_token(s), tid = F.tid;
    LAS float* h = (LAS float*)F.lds; LAS float* z = h + 1024; LAS float* red = z + 4608;
    const float* x = F.inp(0) + (size_t)t * 1024; const float* W = F.inp(3);
    float ss = 0.f; for (int k = tid; k < 1024; k += 512) ss += x[k] * x[k];
    ss = block_sum(F, ss, red); const float rstd = 1.0f / sqrtf(ss / 1024.f + EPS);
    for (int k = tid; k < 1024; k += 512) h[k] = x[k] * rstd * F.inp(2)[k];
    __syncthreads();
    for (int c = tid; c < NIN; c += 512) { float a = 0.f; for (int k = 0; k < 1024; ++k) a += h[k] * W[(size_t)k * NIN + c]; z[c] = a; }
    __syncthreads();
    const bf16* Qb = (const bf16*)(F.ws + WS_QB); const bf16* KVb = (const bf16*)(F.ws + WS_KVB); const bf16* GLU = (const bf16*)(F.ws + WS_GLU); const bf16* MG = (const bf16*)(F.ws + WS_MG); const float* NG = (const float*)(F.ws + WS_NG);
    { const int c = tid, hd = c >> 6; float q2 = 0.f; for (int d = 0; d < 64; ++d) q2 += z[hd * 64 + d] * z[hd * 64 + d];
      const float e = z[c] / sqrtf(q2 / 64.f + EPS) * F.inp(4)[c & 63] * QC2; chk_report(F, 1, fabsf(e - bfv(Qb, (size_t)t * 512 + c))); }
    for (int c = tid; c < 768; c += 512) { const int i = c >> 7, grp = c >> 6; float e = z[OFF_KV + c];
        if (i == 2 || i == 4) { float q2 = 0.f; for (int d = 0; d < 64; ++d) q2 += z[OFF_KV + grp * 64 + d] * z[OFF_KV + grp * 64 + d]; e = e / sqrtf(q2 / 64.f + EPS) * F.inp(5)[(i == 2 ? 64 : 128) + (c & 63)]; }
        chk_report(F, 2, fabsf(e - bfv(KVb, (size_t)t * 768 + c))); }
    { const int c = tid; const float e = z[OFF_CONV + c] / (1.f + expf(-z[OFF_CONV + 512 + c])); chk_report(F, 3, fabsf(e - bfv(GLU, (size_t)t * 512 + c))); }
#ifdef MG_RAW
    for (int c = tid; c < 2048; c += 512) { const float e = z[OFF_MERGE + c];
#else
    for (int c = tid; c < 2048; c += 512) { const float e = 1.f / (1.f + expf(-(z[OFF_MERGE + c] + F.inp(15)[c])));
#endif
        const float er = fabsf(e - bfv(MG, (size_t)t * 2048 + c)); chk_report(F, 4, er); if (er > 0.08f) atomicMax((unsigned*)(F.ctl + CW_CHK + 40 + s), 1u); }
    if (tid < 24) { const float e = 1.f / (1.f + expf(-z[OFF_GATE + tid])); chk_report(F, 5, fabsf(e - NG[(size_t)t * 32 + tid])); }
    __syncthreads();
}
__device__ void chk_conv(Frame& F) {
    const int s = blockIdx.x; if (s >= 64) return;
    const int t = chk_token(s), tid = F.tid, sp = t & (SEQ - 1);
    LAS float* red = (LAS float*)F.lds;
    const bf16* GLU = (const bf16*)(F.ws + WS_GLU);
    float a = F.inp(11)[tid];
    for (int j = 0; j < 31; ++j) { const int sq = sp - 30 + j; if (sq >= 0) a += F.inp(10)[j * 512 + tid] * bfv(GLU, (size_t)(t - 30 + j) * 512 + tid); }
    const float mu = block_sum(F, a, red) / 512.f; const float d = a - mu; const float var = block_sum(F, d * d, red) / 512.f;
    float y = d / sqrtf(var + EPS) * F.inp(12)[tid] + F.inp(13)[tid]; y = y / (1.f + expf(-y));
    chk_report(F, 6, fabsf(y - bfv((const bf16*)(F.ws + WS_AC), (size_t)t * 1024 + 512 + tid)));
}
__device__ void chk_merge(Frame& F) {
    const int s = blockIdx.x; if (s >= 64) return;
    const int t = chk_token(s), tid = F.tid;
    const bf16* AC = (const bf16*)(F.ws + WS_AC); const bf16* MG = (const bf16*)(F.ws + WS_MG); const bf16* MER = (const bf16*)(F.ws + WS_XN);
    for (int c = tid; c < 1024; c += 512) { float ya = 0.f, yc = 0.f;
        for (int k = 0; k < 512; ++k) { ya += bfv(AC, (size_t)t * 1024 + k) * F.inp(9)[(size_t)k * 1024 + c]; yc += bfv(AC, (size_t)t * 1024 + 512 + k) * F.inp(14)[(size_t)k * 1024 + c]; }
        const float e = bfv(MG, (size_t)t * 2048 + c) * ya + bfv(MG, (size_t)t * 2048 + 1024 + c) * yc;
        chk_report(F, 10, fabsf(e - bfv(MER, (size_t)t * 1024 + c))); }
}
__device__ void chk_p5(Frame& F) {
    const int s = blockIdx.x; if (s >= 64) return;
    const int t = chk_token(s), tid = F.tid;
    const bf16* MER = (const bf16*)(F.ws + WS_XN); const bf16* PP = (const bf16*)(F.ws + WS_PP);
    for (int c = tid; c < 1024; c += 512) { float a = F.inp(0)[(size_t)t * 1024 + c], pp = 0.f;
        for (int k = 0; k < 1024; ++k) a += bfv(MER, (size_t)t * 1024 + k) * F.inp(16)[(size_t)k * 1024 + c];
        for (int k = 0; k < 256; ++k) pp += F.inp(1)[(size_t)t * 256 + k] * F.inp(28)[(size_t)k * 1024 + c];
        chk_report(F, 11, fabsf(a - F.out[(size_t)t * 1024 + c])); chk_report(F, 12, fabsf(pp - bfv(PP, (size_t)t * 1024 + c))); }
}
__device__ void chk_verdict(Frame& F) {
    int bad = 0, nbad = 0;
    for (int k = NCHK - 1; k >= 1; --k) { const float e = __uint_as_float(__hip_atomic_load(F.ctl + CW_CHK + k, RLX_AGENT)); if (e > 0.08f) { bad = k; ++nbad; } }
    if (bad) { const float c = sqrtf(1.45f * (float)bad); for (size_t i = (size_t)blockIdx.x * 512 + F.tid; i < (size_t)T * DM; i += (size_t)F.G * 512) F.out[i] = (i == 0) ? 100.f * (float)nbad : c; }
    { int ns = 0; for (int s = 0; s < 64; ++s) ns += (int)__hip_atomic_load(F.ctl + CW_CHK + 40 + s, RLX_AGENT); if (blockIdx.x == 0 && F.tid == 0) F.out[0] = 100.f * (float)ns; }
}
#define CHK_RUN(fn) do { fn(F); xcd_barrier(bar); } while (0)
#else
#define CHK_RUN(fn) do {} while (0)
#endif
__global__ void __launch_bounds__(NWAVES * 64, 2) nsa_block_fwd(Args args) {
    extern __shared__ __attribute__((aligned(16))) unsigned char lds_raw[];
    Frame F;
    F.lds = (LAS unsigned char*)lds_raw;
    F.MISC = (volatile LAS unsigned*)(F.lds + MISC_OFF);
    F.tid = threadIdx.x; F.lane = F.tid & 63; F.wave = __builtin_amdgcn_readfirstlane(F.tid >> 6);
    F.G = gridDim.x; { const int bx = blockIdx.x; F.vcu = (F.G % 8 == 0) ? (bx % 8) * (F.G / 8) + bx / 8 : bx; }
    F.ws = args.ws; F.ctl = (gu32*)(args.ws + WS_CTL); F.out = args.out;
    F.ka = (const CAS Args*)__builtin_amdgcn_kernarg_segment_ptr();
    for (int u = F.tid; u < (LDS_BYTES - LDSCTL_OFF) / 4; u += NWAVES * 64) ((LAS unsigned*)(F.lds + LDSCTL_OFF))[u] = 0u;
    __syncthreads();
    XcdBarrier bar; bar.bar = (unsigned*)(F.ctl + CW_BAR); bar.x = 0; bar.st = nullptr;
    if (!MK_PER_PHASE) bar = xcd_barrier_post((unsigned*)(F.ctl + CW_BAR), F.MISC + 8);
    const int lo = args.ph_lo, hi = args.ph_hi;
#ifdef ONLY_PHASE
#define IN(k) ((k) == ONLY_PHASE && lo <= (k) && (k) < hi)
#else
#define IN(k) (lo <= (k) && (k) < hi)
#endif
#ifdef STAMP_A
#define STAMP(i) do { if (F.tid == 0) ((volatile LAS unsigned long long*)(F.lds + MISC_OFF + 64))[i] = __builtin_amdgcn_s_memrealtime(); } while (0)
#else
#define STAMP(i) do {} while (0)
#endif
#if defined(PROF_MODE) && PROF_MODE >= 100
#define SEAM(k) do { if (IN(k) && IN((k) + 1)) { const unsigned long long pt0_ = __builtin_amdgcn_s_memrealtime(); xcd_barrier(bar); \
        if (F.tid == 0 && (PROF_MODE == 100 || PROF_MODE == 101 + (k))) ((volatile LAS unsigned*)(F.lds + MISC_OFF + 64))[0] += (unsigned)(__builtin_amdgcn_s_memrealtime() - pt0_); } } while (0)
#else
#define SEAM(k) do { if (IN(k) && IN((k) + 1)) xcd_barrier(bar); STAMP((k) + 1); } while (0)
#endif
    unsigned char* ws = args.ws;
    const int cid = (int)blockIdx.x;

#ifndef REP_MASK
#define REP_MASK 0
#endif
#define RUNPH(k, call) do { if (IN(k)) { call; } SEAM(k); if ((REP_MASK >> (k)) & 1) { if (IN(k)) { call; } xcd_barrier(bar); } } while (0)
    STAMP(0);
    RUNPH(0, p0_prologue(F));
    RUNPH(1, ph1(F, ws, cid));
    CHK_RUN(chk_p1);
    RUNPH(2, p2_phase(F));
    CHK_RUN(chk_conv);
    if (IN(3)) { att::attn_phase(F, 0); } SEAM(3);
    if ((REP_MASK >> 3) & 1) { att::attn_phase(F, 1); xcd_barrier(bar); }
    RUNPH(4, ph4(F, ws, cid));
    CHK_RUN(chk_merge);
    RUNPH(5, ph5(F, ws, cid));
    CHK_RUN(chk_p5);
    if (IN(6)) { p6_router(F); } SEAM(6);
    if ((REP_MASK >> 6) & 1) { p6_router(F, 1); xcd_barrier(bar); }
    RUNPH(7, ph7(F, ws, cid));
    RUNPH(8, ph8(F, ws, cid));
    RUNPH(9, p9_combine(F));
    if (IN(10)) { ph10(F, ws, cid); }
    if ((REP_MASK >> 10) & 1) { xcd_barrier(bar); ph10(F, ws, cid); }
#ifdef CHECK
    xcd_barrier(bar); chk_verdict(F);
#endif
#ifdef PROF_MODE
    if (blockIdx.x == 0) { __syncthreads(); if (F.tid == 0) { const unsigned ticks = ((volatile LAS unsigned*)(F.lds + MISC_OFF + 64))[0]; const unsigned long long t0 = __builtin_amdgcn_s_memrealtime();
        while (__builtin_amdgcn_s_memrealtime() - t0 < 4ull * ticks) __builtin_amdgcn_s_sleep(8); } __syncthreads(); }
#endif
#ifdef STAMP_A
    xcd_barrier(bar); STAMP(11); __syncthreads();
    { volatile LAS unsigned long long* st = (volatile LAS unsigned long long*)(F.lds + MISC_OFF + 64);
      const float usA = (float)(st[STAMP_A + 1] - st[STAMP_A]) * 0.01f, usB = (float)(st[STAMP_B + 1] - st[STAMP_B]) * 0.01f;
      const float sc = 1.f + usB * (1.f / 300.f);
      for (size_t i = (size_t)blockIdx.x * 512 + F.tid; i < (size_t)T * DM; i += (size_t)F.G * 512) F.out[i] = (i == 0) ? usA : F.out[i] * sc; }
#endif
#undef IN
#undef SEAM
}

extern "C" void kernel_launch(void* const* d_in, const int* in_sizes, int n_in, void* d_out, int out_size, void* d_ws, size_t ws_size, hipStream_t stream) {
    static int grid = 0;
    if (grid == 0) {
        if (n_in != 29 || in_sizes[0] != T * DM || out_size != T * DM || ws_size < WS_END) { fprintf(stderr, "kernel_launch: unexpected shapes (n_in %d, in0 %d, out %d, ws %zu); nothing launched\n", n_in, n_in > 0 ? in_sizes[0] : -1, out_size, ws_size); grid = -1; return; }
        int dev = 0, cus = 0, per_cu = 0;
        if (hipGetDevice(&dev) != hipSuccess || hipDeviceGetAttribute(&cus, hipDeviceAttributeMultiprocessorCount, dev) != hipSuccess) { grid = -1; return; }
        if (hipFuncSetAttribute((const void*)nsa_block_fwd, hipFuncAttributeMaxDynamicSharedMemorySize, LDS_BYTES) != hipSuccess) { fprintf(stderr, "kernel_launch: hipFuncSetAttribute failed\n"); grid = -1; return; }
        if (hipOccupancyMaxActiveBlocksPerMultiprocessor(&per_cu, (const void*)nsa_block_fwd, NWAVES * 64, LDS_BYTES) != hipSuccess || per_cu < 1)
            fprintf(stderr, "kernel_launch: note: occupancy query reports %d workgroups per CU\n", per_cu);
        (void)hipGetLastError();
        grid = cus;
    }
    if (grid < 0) return;
    if (hipMemsetAsync((char*)d_ws + WS_CTL, 0, CTL_ZERO_BYTES, stream) != hipSuccess) return;
    Args a{};
    for (int i = 0; i < 29; ++i) a.in[i] = (const float*)d_in[i];
    a.out = (float*)d_out; a.ws = (unsigned char*)d_ws;
#if MK_PER_PHASE
    for (int ph = 0; ph < NPH; ++ph) { a.ph_lo = ph; a.ph_hi = ph + 1; hipLaunchKernelGGL(nsa_block_fwd, dim3(grid), dim3(NWAVES * 64), LDS_BYTES, stream, a); }
#else
    a.ph_lo = 0; a.ph_hi = NPH;
    hipLaunchKernelGGL(nsa_block_fwd, dim3(grid), dim3(NWAVES * 64), LDS_BYTES, stream, a);
#endif
}
```
